# Optimizing an MI355X kernel written in HIP

```python
import math
import jax, jax.numpy as jnp
from jax import lax
import numpy as np

D_MODEL = 2048
BATCH = 4
SEQ = 4096
DEPTH = 2

HEAD_DIM = 128
H_A = 4
H_B = 6
H_C = 6
N_HEADS = H_A + H_B + H_C
H_SOFT = H_B + H_C
MIX_WIDTH = N_HEADS * HEAD_DIM
N_BRANCH = 3
D_FF = -(-(8 * D_MODEL) // (3 * 256)) * 256
Q_BLOCK = 128
MOBA_BLOCK = 256
MOBA_TOPK = 3
MOBA_Q_CHUNK = 32
DILATIONS = ((128, 1), (512, 4), (2048, 16))
BAND_BLOCK = 128
N_BUCKETS = 32
MAX_DISTANCE = 2048
RMS_EPS = 1e-6
NEG_INF = -1e30

kernel_name = 'hybrid_sb_moba_dilated_block'


def rmsnorm(x, g):
    xf = x.astype(jnp.float32)
    y = xf * lax.rsqrt(jnp.mean(xf * xf, axis=-1, keepdims=True) + RMS_EPS)
    return (y * g.astype(jnp.float32)).astype(x.dtype)


def t5_bucket(dist):
    max_exact = N_BUCKETS // 2
    d = jnp.maximum(dist, 0)
    df = jnp.maximum(d, 1).astype(jnp.float32)
    large = max_exact + (jnp.log(df / max_exact) / math.log(MAX_DISTANCE / max_exact)
                         * (N_BUCKETS - max_exact)).astype(jnp.int32)
    large = jnp.minimum(large, N_BUCKETS - 1)
    return jnp.where(d < max_exact, d, large)


def stick_breaking_attention(q, k, v):
    B, H, S, hd = q.shape
    scale = hd ** -0.5
    kpos = jnp.arange(S)

    def block(i):
        t0 = i * Q_BLOCK
        qb = lax.dynamic_slice_in_dim(q, t0, Q_BLOCK, axis=2)
        z = jnp.einsum('bhqd,bhkd->bhqk', qb, k).astype(jnp.float32) * scale
        qpos = t0 + jnp.arange(Q_BLOCK)
        past = kpos[None, :] < qpos[:, None]
        log_beta = jax.nn.log_sigmoid(z)
        log_1mb = jnp.where(past, jax.nn.log_sigmoid(-z), 0.0)
        after = lax.cumsum(log_1mb, axis=3, reverse=True) - log_1mb
        w = jnp.where(past, jnp.exp(log_beta + after), 0.0)
        return jnp.einsum('bhqk,bhkd->bhqd', w.astype(v.dtype), v)

    out = lax.map(block, jnp.arange(S // Q_BLOCK))
    return jnp.moveaxis(out, 0, 2).reshape(B, H, S, hd)


def moba_attention(q, k, v, bias_table):
    B, H, S, hd = q.shape
    nb = -(-S // MOBA_BLOCK)
    s_pad = nb * MOBA_BLOCK
    pad = ((0, 0), (0, 0), (0, s_pad - S), (0, 0))
    kp, vp = jnp.pad(k, pad), jnp.pad(v, pad)
    kblk = kp.reshape(B, H, nb, MOBA_BLOCK, hd)
    vblk = vp.reshape(B, H, nb, MOBA_BLOCK, hd)
    scale = hd ** -0.5
    bias_hb = bias_table.T.astype(jnp.float32)
    n_sel = min(MOBA_TOPK, nb - 1)
    own_blk = jnp.arange(S) // MOBA_BLOCK
    if n_sel > 0:
        kmean = jnp.mean(kblk, axis=3)
        gate = jnp.einsum('bhsd,bhnd->bhsn', q, kmean).astype(jnp.float32)
        fully_past = jnp.arange(nb)[None, :] < own_blk[:, None]
        gate = jnp.where(fully_past, gate, NEG_INF)
        _, sel = lax.top_k(gate, n_sel)
        sel_ok = sel < own_blk[:, None]
    b_idx = jnp.arange(B)[:, None, None, None]
    h_idx = jnp.arange(H)[None, :, None, None]
    in_blk = jnp.arange(MOBA_BLOCK)

    def chunk(i):
        t0 = i * MOBA_Q_CHUNK
        qc = lax.dynamic_slice_in_dim(q, t0, MOBA_Q_CHUNK, axis=2)
        tq = t0 + jnp.arange(MOBA_Q_CHUNK)
        b0 = (t0 // MOBA_BLOCK) * MOBA_BLOCK
        k_own = lax.dynamic_slice_in_dim(kp, b0, MOBA_BLOCK, axis=2)
        v_own = lax.dynamic_slice_in_dim(vp, b0, MOBA_BLOCK, axis=2)
        dist = tq[:, None] - (b0 + in_blk)[None, :]
        l_own = jnp.einsum('bhqd,bhkd->bhqk', qc, k_own).astype(jnp.float32) * scale
        l_own = jnp.where(dist >= 0, l_own + bias_hb[:, t5_bucket(dist)], NEG_INF)
        if n_sel == 0:
            p = jax.nn.softmax(l_own, axis=-1).astype(v.dtype)
            return jnp.einsum('bhqk,bhkd->bhqd', p, v_own)
        sc = lax.dynamic_slice_in_dim(sel, t0, MOBA_Q_CHUNK, axis=2)
        ok = lax.dynamic_slice_in_dim(sel_ok, t0, MOBA_Q_CHUNK, axis=2)
        k_sel = kblk[b_idx, h_idx, sc]
        v_sel = vblk[b_idx, h_idx, sc]
        dist_sel = tq[:, None, None] - (sc[..., None] * MOBA_BLOCK + in_blk)
        l_sel = jnp.einsum('bhqd,bhqnkd->bhqnk', qc, k_sel).astype(jnp.float32) * scale
        l_sel = l_sel + bias_hb[h_idx[..., None], t5_bucket(dist_sel)]
        n_past = n_sel * MOBA_BLOCK
        l_sel = jnp.where(ok[..., None], l_sel, NEG_INF).reshape(B, H, MOBA_Q_CHUNK, n_past)
        p = jax.nn.softmax(jnp.concatenate([l_sel, l_own], axis=-1), axis=-1).astype(v.dtype)
        o = jnp.einsum('bhqk,bhqkd->bhqd', p[..., :n_past],
                       v_sel.reshape(B, H, MOBA_Q_CHUNK, n_past, hd))
        return o + jnp.einsum('bhqk,bhkd->bhqd', p[..., n_past:], v_own)

    out = lax.map(chunk, jnp.arange(S // MOBA_Q_CHUNK))
    return jnp.moveaxis(out, 0, 2).reshape(B, H, S, hd)


def dilated_attention(q, k, v, bias_table):
    B, H, S, hd = q.shape
    scale = hd ** -0.5
    bb = BAND_BLOCK
    qi = jnp.arange(bb)[:, None]
    kj = jnp.arange(2 * bb)[None, :]
    delta = qi + bb - kj
    outs, lses = [], []
    for window, r in DILATIONS:
        span = window // r
        L = S // r
        nb = -(-L // bb)
        Lp = nb * bb

        def to_sub(t):
            t = t.reshape(B, H, L, r, hd).swapaxes(2, 3)
            return jnp.pad(t, ((0, 0), (0, 0), (0, 0), (0, Lp - L), (0, 0)))

        def band(t):
            t = jnp.pad(to_sub(t), ((0, 0), (0, 0), (0, 0), (bb, 0), (0, 0))).reshape(B, H, r, nb + 1, bb, hd)
            return jnp.concatenate([t[:, :, :, :-1], t[:, :, :, 1:]], axis=4)

        qs = to_sub(q).reshape(B, H, r, nb, bb, hd)
        kb, vb = band(k), band(v)
        key_idx = (jnp.arange(nb)[:, None, None] - 1) * bb + kj[None]
        mask = (delta >= 0) & (delta <= span) & (key_idx >= 0)
        bias = jnp.transpose(bias_table[t5_bucket(delta * r)], (2, 0, 1)).astype(jnp.float32)
        logits = jnp.einsum('bhrnqd,bhrnkd->bhrnqk', qs, kb).astype(jnp.float32) * scale
        logits = jnp.where(mask, logits + bias[:, None, None], NEG_INF)
        m = jnp.max(logits, axis=-1, keepdims=True)
        p = jnp.exp(logits - m)
        den = jnp.sum(p, axis=-1, keepdims=True)
        o = jnp.einsum('bhrnqk,bhrnkd->bhrnqd', (p / den).astype(v.dtype), vb)
        lse = (m + jnp.log(den))[..., 0]

        def from_sub(t):
            t = t.reshape((B, H, r, Lp) + t.shape[5:])[:, :, :, :L]
            return jnp.swapaxes(t, 2, 3).reshape((B, H, S) + t.shape[4:])

        outs.append(from_sub(o))
        lses.append(from_sub(lse))
    w = jax.nn.softmax(jnp.stack(lses, axis=0), axis=0)
    return jnp.einsum('gbhs,gbhsd->bhsd', w.astype(v.dtype), jnp.stack(outs, axis=0))


def hybrid_layer(x, g_mix, w_in, q_gain, k_gain, w_branch, w_out, g_ffn, w_gu, w_down, rel_bias):
    B, S, _ = x.shape
    h = rmsnorm(x, g_mix)
    proj = h @ w_in
    qkv = proj[..., :3 * MIX_WIDTH].reshape(B, S, 3, N_HEADS, HEAD_DIM)
    qkv = jnp.transpose(qkv, (2, 0, 3, 1, 4))
    q, k, v = qkv[0], qkv[1], qkv[2]
    gates = jax.nn.sigmoid(proj[..., 3 * MIX_WIDTH:].astype(jnp.float32)).astype(x.dtype)
    gates = gates.reshape(B, S, N_BRANCH, D_MODEL)

    o_a = stick_breaking_attention(q[:, :H_A], k[:, :H_A], v[:, :H_A])
    qn = rmsnorm(q[:, H_A:], q_gain[:, None, :])
    kn = rmsnorm(k[:, H_A:], k_gain[:, None, :])
    o_b = moba_attention(qn[:, :H_B], kn[:, :H_B], v[:, H_A:H_A + H_B], rel_bias[:, :H_B])
    o_c = dilated_attention(qn[:, H_B:], kn[:, H_B:], v[:, H_A + H_B:], rel_bias[:, H_B:])

    def flat(o):
        return jnp.transpose(o, (0, 2, 1, 3)).reshape(B, S, -1)

    ea, eb = H_A * HEAD_DIM, (H_A + H_B) * HEAD_DIM
    merged = (gates[:, :, 0] * (flat(o_a) @ w_branch[:ea])
              + gates[:, :, 1] * (flat(o_b) @ w_branch[ea:eb])
              + gates[:, :, 2] * (flat(o_c) @ w_branch[eb:]))
    x = x + merged @ w_out

    h2 = rmsnorm(x, g_ffn)
    gu = h2 @ w_gu
    x = x + (jax.nn.silu(gu[..., :D_FF]) * gu[..., D_FF:]) @ w_down
    return x


def setup_inputs(seed: int = 0) -> dict:
    key = jax.random.key(seed)
    ks = jax.random.split(key, 11)

    def nrm(k, shape, s):
        return jax.random.normal(k, shape, jnp.float32) * s

    return {
        'x': nrm(ks[0], (BATCH, SEQ, D_MODEL), 1.0),
        'g_mix': 1.0 + nrm(ks[1], (DEPTH, D_MODEL), 0.02),
        'w_in': nrm(ks[2], (DEPTH, D_MODEL, 3 * MIX_WIDTH + N_BRANCH * D_MODEL), D_MODEL ** -0.5),
        'q_gain': 1.0 + nrm(ks[3], (DEPTH, H_SOFT, HEAD_DIM), 0.02),
        'k_gain': 1.0 + nrm(ks[4], (DEPTH, H_SOFT, HEAD_DIM), 0.02),
        'w_branch': nrm(ks[5], (DEPTH, MIX_WIDTH, D_MODEL), (MIX_WIDTH / N_BRANCH) ** -0.5),
        'w_out': nrm(ks[6], (DEPTH, D_MODEL, D_MODEL), D_MODEL ** -0.5),
        'g_ffn': 1.0 + nrm(ks[7], (DEPTH, D_MODEL), 0.02),
        'w_gu': nrm(ks[8], (DEPTH, D_MODEL, 2 * D_FF), D_MODEL ** -0.5),
        'w_down': nrm(ks[9], (DEPTH, D_FF, D_MODEL), D_FF ** -0.5),
        'rel_bias': nrm(ks[10], (N_BUCKETS, H_SOFT), 0.5),
    }


def reference(x, g_mix, w_in, q_gain, k_gain, w_branch, w_out, g_ffn, w_gu, w_down, rel_bias):
    for l in range(DEPTH):
        x = hybrid_layer(x, g_mix[l], w_in[l], q_gain[l], k_gain[l], w_branch[l], w_out[l],
                         g_ffn[l], w_gu[l], w_down[l], rel_bias)
    return x
```

```cpp
#include <hip/hip_runtime.h>
#include <hip/hip_cooperative_groups.h>
#include <cstdio>
#include <cstdint>
namespace cg = cooperative_groups;

#ifndef MK_DUP_PRO
#define MK_DUP_PRO 1
#define MK_DUP_BIG 1
#define MK_DUP_BR 1
#define MK_DUP_ATT 1
#define MK_DUP_SYNC 1
#endif
#ifndef MK_PH_END
#define MK_PH_END 15
#endif
#ifndef MK_COOP
#define MK_COOP 1
#endif

namespace pg8 {
#define PG8_LAS __attribute__((address_space(3)))
typedef unsigned short bf16_t;
typedef short bf16x8 __attribute__((ext_vector_type(8)));
typedef float f32x4 __attribute__((ext_vector_type(4)));
typedef unsigned u32x4 __attribute__((ext_vector_type(4)));
typedef unsigned u32x2 __attribute__((ext_vector_type(2)));
constexpr int BM = 256, BK = 64, HALF = 128, HTB = HALF * BK * 2, STAGE_BYTES = 8 * HTB, NXCD = 8, WGM = 8;

__host__ __device__ __forceinline__ int lds_byte(int r, int c) { const int st = (r >> 4) * 2 + (c >> 5), rr = r & 15, cc = c & 31, ob = rr * 64 + cc * 2; return st * 1024 + (ob ^ (((ob >> 9) & 1) << 5)); }
__host__ __device__ __forceinline__ void stage_rc(int b, int& R, int& C) { const int st = b / 1024, sb = b % 1024, swz = sb ^ (((sb >> 9) & 1) << 5); R = (st >> 1) * 16 + swz / 64; C = (st & 1) * 32 + (swz % 64) / 2; }
__host__ __device__ __forceinline__ int perm32(int rho) { const int n = rho >> 4, i = rho & 15; return 8 * (i >> 2) + 4 * n + (i & 3); }

struct Unit { int pm, pn; };
struct Gemm { const bf16_t* A; const bf16_t* Bt; int lda, ldb, M, N, K; };

struct StaticOrder {
    int nM, nN, nwg, G, c;
    __host__ __device__ void init(int M, int N, int G_, int c_) { nM = M / BM; nN = N / BM; nwg = nM * nN; G = G_; c = c_; }
    __host__ __device__ bool next(int i, Unit& u) const {
        const int L = i * G + c; if (L >= nwg) return false;
        int wgid = L; { const int q = nwg / NXCD, r = nwg % NXCD, xcd = wgid % NXCD, off = wgid / NXCD; wgid = (xcd < r ? xcd * (q + 1) : r * (q + 1) + (xcd - r) * q) + off; }
        const int nig = WGM * nN, gid = wgid / nig, fm = gid * WGM, gsz = (nM - fm) < WGM ? (nM - fm) : WGM;
        u.pm = fm + ((wgid % nig) % gsz); u.pn = (wgid % nig) / gsz; return true;
    }
};

typedef float f32x2c_t __attribute__((ext_vector_type(2))); typedef __bf16 bf16x2c_t __attribute__((ext_vector_type(2)));
__device__ __forceinline__ unsigned cvt_pk_bf16(float lo, float hi) { f32x2c_t v = {lo, hi}; bf16x2c_t b = __builtin_convertvector(v, bf16x2c_t); return __builtin_bit_cast(unsigned, b); }
__device__ __forceinline__ float bf_lo(unsigned w) { return __uint_as_float(w << 16); }
__device__ __forceinline__ float bf_hi(unsigned w) { return __uint_as_float(w & 0xffff0000u); }
__device__ __forceinline__ float sigmoidf_(float v) { return __builtin_amdgcn_rcpf(1.0f + __builtin_amdgcn_exp2f(v * -1.4426950408889634f)); }


struct EpiIn {
    static constexpr bool PERM = true;
    bf16_t* qkv; bf16_t* gates; const float* ss;
    __device__ __forceinline__ void operator()(const f32x4 (&acc)[2][2][4][2], const Unit& u, int wr, int wc, int fr, int fq) const {
        const int row0 = u.pm * BM + wr * 64 + fr; const bool isg = u.pn >= 24;
        bf16_t* base = isg ? gates : qkv; const int col0 = (isg ? u.pn - 24 : u.pn) * BM + wc * 32 + 8 * fq;
        float ssv[2][4];
#pragma unroll
        for (int ai = 0; ai < 2; ++ai)
#pragma unroll
            for (int m = 0; m < 4; ++m) ssv[ai][m] = ss[row0 + ai * HALF + m * 16];
#pragma unroll
        for (int ai = 0; ai < 2; ++ai)
#pragma unroll
            for (int m = 0; m < 4; ++m) { const int row = row0 + ai * HALF + m * 16; const float rs = rsqrtf(ssv[ai][m] * (1.0f / 2048.0f) + 1e-6f);
                bf16_t* rowp = base + (size_t)row * 6144 + col0;
#pragma unroll
                for (int bj = 0; bj < 2; ++bj) { f32x4 v0 = acc[ai][bj][m][0] * rs, v1 = acc[ai][bj][m][1] * rs;
                    if (isg) { v0 = (f32x4){sigmoidf_(v0[0]), sigmoidf_(v0[1]), sigmoidf_(v0[2]), sigmoidf_(v0[3])}; v1 = (f32x4){sigmoidf_(v1[0]), sigmoidf_(v1[1]), sigmoidf_(v1[2]), sigmoidf_(v1[3])}; }
                    u32x4 w; w.x = cvt_pk_bf16(v0[0], v0[1]); w.y = cvt_pk_bf16(v0[2], v0[3]); w.z = cvt_pk_bf16(v1[0], v1[1]); w.w = cvt_pk_bf16(v1[2], v1[3]);
                    *(u32x4*)(rowp + bj * HALF) = w; } }
    }
};
struct EpiGU {
    static constexpr bool PERM = true;
    bf16_t* act; const float* ss;
    __device__ __forceinline__ void operator()(const f32x4 (&acc)[2][2][4][2], const Unit& u, int wr, int wc, int fr, int fq) const {
        const int row0 = u.pm * BM + wr * 64 + fr; const int col0 = u.pn * HALF + wc * 32 + 8 * fq;
        float ssv[2][4];
#pragma unroll
        for (int ai = 0; ai < 2; ++ai)
#pragma unroll
            for (int m = 0; m < 4; ++m) ssv[ai][m] = ss[row0 + ai * HALF + m * 16];
#pragma unroll
        for (int ai = 0; ai < 2; ++ai)
#pragma unroll
            for (int m = 0; m < 4; ++m) { const int row = row0 + ai * HALF + m * 16; const float rs = rsqrtf(ssv[ai][m] * (1.0f / 2048.0f) + 1e-6f);
                float r[8];
#pragma unroll
                for (int n = 0; n < 2; ++n)
#pragma unroll
                    for (int e = 0; e < 4; ++e) { const float g = acc[ai][0][m][n][e] * rs, up = acc[ai][1][m][n][e] * rs; r[n * 4 + e] = g * sigmoidf_(g) * up; }
                u32x4 w; w.x = cvt_pk_bf16(r[0], r[1]); w.y = cvt_pk_bf16(r[2], r[3]); w.z = cvt_pk_bf16(r[4], r[5]); w.w = cvt_pk_bf16(r[6], r[7]);
                *(u32x4*)(act + (size_t)row * 5632 + col0) = w; }
    }
};
struct EpiBranch {
    static constexpr bool PERM = true;
    bf16_t* merged; const bf16_t* gates; int gcol; int first;
    __device__ __forceinline__ void operator()(const f32x4 (&acc)[2][2][4][2], const Unit& u, int wr, int wc, int fr, int fq) const {
        const int row0 = u.pm * BM + wr * 64 + fr; const int col0 = u.pn * BM + wc * 32 + 8 * fq;
#pragma unroll
        for (int aq = 0; aq < 4; ++aq) { const int ai = aq >> 1, m0 = 2 * (aq & 1);
            u32x4 gw[2][2], pw[2][2];
#pragma unroll
            for (int mm = 0; mm < 2; ++mm)
#pragma unroll
                for (int bj = 0; bj < 2; ++bj) { const int row = row0 + ai * HALF + (m0 + mm) * 16, col = col0 + bj * HALF;
                    gw[mm][bj] = *(const u32x4*)(gates + (size_t)row * 6144 + gcol + col);
                    pw[mm][bj] = first ? (u32x4){0u, 0u, 0u, 0u} : *(const u32x4*)(merged + (size_t)row * 6144 + col); }
#pragma unroll
            for (int mm = 0; mm < 2; ++mm)
#pragma unroll
                for (int bj = 0; bj < 2; ++bj) { const int m = m0 + mm; const int row = row0 + ai * HALF + m * 16, col = col0 + bj * HALF;
                    const u32x4 g_ = gw[mm][bj], p_ = pw[mm][bj]; float r[8];
                    r[0] = bf_lo(g_.x) * acc[ai][bj][m][0][0] + bf_lo(p_.x); r[1] = bf_hi(g_.x) * acc[ai][bj][m][0][1] + bf_hi(p_.x);
                    r[2] = bf_lo(g_.y) * acc[ai][bj][m][0][2] + bf_lo(p_.y); r[3] = bf_hi(g_.y) * acc[ai][bj][m][0][3] + bf_hi(p_.y);
                    r[4] = bf_lo(g_.z) * acc[ai][bj][m][1][0] + bf_lo(p_.z); r[5] = bf_hi(g_.z) * acc[ai][bj][m][1][1] + bf_hi(p_.z);
                    r[6] = bf_lo(g_.w) * acc[ai][bj][m][1][2] + bf_lo(p_.w); r[7] = bf_hi(g_.w) * acc[ai][bj][m][1][3] + bf_hi(p_.w);
                    u32x4 w; w.x = cvt_pk_bf16(r[0], r[1]); w.y = cvt_pk_bf16(r[2], r[3]); w.z = cvt_pk_bf16(r[4], r[5]); w.w = cvt_pk_bf16(r[6], r[7]);
                    *(u32x4*)(merged + (size_t)row * 6144 + col) = w; }
            asm volatile("" ::: "memory");
        }
    }
};
struct EpiResid {
    static constexpr bool PERM = true;
    const float* base; float* out; bf16_t* xb; float* ss;
    __device__ __forceinline__ void operator()(const f32x4 (&acc)[2][2][4][2], const Unit& u, int wr, int wc, int fr, int fq) const {
        const int row0 = u.pm * BM + wr * 64 + fr; const int col0 = u.pn * BM + wc * 32 + 8 * fq;
#pragma unroll
        for (int aq = 0; aq < 4; ++aq) { const int ai = aq >> 1, m0 = 2 * (aq & 1);
            f32x4 bv[2][2][2];
#pragma unroll
            for (int mm = 0; mm < 2; ++mm)
#pragma unroll
                for (int bj = 0; bj < 2; ++bj) { const size_t off = (size_t)(row0 + ai * HALF + (m0 + mm) * 16) * 2048 + col0 + bj * HALF;
                    bv[mm][bj][0] = *(const f32x4*)(base + off); bv[mm][bj][1] = *(const f32x4*)(base + off + 4); }
#pragma unroll
            for (int mm = 0; mm < 2; ++mm) { const int m = m0 + mm; const int row = row0 + ai * HALF + m * 16; float sq = 0.f;
#pragma unroll
                for (int bj = 0; bj < 2; ++bj) { const size_t off = (size_t)row * 2048 + col0 + bj * HALF;
                    const f32x4 o0 = bv[mm][bj][0] + acc[ai][bj][m][0], o1 = bv[mm][bj][1] + acc[ai][bj][m][1];
                    *(f32x4*)(out + off) = o0; *(f32x4*)(out + off + 4) = o1;
                    sq += (o0[0] * o0[0] + o0[1] * o0[1]) + (o0[2] * o0[2] + o0[3] * o0[3]) + (o1[0] * o1[0] + o1[1] * o1[1]) + (o1[2] * o1[2] + o1[3] * o1[3]);
                    if (xb) { u32x4 w; w.x = cvt_pk_bf16(o0[0], o0[1]); w.y = cvt_pk_bf16(o0[2], o0[3]); w.z = cvt_pk_bf16(o1[0], o1[1]); w.w = cvt_pk_bf16(o1[2], o1[3]); *(u32x4*)(xb + off) = w; } }
                if (ss) { sq += __shfl_xor(sq, 16); sq += __shfl_xor(sq, 32); if (fq == 0) atomicAdd(ss + row, sq); } }
            asm volatile("" ::: "memory");
        }
    }
};

template <class Epi, class Sched>
__device__ __forceinline__ void gemm_phase(PG8_LAS unsigned char* lds, const Gemm g, const Sched& S, const Epi& E, const int tid) {
    const int wid = __builtin_amdgcn_readfirstlane(tid >> 6), lane = tid & 63, wr = wid >> 2, wc = wid & 3, fr = lane & 15, fq = lane >> 4;
    const int nt = g.K / BK;
    unsigned voffA[2], voffB[2];
#pragma unroll
    for (int i = 0; i < 2; ++i) { int R, C; stage_rc(tid * 16 + i * 8192, R, C); const int Rb = Epi::PERM ? ((R & ~31) + perm32(R & 31)) : R;
        voffA[i] = (unsigned)(R * g.lda + C) * 2u; voffB[i] = (unsigned)(Rb * g.ldb + C) * 2u; }
    const size_t kstep = (size_t)(BK * 2);
    const size_t hstepA = (size_t)HALF * g.lda * 2, hstepB = (size_t)HALF * g.ldb * 2;
    const size_t tstepA = 2 * hstepA, tstepB = 2 * hstepB;
    const unsigned ldsw = (unsigned)wid * 1024u;
    const int aoff = lds_byte(wr * 64 + fr, fq * 8), boff = lds_byte(wc * 32 + fr, fq * 8);
#define PG8_SA(b, h) (((b) * 2 + (h)) * HTB)
#define PG8_SB(b, h) ((4 + (b) * 2 + (h)) * HTB)
#define PG8_STAGE(bufoff, gbase, voff) do { _Pragma("unroll") for (int _i = 0; _i < 2; ++_i) \
        __builtin_amdgcn_global_load_lds((const unsigned*)((const char*)(gbase) + (voff)[_i]), (PG8_LAS unsigned*)(lds + (bufoff) + ldsw + _i * 8192), 16, 0, 0); } while (0)
#define PG8_LDA(dst, b, h) do { _Pragma("unroll") for (int m = 0; m < 4; ++m) _Pragma("unroll") for (int k = 0; k < 2; ++k) dst[m][k] = *(const PG8_LAS bf16x8*)(lds + PG8_SA(b, h) + aoff + m * 2048 + k * 1024); } while (0)
#define PG8_LDB(dst, b, h) do { _Pragma("unroll") for (int n = 0; n < 2; ++n) _Pragma("unroll") for (int k = 0; k < 2; ++k) dst[n][k] = *(const PG8_LAS bf16x8*)(lds + PG8_SB(b, h) + boff + n * 2048 + k * 1024); } while (0)
#define PG8_MMA(ai, bj, At, Bt) do { __builtin_amdgcn_s_setprio(1); _Pragma("unroll") for (int m = 0; m < 4; ++m) _Pragma("unroll") for (int n = 0; n < 2; ++n) _Pragma("unroll") for (int k = 0; k < 2; ++k) \
        acc[ai][bj][m][n] = __builtin_amdgcn_mfma_f32_16x16x32_bf16(Bt[n][k], At[m][k], acc[ai][bj][m][n], 0, 0, 0); __builtin_amdgcn_s_setprio(0); } while (0)
#define PG8_WAIT_V(n) asm volatile("s_waitcnt vmcnt(" #n ")" ::: "memory")
#define PG8_WAIT_L(n) asm volatile("s_waitcnt lgkmcnt(" #n ")" ::: "memory")
#define PG8_BAR __builtin_amdgcn_s_barrier()
#define PG8_SCHED __builtin_amdgcn_sched_barrier(0)
    Unit cur, nxt; int ui = 0;
    if (!S.next(0, cur)) return;
    f32x4 acc[2][2][4][2];
#pragma unroll
    for (int a = 0; a < 2; ++a)
#pragma unroll
        for (int b = 0; b < 2; ++b)
#pragma unroll
            for (int m = 0; m < 4; ++m)
#pragma unroll
                for (int n = 0; n < 2; ++n) acc[a][b][m][n] = (f32x4){0.f, 0.f, 0.f, 0.f};
    bf16x8 At[4][2], B0[2][2], B1[2][2];
    const char* cA = (const char*)g.A + (size_t)cur.pm * tstepA; const char* cB = (const char*)g.Bt + (size_t)cur.pn * tstepB;
    PG8_STAGE(PG8_SB(0, 0), cB, voffB); PG8_STAGE(PG8_SB(0, 1), cB + hstepB, voffB); PG8_STAGE(PG8_SA(0, 0), cA, voffA); PG8_STAGE(PG8_SA(0, 1), cA + hstepA, voffA);
    if (wr == 1) PG8_BAR;
    PG8_WAIT_V(2); PG8_BAR;
    PG8_STAGE(PG8_SB(1, 0), cB + kstep, voffB); PG8_STAGE(PG8_SA(1, 0), cA + kstep, voffA); PG8_STAGE(PG8_SB(1, 1), cB + hstepB + kstep, voffB);
    PG8_WAIT_V(6); PG8_BAR;
    for (;;) {
        const bool has_next = S.next(ui + 1, nxt);
        const char* nA = has_next ? (const char*)g.A + (size_t)nxt.pm * tstepA : cA; const char* nB = has_next ? (const char*)g.Bt + (size_t)nxt.pn * tstepB : cB;
        for (int t = 0; t < nt; t += 2) {
            const bool last = (t == nt - 2);
            const char* a1 = cA + (size_t)(t + 1) * kstep;
            const char* a2 = last ? nA : cA + (size_t)(t + 2) * kstep; const char* b2 = last ? nB : cB + (size_t)(t + 2) * kstep;
            const char* a3 = a2 + kstep; const char* b3 = b2 + kstep;
            PG8_LDB(B0, 0, 0); PG8_LDB(B1, 0, 1); PG8_SCHED; PG8_LDA(At, 0, 0); PG8_STAGE(PG8_SA(1, 1), a1 + hstepA, voffA);
            PG8_WAIT_V(8); PG8_WAIT_L(0); PG8_BAR; PG8_MMA(0, 0, At, B0); PG8_MMA(0, 1, At, B1); PG8_BAR; PG8_SCHED;
            PG8_LDA(At, 0, 1); PG8_STAGE(PG8_SB(0, 0), b2, voffB); PG8_STAGE(PG8_SB(0, 1), b2 + hstepB, voffB); PG8_STAGE(PG8_SA(0, 0), a2, voffA);
            PG8_WAIT_V(8); PG8_WAIT_L(0); PG8_BAR; PG8_MMA(1, 0, At, B0); PG8_MMA(1, 1, At, B1); PG8_BAR; PG8_SCHED;
            PG8_LDB(B0, 1, 0); PG8_LDB(B1, 1, 1); PG8_SCHED; PG8_LDA(At, 1, 0); PG8_STAGE(PG8_SA(0, 1), a2 + hstepA, voffA);
            PG8_WAIT_V(8); PG8_WAIT_L(0); PG8_BAR; PG8_MMA(0, 0, At, B0); PG8_MMA(0, 1, At, B1); PG8_BAR; PG8_SCHED;
            PG8_LDA(At, 1, 1); PG8_STAGE(PG8_SB(1, 0), b3, voffB); PG8_STAGE(PG8_SB(1, 1), b3 + hstepB, voffB); PG8_STAGE(PG8_SA(1, 0), a3, voffA);
            PG8_WAIT_V(8); PG8_WAIT_L(0); PG8_BAR; PG8_MMA(1, 0, At, B0); PG8_MMA(1, 1, At, B1); PG8_BAR; PG8_SCHED;
        }
        if (wr == 0) PG8_BAR;
        E(acc, cur, wr, wc, fr, fq);
        if (!has_next) break;
#pragma unroll
        for (int a = 0; a < 2; ++a)
#pragma unroll
            for (int b = 0; b < 2; ++b)
#pragma unroll
                for (int m = 0; m < 4; ++m)
#pragma unroll
                    for (int n = 0; n < 2; ++n) acc[a][b][m][n] = (f32x4){0.f, 0.f, 0.f, 0.f};
        cur = nxt; cA = nA; cB = nB; ++ui;
        if (wr == 1) PG8_BAR;
    }
    PG8_WAIT_V(0);
    PG8_BAR;
#undef PG8_SA
#undef PG8_SB
#undef PG8_STAGE
#undef PG8_LDA
#undef PG8_LDB
#undef PG8_MMA
#undef PG8_WAIT_V
#undef PG8_WAIT_L
#undef PG8_BAR
#undef PG8_SCHED
}
}

#define GAS __attribute__((address_space(1)))
#define LAS __attribute__((address_space(3)))
typedef unsigned short bf16_t;
typedef short bf16x8 __attribute__((ext_vector_type(8)));
typedef short s16x4 __attribute__((ext_vector_type(4)));
typedef float f32x4 __attribute__((ext_vector_type(4)));
typedef float f32x16 __attribute__((ext_vector_type(16)));
typedef unsigned u32x4 __attribute__((ext_vector_type(4)));
typedef unsigned u32x2 __attribute__((ext_vector_type(2)));

constexpr int DM = 2048, BATCH = 4, SEQ = 4096, M = BATCH * SEQ, DFF = 5632, NIN = 12288, NGU = 11264, QKVP = 6144;
constexpr int NWAVES = 8, NTHR = 512;
constexpr size_t MiB = 1u << 20;
constexpr size_t WS_CTR = 0, WS_SS = 64 * 1024, WS_LUT = 512 * 1024, WS_KM = 1 * MiB;
constexpr size_t WS_WIN = 4 * MiB, WS_WBR = 100 * MiB, WS_WOUT = 116 * MiB, WS_WGU = 132 * MiB, WS_WDN = 220 * MiB;
constexpr size_t WS_XB = 264 * MiB, WS_QKV = 328 * MiB, WS_GATES = 520 * MiB, WS_END = 712 * MiB;
constexpr int LDS_BYTES = 132096;
constexpr int ATT_V_OFF = 0, ATT_LUT_OFF = 65536, ATT_KM_OFF = 81920, MISC_OFF = 131072;

struct Args {
    const float* x; const float* g_mix; const float* w_in; const float* q_gain; const float* k_gain; const float* w_branch; const float* w_out;
    const float* g_ffn; const float* w_gu; const float* w_down; const float* rel_bias;
    float* out; unsigned char* ws; int ph_lo, ph_hi;
};

__device__ __forceinline__ unsigned f2bf(float f) { unsigned u = __builtin_bit_cast(unsigned, f); return (u + 0x7fffu + ((u >> 16) & 1u)) >> 16; }
__device__ __forceinline__ unsigned pk2(float lo, float hi) { return pg8::cvt_pk_bf16(lo, hi); }
__device__ __forceinline__ float wave_sum(float v) {
#pragma unroll
    for (int o = 1; o < 64; o <<= 1) v += __shfl_xor(v, o);
    return v;
}

template <bool GU>
__device__ __forceinline__ void transpose_item(const float* W, const float* gk, int K, int N, bf16_t* WT, LAS float* scr, int item, int lane) {
    const int nblk = N / 32, kb = item / nblk, nb = item % nblk, k0 = 64 * kb, n0 = 32 * nb;
    float v[32];
#pragma unroll
    for (int i = 0; i < 32; ++i) v[i] = W[(size_t)(k0 + 2 * i + (lane >> 5)) * N + n0 + (lane & 31)];
#pragma unroll
    for (int i = 0; i < 32; ++i) { const int kk = 2 * i + (lane >> 5); if (gk) v[i] *= gk[k0 + kk]; scr[kk * 33 + (lane & 31)] = v[i]; }
    asm volatile("s_waitcnt lgkmcnt(0)" ::: "memory");
    const int c = lane & 7;
#pragma unroll
    for (int j = 0; j < 4; ++j) { const int n = (lane >> 3) + 8 * j; const LAS float* s = scr + (8 * c) * 33 + n;
        u32x4 o; o.x = pk2(s[0 * 33], s[1 * 33]); o.y = pk2(s[2 * 33], s[3 * 33]); o.z = pk2(s[4 * 33], s[5 * 33]); o.w = pk2(s[6 * 33], s[7 * 33]);
        int col = n0 + n, drow;
        if (GU) { const int half = col >= DFF ? 1 : 0, jj = col - half * DFF; drow = 256 * (jj >> 7) + 128 * half + (jj & 127); } else drow = col;
        *(u32x4*)(WT + (size_t)drow * K + k0 + 8 * c) = o; }
    asm volatile("s_waitcnt lgkmcnt(0)" ::: "memory");
}

__device__ __forceinline__ void phase_prologue(const Args& a, LAS unsigned char* lds, int tid, int lane, int wave) {
    unsigned char* ws = a.ws;
    LAS float* scr = (LAS float*)(lds + wave * 16384);
    int NGW = gridDim.x * NWAVES; asm volatile("" : "+s"(NGW));
    const int gw = blockIdx.x * NWAVES + wave;
    constexpr int I_IN = (DM / 64) * (NIN / 32), I_BR = (DM / 64) * (DM / 32), I_OUT = I_BR, I_GU = (DM / 64) * (NGU / 32), I_DN = (DFF / 64) * (DM / 32);
    constexpr int I_LAYER = I_IN + I_BR + I_OUT + I_GU + I_DN;
    for (int it = gw; it < 2 * I_LAYER; it += NGW) {
        const int l = it / I_LAYER; int r = it % I_LAYER;
        if (r < I_IN) { transpose_item<false>(a.w_in + (size_t)l * DM * NIN, a.g_mix + l * DM, DM, NIN, (bf16_t*)(ws + WS_WIN) + (size_t)l * NIN * DM, scr, r, lane); continue; } r -= I_IN;
        if (r < I_BR) { transpose_item<false>(a.w_branch + (size_t)l * DM * DM, nullptr, DM, DM, (bf16_t*)(ws + WS_WBR) + (size_t)l * DM * DM, scr, r, lane); continue; } r -= I_BR;
        if (r < I_OUT) { transpose_item<false>(a.w_out + (size_t)l * DM * DM, nullptr, DM, DM, (bf16_t*)(ws + WS_WOUT) + (size_t)l * DM * DM, scr, r, lane); continue; } r -= I_OUT;
        if (r < I_GU) { transpose_item<true>(a.w_gu + (size_t)l * DM * NGU, a.g_ffn + l * DM, DM, NGU, (bf16_t*)(ws + WS_WGU) + (size_t)l * NGU * DM, scr, r, lane); continue; } r -= I_GU;
        transpose_item<false>(a.w_down + (size_t)l * DFF * DM, nullptr, DFF, DM, (bf16_t*)(ws + WS_WDN) + (size_t)l * DM * DFF, scr, r, lane);
    }
    float* ss = (float*)(ws + WS_SS);
    for (int m = gw; m < M; m += NGW) {
        const f32x4* xr = (const f32x4*)(a.x + (size_t)m * DM) + lane; u32x2* o8 = (u32x2*)((bf16_t*)(ws + WS_XB) + (size_t)m * DM) + lane;
        float s = 0.f;
#pragma unroll
        for (int j = 0; j < 8; ++j) { const f32x4 v = xr[64 * j]; s += (v.x * v.x + v.y * v.y) + (v.z * v.z + v.w * v.w); u32x2 w; w.x = pk2(v.x, v.y); w.y = pk2(v.z, v.w); o8[64 * j] = w; }
        s = wave_sum(s);
        if (lane == 0) ss[m] = s;
    }
    int NGT = gridDim.x * NTHR; asm volatile("" : "+s"(NGT));
    const int gt = blockIdx.x * NTHR + tid;
    for (int i = gt; i < 3 * M; i += NGT) ss[M + i] = 0.f;
    if (gt < 1024) ((unsigned*)(ws + WS_CTR))[gt] = 0u;
    float* lut = (float*)(ws + WS_LUT);
    for (int i = gt; i < 12 * 4096; i += NGT) { const int hs = i >> 12, d = i & 4095; int bucket;
        if (d < 16) bucket = d; else { const float df = (float)d; int large = 16 + (int)(logf(df / 16.0f) / 4.852030263919617f * 16.0f); bucket = large < 31 ? large : 31; }
        lut[i] = a.rel_bias[bucket * 12 + hs] * 1.4426950408889634f; }
}

__device__ __forceinline__ void phase_qknorm(const Args& a, int l, LAS unsigned char* lds, int tid, int lane, int wave) {
    bf16_t* qkv = (bf16_t*)(a.ws + WS_QKV); float* kmean = (float*)(a.ws + WS_KM);
    LAS float* red = (LAS float*)lds;
    for (int it = blockIdx.x; it < 1536; it += gridDim.x) {
        const int kind = it / 768, rem = it % 768, b = rem / 192, hs = (rem % 192) / 16, blk = rem % 16;
        const float* gain = (kind ? a.k_gain : a.q_gain) + (size_t)l * 12 * 128 + hs * 128 + (lane & 15) * 8;
        float gn[8];
#pragma unroll
        for (int e = 0; e < 8; ++e) gn[e] = gain[e];
        bf16_t* base = qkv + (size_t)(b * SEQ + blk * 256 + wave * 32) * QKVP + kind * 2048 + (4 + hs) * 128 + (lane & 15) * 8;
        float ks[8];
#pragma unroll
        for (int e = 0; e < 8; ++e) ks[e] = 0.f;
        u32x4 wv[8];
#pragma unroll
        for (int ii = 0; ii < 8; ++ii) wv[ii] = *(const u32x4*)(base + (size_t)(4 * ii + (lane >> 4)) * QKVP);
#pragma unroll
        for (int ii = 0; ii < 8; ++ii) { bf16_t* p = base + (size_t)(4 * ii + (lane >> 4)) * QKVP;
            const u32x4 w = wv[ii]; float v[8];
            v[0] = pg8::bf_lo(w.x); v[1] = pg8::bf_hi(w.x); v[2] = pg8::bf_lo(w.y); v[3] = pg8::bf_hi(w.y); v[4] = pg8::bf_lo(w.z); v[5] = pg8::bf_hi(w.z); v[6] = pg8::bf_lo(w.w); v[7] = pg8::bf_hi(w.w);
            float s = 0.f;
#pragma unroll
            for (int e = 0; e < 8; ++e) s += v[e] * v[e];
            s += __shfl_xor(s, 1); s += __shfl_xor(s, 2); s += __shfl_xor(s, 4); s += __shfl_xor(s, 8);
            const float rs = rsqrtf(s * (1.0f / 128.0f) + 1e-6f);
#pragma unroll
            for (int e = 0; e < 8; ++e) { v[e] = v[e] * rs * gn[e]; ks[e] += v[e]; }
            u32x4 o; o.x = pk2(v[0], v[1]); o.y = pk2(v[2], v[3]); o.z = pk2(v[4], v[5]); o.w = pk2(v[6], v[7]);
            *(u32x4*)p = o; }
        const bool km = (kind == 1) && (hs < 6);
        if (km) {
#pragma unroll
            for (int e = 0; e < 8; ++e) { ks[e] += __shfl_xor(ks[e], 16); ks[e] += __shfl_xor(ks[e], 32); }
            if (lane < 16) {
#pragma unroll
                for (int e = 0; e < 8; ++e) red[wave * 128 + lane * 8 + e] = ks[e]; }
        }
        __syncthreads();
        if (km && tid < 128) { float s = 0.f;
#pragma unroll
            for (int w = 0; w < 8; ++w) s += red[w * 128 + tid];
            kmean[((size_t)(b * 6 + hs) * 16 + blk) * 128 + tid] = s * (1.0f / 256.0f); }
        __syncthreads();
    }
}

namespace att {
constexpr float SCALE = 0.08838834764831845f, LOG2E = 1.4426950408889634f, NEG = -1e30f, C1 = SCALE * LOG2E;
__device__ __forceinline__ unsigned offa(unsigned row, unsigned ch) { return 2048u * (row >> 3) + 512u * (ch >> 2) + 64u * (row & 7u) + 16u * ((ch & 3u) ^ ((row >> 2) & 3u)); }
__device__ __forceinline__ int clamp_s(int s) { return s < 0 ? 0 : (s > SEQ - 1 ? SEQ - 1 : s); }
__device__ __forceinline__ void load_k(bf16x8 (&kf)[8], const bf16_t* Kb, int s0, int stride, int lane) {
    const int s = clamp_s(s0 + stride * (lane & 31));
    const GAS bf16x8* p = (const GAS bf16x8*)(Kb + (size_t)s * QKVP + 8 * (lane >> 5));
#pragma unroll
    for (int j = 0; j < 8; ++j) kf[j] = p[2 * j];
}
__device__ __forceinline__ void load_v(u32x4 (&vr)[8], const bf16_t* Vb, int s0, int stride, int lane) {
#pragma unroll
    for (int ii = 0; ii < 8; ++ii) { const int s = clamp_s(s0 + stride * ((lane >> 4) + 4 * ii)); vr[ii] = *(const GAS u32x4*)(Vb + (size_t)s * QKVP + (lane & 15) * 8); }
}
__device__ __forceinline__ void stage_v(LAS unsigned char* vl, const u32x4 (&vr)[8], int lane) {
    const unsigned ch = lane & 15, wl = 512u * (ch >> 2) + 64u * (unsigned)(lane >> 4);
#pragma unroll
    for (int ii = 0; ii < 8; ++ii) *(LAS u32x4*)(vl + wl + 16u * ((ch & 3u) ^ (unsigned)(ii & 3)) + 2048 * (ii >> 1) + 256 * (ii & 1)) = vr[ii];
}
__device__ __forceinline__ f32x16 qk(const bf16x8 (&kf)[8], const bf16x8 (&qf)[8]) {
    f32x16 acc = {0.f, 0.f, 0.f, 0.f, 0.f, 0.f, 0.f, 0.f, 0.f, 0.f, 0.f, 0.f, 0.f, 0.f, 0.f, 0.f};
#pragma unroll
    for (int j = 0; j < 8; ++j) acc = __builtin_amdgcn_mfma_f32_32x32x16_bf16(kf[j], qf[j], acc, 0, 0, 0);
    return acc;
}
typedef short v4i16_t __attribute__((ext_vector_type(4)));
__device__ __forceinline__ s16x4 vtr(LAS unsigned char* p) { return __builtin_bit_cast(s16x4, __builtin_amdgcn_ds_read_tr16_b64_v4i16((LAS v4i16_t*)p)); }
__device__ __forceinline__ void pv(f32x16 (&o)[4], LAS unsigned char* vl, bf16x8 P0, bf16x8 P1, int lane) {
    const unsigned h = lane >> 5, blk = (lane >> 4) & 1, q = (lane & 15) >> 2, p = lane & 3;
    const unsigned lb = 64u * (4u * h + q) + 16u * ((p >> 1) ^ h) + 8u * (p & 1u);
    LAS unsigned char* b0 = vl + lb + 32u * blk; LAS unsigned char* b1 = vl + lb + 32u * (blk ^ 1u) + 2048u;
#pragma unroll
    for (int hf = 0; hf < 2; ++hf) {
        s16x4 lo[2][2], hi[2][2];
#pragma unroll
        for (int cc = 0; cc < 2; ++cc)
#pragma unroll
            for (int s = 0; s < 2; ++s) { lo[cc][s] = vtr(b0 + 4096 * s + 512 * (2 * hf + cc)); hi[cc][s] = vtr(b1 + 4096 * s + 512 * (2 * hf + cc)); }
        asm volatile("s_waitcnt lgkmcnt(0)" ::: "memory");
        __builtin_amdgcn_sched_barrier(0);
#pragma unroll
        for (int cc = 0; cc < 2; ++cc)
#pragma unroll
            for (int s = 0; s < 2; ++s) {
                const bf16x8 A = {lo[cc][s][0], lo[cc][s][1], lo[cc][s][2], lo[cc][s][3], hi[cc][s][0], hi[cc][s][1], hi[cc][s][2], hi[cc][s][3]};
                o[2 * hf + cc] = __builtin_amdgcn_mfma_f32_32x32x16_bf16(A, s ? P1 : P0, o[2 * hf + cc], 0, 0, 0);
            }
        __builtin_amdgcn_sched_barrier(0);
    }
}
typedef float f32x2_t __attribute__((ext_vector_type(2))); typedef __bf16 bf16x2_t __attribute__((ext_vector_type(2)));
__device__ __forceinline__ unsigned cvtpk(float lo, float hi) { f32x2_t v = {lo, hi}; bf16x2_t b = __builtin_convertvector(v, bf16x2_t); return __builtin_bit_cast(unsigned, b); }
__device__ __forceinline__ void pack_p(const float (&p)[16], bf16x8& P0, bf16x8& P1) {
    u32x4 a, b; a.x = cvtpk(p[0], p[1]); a.y = cvtpk(p[2], p[3]); a.z = cvtpk(p[4], p[5]); a.w = cvtpk(p[6], p[7]);
    b.x = cvtpk(p[8], p[9]); b.y = cvtpk(p[10], p[11]); b.z = cvtpk(p[12], p[13]); b.w = cvtpk(p[14], p[15]);
    P0 = __builtin_bit_cast(bf16x8, a); P1 = __builtin_bit_cast(bf16x8, b);
}
__device__ __forceinline__ void softmax_step(float (&x)[16], float& m, float& l, f32x16 (&o)[4], bf16x8& P0, bf16x8& P1) {
    float mx = fmaxf(x[0], x[1]);
#pragma unroll
    for (int r = 2; r < 16; ++r) mx = fmaxf(mx, x[r]);
    mx = fmaxf(mx, __shfl_xor(mx, 32));
    const float mn = fmaxf(m, mx);
    const float alpha = __builtin_amdgcn_exp2f(m - mn);
    float ls = 0.f;
#pragma unroll
    for (int r = 0; r < 16; ++r) { const float p = __builtin_amdgcn_exp2f(x[r] - mn); ls += p; x[r] = p; }
    l = l * alpha + ls; m = mn;
    if (__any(alpha != 1.0f)) {
#pragma unroll
        for (int c = 0; c < 4; ++c) o[c] = o[c] * alpha;
    }
    pack_p(x, P0, P1);
}
__device__ __forceinline__ void softmax_fixed(float (&x)[16], float& l, bf16x8& P0, bf16x8& P1) {
    float ls = 0.f;
#pragma unroll
    for (int r = 0; r < 16; ++r) { const float p = __builtin_amdgcn_exp2f(x[r]); ls += p; x[r] = p; }
    l += ls;
    pack_p(x, P0, P1);
}
__device__ __forceinline__ float softmax_ref(const Args& a, int l, int hs, const bf16x8 (&qf)[8], int lane) {
    const float* kg = a.k_gain + (size_t)l * 12 * 128 + hs * 128;
    float gm = fmaxf(fabsf(kg[lane]), fabsf(kg[lane + 64]));
    float bm = a.rel_bias[(lane & 31) * 12 + hs];
#pragma unroll
    for (int o_ = 1; o_ < 64; o_ <<= 1) { gm = fmaxf(gm, __shfl_xor(gm, o_)); bm = fmaxf(bm, __shfl_xor(bm, o_)); }
    float qs = 0.f;
#pragma unroll
    for (int j = 0; j < 8; ++j) { const u32x4 qw = __builtin_bit_cast(u32x4, qf[j]);
        const float q0 = pg8::bf_lo(qw.x), q1 = pg8::bf_hi(qw.x), q2 = pg8::bf_lo(qw.y), q3 = pg8::bf_hi(qw.y), q4 = pg8::bf_lo(qw.z), q5 = pg8::bf_hi(qw.z), q6 = pg8::bf_lo(qw.w), q7 = pg8::bf_hi(qw.w);
        qs += (q0 * q0 + q1 * q1) + (q2 * q2 + q3 * q3) + (q4 * q4 + q5 * q5) + (q6 * q6 + q7 * q7); }
    qs += __shfl_xor(qs, 32);
    return C1 * sqrtf(qs) * (11.3137085f * 1.004f * gm) + bm * LOG2E + 1e-3f;
}
__device__ __forceinline__ void store_o(const f32x16 (&o)[4], float inv, bf16_t* orow, int lane) {
    const int h = lane >> 5;
#pragma unroll
    for (int c = 0; c < 4; ++c)
#pragma unroll
        for (int i = 0; i < 4; ++i) { u32x2 w; w.x = cvtpk(o[c][4 * i] * inv, o[c][4 * i + 1] * inv); w.y = cvtpk(o[c][4 * i + 2] * inv, o[c][4 * i + 3] * inv);
            *(GAS u32x2*)(orow + 32 * c + 8 * i + 4 * h) = w; }
}
__device__ __forceinline__ void load_q(bf16x8 (&qf)[8], const bf16_t* qrow, int lane) {
    const GAS bf16x8* p = (const GAS bf16x8*)(qrow + 8 * (lane >> 5));
#pragma unroll
    for (int j = 0; j < 8; ++j) qf[j] = p[2 * j];
}

__device__ __forceinline__ void unit_moba(const Args& a, int lyr, bf16_t* Ob, int OP, int b, int hm, int qb, LAS unsigned char* lds, int tid, int lane, int wave) {
    asm volatile("" : "+v"(lane));
    const bf16_t* qkv = (const bf16_t*)(a.ws + WS_QKV);
    LAS float* lutL = (LAS float*)(lds + ATT_LUT_OFF); LAS float* kmL = (LAS float*)(lds + ATT_KM_OFF);
    { const float* lutG = (const float*)(a.ws + WS_LUT) + hm * 4096;
#pragma unroll
      for (int k_ = 0; k_ < 8; ++k_) lutL[tid + k_ * NTHR] = lutG[tid + k_ * NTHR];
      const float* kmG = (const float*)(a.ws + WS_KM) + (size_t)(b * 6 + hm) * 16 * 128;
#pragma unroll
      for (int k_ = 0; k_ < 4; ++k_) kmL[tid + k_ * NTHR] = kmG[tid + k_ * NTHR]; }
    __syncthreads();
    const int h = lane >> 5, t0 = qb * 256, tw = t0 + 32 * wave, t = tw + (lane & 31), hg = 4 + hm;
    const bf16_t* Kb = qkv + (size_t)b * SEQ * QKVP + 2048 + hg * 128; const bf16_t* Vb = Kb + 2048;
    bf16x8 qf[8]; load_q(qf, qkv + (size_t)(b * SEQ + t) * QKVP + hg * 128, lane);
    unsigned selmask = 0u, anymask = 0u;
    if (qb > 0) {
        float v1 = -3e38f, v2 = -3e38f, v3 = -3e38f; int i1 = -1, i2 = -1, i3 = -1;
        for (int n = 0; n < qb; ++n) {
            float g = 0.f;
#pragma unroll
            for (int j = 0; j < 8; ++j) { const LAS f32x4* kp = (const LAS f32x4*)(kmL + n * 128 + 16 * j + 8 * h); const f32x4 k0 = kp[0], k1 = kp[1];
                const u32x4 qw = __builtin_bit_cast(u32x4, qf[j]);
                g += pg8::bf_lo(qw.x) * k0[0] + pg8::bf_hi(qw.x) * k0[1] + pg8::bf_lo(qw.y) * k0[2] + pg8::bf_hi(qw.y) * k0[3]
                   + pg8::bf_lo(qw.z) * k1[0] + pg8::bf_hi(qw.z) * k1[1] + pg8::bf_lo(qw.w) * k1[2] + pg8::bf_hi(qw.w) * k1[3]; }
            g += __shfl_xor(g, 32);
            if (g > v1) { v3 = v2; i3 = i2; v2 = v1; i2 = i1; v1 = g; i1 = n; } else if (g > v2) { v3 = v2; i3 = i2; v2 = g; i2 = n; } else if (g > v3) { v3 = g; i3 = n; }
        }
        if (i1 >= 0) selmask |= 1u << i1; if (i2 >= 0) selmask |= 1u << i2; if (i3 >= 0) selmask |= 1u << i3;
        for (int n = 0; n < qb; ++n) if (__ballot((selmask >> n) & 1u) != 0ull) anymask |= 1u << n;
    }
    volatile LAS unsigned* misc = (volatile LAS unsigned*)(lds + MISC_OFF);
    if (tid == 0) misc[4] = 0u;
    __syncthreads();
    if (lane == 0 && anymask != 0u) __hip_atomic_fetch_or((LAS unsigned*)(lds + MISC_OFF + 16), anymask, __ATOMIC_RELAXED, __HIP_MEMORY_SCOPE_WORKGROUP);
    __syncthreads();
    const unsigned anywg = misc[4];
    const float nref = -softmax_ref(a, lyr, hm, qf, lane);
    float l = 0.f; f32x16 o[4];
#pragma unroll
    for (int c = 0; c < 4; ++c) o[c] = (f32x16){0.f, 0.f, 0.f, 0.f, 0.f, 0.f, 0.f, 0.f, 0.f, 0.f, 0.f, 0.f, 0.f, 0.f, 0.f, 0.f};
    const int srow = 8 * (wave >> 1) + ((lane >> 2) & 7), sch = 4 * (2 * (wave & 1) + (lane >> 5)) + ((lane & 3) ^ ((srow >> 2) & 3));
    const bf16_t* kg = Kb + (size_t)srow * QKVP + sch * 8; const bf16_t* vg = Vb + (size_t)srow * QKVP + sch * 8;
    const int r31 = lane & 31; const unsigned x0 = (r31 >> 2) & 1, x1 = (r31 >> 3) & 1;
    const unsigned kb_l = 2048u * (r31 >> 3) + 64u * (r31 & 7) + 16u * ((unsigned)h ^ x0);
    const unsigned ke0 = kb_l + 32u * x1, ke1 = kb_l + 32u * (x1 ^ 1u);
#define MOBA_STAGE(buf, nblk, stp) do { const size_t ro_ = (size_t)(256 * (nblk) + 64 * (stp)) * QKVP; LAS unsigned char* d_ = lds + ATT_V_OFF + (buf) * 32768 + wave * 1024; \
        __builtin_amdgcn_global_load_lds((const unsigned*)(kg + ro_), (LAS unsigned*)(d_), 16, 0, 0); \
        __builtin_amdgcn_global_load_lds((const unsigned*)(kg + ro_ + 32 * QKVP), (LAS unsigned*)(d_ + 8192), 16, 0, 0); \
        __builtin_amdgcn_global_load_lds((const unsigned*)(vg + ro_), (LAS unsigned*)(d_ + 16384), 16, 0, 0); \
        __builtin_amdgcn_global_load_lds((const unsigned*)(vg + ro_ + 32 * QKVP), (LAS unsigned*)(d_ + 24576), 16, 0, 0); } while (0)
    int n = qb, st = 3;
    MOBA_STAGE(0, n, st);
    asm volatile("s_waitcnt vmcnt(0)" ::: "memory");
    __syncthreads();
    int cur = 0;
    for (;;) {
        int nn = n, nst = st; bool has_next = true;
        if (n == qb) { if (st > 0) nst = st - 1; else { if (anywg == 0u) has_next = false; else { nn = __builtin_ctz(anywg); nst = 0; } } }
        else { if (st < 3) nst = st + 1; else { const unsigned rest = anywg & ~((2u << n) - 1u); if (rest == 0u) has_next = false; else { nn = __builtin_ctz(rest); nst = 0; } } }
        if (has_next) MOBA_STAGE(cur ^ 1, nn, nst);
        const bool own = (n == qb);
        const bool active = own ? (2 * st <= wave) : (((anymask >> (n & 31)) & 1u) != 0u);
        if (active) {
            LAS unsigned char* kl = lds + ATT_V_OFF + cur * 32768;
            const int dbase = t - (256 * n + 64 * st);
            const float lanebias = own ? nref : (((selmask >> (n & 31)) & 1u) ? nref : NEG);
            bf16x8 PA0, PA1, PB0, PB1;
#pragma unroll
            for (int tt = 0; tt < 2; ++tt) {
                bf16x8 kc[8];
#pragma unroll
                for (int s = 0; s < 8; ++s) kc[s] = *(const LAS bf16x8*)(kl + 8192 * tt + ((s & 1) ? ke1 : ke0) + 512 * (s >> 1));
                asm volatile("s_waitcnt lgkmcnt(0)" ::: "memory"); __builtin_amdgcn_sched_barrier(0);
                const f32x16 sacc = qk(kc, qf);
                const int db = dbase - 32 * tt;
                float x[16];
                if (own) {
#pragma unroll
                    for (int r = 0; r < 16; ++r) { const int dist = db - (8 * (r >> 2) + 4 * h + (r & 3)); const float lvv = lutL[dist < 0 ? 0 : dist];
                        const float xx = __builtin_fmaf(sacc[r], C1, lvv) + nref; x[r] = (dist >= 0) ? xx : NEG; }
                } else {
                    const LAS float* lp = lutL + (db - 4 * h);
#pragma unroll
                    for (int r = 0; r < 16; ++r) x[r] = __builtin_fmaf(sacc[r], C1, lp[-(8 * (r >> 2) + (r & 3))]) + lanebias;
                }
                if (tt == 0) softmax_fixed(x, l, PA0, PA1); else softmax_fixed(x, l, PB0, PB1);
            }
            pv(o, kl + 16384, PA0, PA1, lane);
            pv(o, kl + 24576, PB0, PB1, lane);
        }
        if (!has_next) break;
        asm volatile("s_waitcnt vmcnt(0)" ::: "memory");
        __syncthreads();
        n = nn; st = nst; cur ^= 1;
    }
#undef MOBA_STAGE
    l += __shfl_xor(l, 32);
    store_o(o, 1.0f / l, Ob + (size_t)(b * SEQ + t) * OP + hg * 128, lane);
}

__device__ __forceinline__ void dil_desc(int idx, int tb, int c4, int i, int& s0, int& stride, int& delta0, int& pat, int& aa) {
    if (idx < 5) { const int kt = 4 - idx; stride = 4; s0 = tb + c4 + 4 * (-128 + 32 * kt); delta0 = i + 128 - 32 * kt; pat = 0; aa = 0; }
    else if (idx < 13) { const int kt = idx - 5; stride = 1; s0 = tb - 128 + 32 * kt; delta0 = c4 + 4 * i + 128 - 32 * kt; pat = 1; aa = 0; }
    else { aa = (idx - 13) / 5; const int kt = (idx - 13) % 5; stride = 16; s0 = tb + c4 + 4 * aa + 16 * (-128 + 32 * kt); delta0 = (i >> 2) + 128 - 32 * kt; pat = 2; }
}
__device__ __forceinline__ void unit_dilated(const Args& a, int lyr, bf16_t* Ob, int OP, int b, int hd, int qb, LAS unsigned char* lds, int tid, int lane, int wave) {
    asm volatile("" : "+v"(lane));
    const bf16_t* qkv = (const bf16_t*)(a.ws + WS_QKV);
    LAS float* lut3 = (LAS float*)(lds + ATT_LUT_OFF);
    { const float* lutG = (const float*)(a.ws + WS_LUT) + (6 + hd) * 4096;

#pragma unroll
      for (int k_ = 0; k_ < 3; ++k_) { const int e = tid + k_ * NTHR; if (e >= 3 * 384) break; const int p = e / 384, d = e % 384 - 128; const int st = p == 0 ? 4 : (p == 1 ? 1 : 16); lut3[e] = (d >= 0 && d <= 128) ? lutG[st * d] : 0.f; } }
    __syncthreads();
    LAS unsigned char* vl = lds + ATT_V_OFF + wave * 8192;
    const int h = lane >> 5, i = lane & 31, t0 = qb * 256, tb = t0 + 128 * (wave >> 2), c4 = wave & 3, t = tb + c4 + 4 * i, hg = 10 + hd;
    const bf16_t* Kb = qkv + (size_t)b * SEQ * QKVP + 2048 + hg * 128; const bf16_t* Vb = Kb + 2048;
    bf16x8 qf[8]; load_q(qf, qkv + (size_t)(b * SEQ + t) * QKVP + hg * 128, lane);
    const float nref = -softmax_ref(a, lyr, 6 + hd, qf, lane);
    const unsigned dmax4 = (unsigned)((t >> 2) < 128 ? (t >> 2) : 128), dmax1 = (unsigned)(t < 128 ? t : 128), dmax16 = (unsigned)((t >> 4) < 128 ? (t >> 4) : 128);
    float l = 0.f; f32x16 o[4];
#pragma unroll
    for (int c = 0; c < 4; ++c) o[c] = (f32x16){0.f, 0.f, 0.f, 0.f, 0.f, 0.f, 0.f, 0.f, 0.f, 0.f, 0.f, 0.f, 0.f, 0.f, 0.f, 0.f};
    bf16x8 kc[8]; u32x4 vr[8];
    int s0, stride, delta0, pat, aa;
    dil_desc(0, tb, c4, i, s0, stride, delta0, pat, aa);
    load_k(kc, Kb, s0, stride, lane); load_v(vr, Vb, s0, stride, lane);
    for (int idx = 0; idx < 33; ++idx) {
        const f32x16 sacc = qk(kc, qf);
        stage_v(vl, vr, lane);
        int s0n = 0, stn = 1, d0n = 0, patn = 0, aan = 0;
        if (idx + 1 < 33) { dil_desc(idx + 1, tb, c4, i, s0n, stn, d0n, patn, aan); load_k(kc, Kb, s0n, stn, lane); }
        const unsigned dmax = pat == 0 ? dmax4 : (pat == 1 ? dmax1 : dmax16);
        const float lb = (pat == 2 && (i & 3) != aa) ? NEG : nref;
        const int dk = delta0 - 4 * h;
        const LAS float* lp = lut3 + pat * 384 + 128 + dk;
        float x[16];
#pragma unroll
        for (int r = 0; r < 16; ++r) { const float lvv = lp[-(8 * (r >> 2) + (r & 3))]; const float xx = __builtin_fmaf(sacc[r], C1, lvv) + lb;
            const unsigned delta = (unsigned)(dk - (8 * (r >> 2) + (r & 3))); x[r] = (delta <= dmax) ? xx : NEG; }
        bf16x8 P0, P1; softmax_fixed(x, l, P0, P1);
        if (idx + 1 < 33) load_v(vr, Vb, s0n, stn, lane);
        pv(o, vl, P0, P1, lane);
        s0 = s0n; stride = stn; delta0 = d0n; pat = patn; aa = aan;
    }
    l += __shfl_xor(l, 32);
    store_o(o, 1.0f / l, Ob + (size_t)(b * SEQ + t) * OP + hg * 128, lane);
}

__device__ __forceinline__ void unit_sb(const Args& a, bf16_t* Ob, int OP, int b, int ha, int qb, LAS unsigned char* lds, int tid, int lane, int wave) {
    asm volatile("" : "+v"(lane));
    const bf16_t* qkv = (const bf16_t*)(a.ws + WS_QKV);
    LAS unsigned char* vl = lds + ATT_V_OFF + wave * 8192;
    const int h = lane >> 5, t0 = qb * 256, tw = t0 + 32 * wave, t = tw + (lane & 31);
    const bf16_t* Kb = qkv + (size_t)b * SEQ * QKVP + 2048 + ha * 128; const bf16_t* Vb = Kb + 2048;
    bf16x8 qf[8]; load_q(qf, qkv + (size_t)(b * SEQ + t) * QKVP + ha * 128, lane);
    f32x16 o[4];
#pragma unroll
    for (int c = 0; c < 4; ++c) o[c] = (f32x16){0.f, 0.f, 0.f, 0.f, 0.f, 0.f, 0.f, 0.f, 0.f, 0.f, 0.f, 0.f, 0.f, 0.f, 0.f, 0.f};
    float R = 0.f;
    for (int kt = tw >> 5; kt >= 0; --kt) {
        f32x16 sacc;
        { bf16x8 kc[8]; load_k(kc, Kb, 32 * kt, 1, lane); sacc = qk(kc, qf); }
        { u32x4 vr[8]; load_v(vr, Vb, 32 * kt, 1, lane); stage_v(vl, vr, lane); }
        const int dbase = t - 32 * kt;
        float lb[16], g[4], gp[4];
#pragma unroll
        for (int i = 0; i < 4; ++i) { g[i] = 0.f;
#pragma unroll
            for (int j = 0; j < 4; ++j) { const int r = 4 * i + j; const int kap = 8 * i + 4 * h + j; const bool past = kap < dbase;
                const float z = sacc[r] * SCALE; const float sp = __logf(1.0f + __expf(-fabsf(z)));
                lb[r] = fminf(z, 0.f) - sp; g[i] += past ? (lb[r] - z) : 0.f; }
            gp[i] = __shfl_xor(g[i], 32); }
        float sg[4]; sg[3] = 0.f; sg[2] = g[3] + gp[3]; sg[1] = sg[2] + g[2] + gp[2]; sg[0] = sg[1] + g[1] + gp[1];
        const float tot = sg[0] + g[0] + gp[0];
#pragma unroll
        for (int i = 0; i < 4; ++i) { const float basei = sg[i] + R + (h == 0 ? gp[i] : 0.f);
            float suf = 0.f;
#pragma unroll
            for (int j = 3; j >= 0; --j) { const int r = 4 * i + j; const int kap = 8 * i + 4 * h + j; const bool past = kap < dbase;
                const float l1 = past ? (lb[r] - sacc[r] * SCALE) : 0.f;
                lb[r] = past ? __expf(lb[r] + suf + basei) : 0.f; suf += l1; } }
        R += tot;
        bf16x8 P0, P1; pack_p(lb, P0, P1);
        pv(o, vl, P0, P1, lane);
        if (__all(R < -110.0f)) break;
    }
    store_o(o, 1.0f, Ob + (size_t)(b * SEQ + t) * OP + ha * 128, lane);
}

__device__ __forceinline__ void phase_attention(const Args& a, int l, int rep, LAS unsigned char* lds, int tid, int lane, int wave) {
    unsigned* ctr0 = (unsigned*)(a.ws + WS_CTR) + (l + 2 * rep) * 64;
    bf16_t* Ob = l == 0 ? (bf16_t*)a.out : (bf16_t*)(a.ws + WS_QKV); const int OP = l == 0 ? DM : QKVP;
    volatile LAS unsigned* misc = (volatile LAS unsigned*)(lds + MISC_OFF);
    int xq = (int)((unsigned)__builtin_amdgcn_s_getreg((3 << 11) | 20) & 7u), left = 8;
    for (;;) {
        __syncthreads();
        if (tid == 0) misc[0] = atomicAdd(ctr0 + xq * 8, 1u);
        __syncthreads();
        const int j = (int)misc[0];
        if (j >= 128) { if (--left == 0) break; xq = (xq + 1) & 7; continue; }
        if (j < 48) { const int qb = 15 - j / 3, bh = 3 * xq + j % 3; unit_moba(a, l, Ob, OP, bh / 6, bh % 6, qb, lds, tid, lane, wave); }
        else if (j < 96) { const int jj = j - 48, qb = jj % 16, bh = 3 * xq + jj / 16; unit_dilated(a, l, Ob, OP, bh / 6, bh % 6, qb, lds, tid, lane, wave); }
        else { const int jj = j - 96, qb = 15 - jj / 2, bh = 2 * xq + jj % 2; unit_sb(a, Ob, OP, bh / 4, bh % 4, qb, lds, tid, lane, wave); }
    }
}
}

__device__ __forceinline__ void grid_barrier(unsigned* bar, unsigned k) {
    asm volatile("s_waitcnt vmcnt(0) lgkmcnt(0)" ::: "memory");
    __syncthreads();
    if (threadIdx.x == 0) {
        const unsigned G = gridDim.x, g = blockIdx.x & 7u, nloc = (G - g + 7u) >> 3, ngrp = G < 8u ? G : 8u;
        __builtin_amdgcn_fence(__ATOMIC_RELEASE, "agent");
        asm volatile("s_waitcnt vmcnt(0)" ::: "memory");
        const unsigned old = __hip_atomic_fetch_add(bar + 64 * g, 1u, __ATOMIC_RELAXED, __HIP_MEMORY_SCOPE_AGENT);
        if (old + 1u == nloc * k) __hip_atomic_fetch_add(bar + 512, 1u, __ATOMIC_RELAXED, __HIP_MEMORY_SCOPE_AGENT);
        unsigned spins = 0;
        while (__hip_atomic_load(bar + 512, __ATOMIC_RELAXED, __HIP_MEMORY_SCOPE_AGENT) < ngrp * k) { __builtin_amdgcn_s_sleep(2); if (++spins > (1u << 24)) break; }
        __builtin_amdgcn_fence(__ATOMIC_ACQUIRE, "agent");
        asm volatile("s_waitcnt vmcnt(0)" ::: "memory");
    }
    __syncthreads();
}

__global__ void __launch_bounds__(NTHR, 2) hybrid_fwd(Args a_) {
    __shared__ __attribute__((aligned(16))) unsigned char lds_raw[LDS_BYTES];
    LAS unsigned char* lds = (LAS unsigned char*)lds_raw;
    const int ph_lo = a_.ph_lo, ph_hi = a_.ph_hi;
    for (int ph = ph_lo; ph < ph_hi; ++ph) {
        {
        constexpr int rep = 0;
        int tid = threadIdx.x; asm volatile("" : "+v"(tid));
        const int lane = tid & 63, wave = __builtin_amdgcn_readfirstlane(tid >> 6);
        const __attribute__((address_space(4))) Args* ap = (const __attribute__((address_space(4))) Args*)__builtin_amdgcn_kernarg_segment_ptr(); asm volatile("" : "+s"(ap));
        Args a; a.x = ap->x; a.g_mix = ap->g_mix; a.w_in = ap->w_in; a.q_gain = ap->q_gain; a.k_gain = ap->k_gain; a.w_branch = ap->w_branch; a.w_out = ap->w_out;
        a.g_ffn = ap->g_ffn; a.w_gu = ap->w_gu; a.w_down = ap->w_down; a.rel_bias = ap->rel_bias; a.out = ap->out; a.ws = ap->ws; a.ph_lo = 0; a.ph_hi = 0;
        unsigned char* ws = a.ws;
        const int G = gridDim.x, cidx = blockIdx.x;
        float* ss = (float*)(ws + WS_SS);
        bf16_t* xb = (bf16_t*)(ws + WS_XB); bf16_t* qkv = (bf16_t*)(ws + WS_QKV); bf16_t* gates = (bf16_t*)(ws + WS_GATES);
        bf16_t* ob = qkv; bf16_t* merged = qkv + 2048; bf16_t* act = qkv;
        if (ph == 0) phase_prologue(a, lds, tid, lane, wave);
        else {
            const int l = (ph - 1) / 7, k = (ph - 1) % 7;
            if (k == 0) {
                pg8::Gemm g{xb, (const bf16_t*)(ws + WS_WIN) + (size_t)l * NIN * DM, DM, DM, M, NIN, DM}; pg8::StaticOrder S; S.init(M, NIN, G, cidx);
                pg8::EpiIn E{qkv, gates, ss + (size_t)(2 * l) * M};
                pg8::gemm_phase<pg8::EpiIn, pg8::StaticOrder>(lds, g, S, E, tid);
            } else if (k == 1) phase_qknorm(a, l, lds, tid, lane, wave);
            else if (k == 2) att::phase_attention(a, l, rep, lds, tid, lane, wave);
            else if (k == 3) {
                const bf16_t* wbt = (const bf16_t*)(ws + WS_WBR) + (size_t)l * DM * DM;
                for (int br = 0; br < 3; ++br) {
                    const int k0 = br == 0 ? 0 : (br == 1 ? 512 : 1280), kl = br == 0 ? 512 : 768;
                    pg8::Gemm g{(l == 0 ? (const bf16_t*)a.out : ob) + k0, wbt + k0, l == 0 ? DM : QKVP, DM, M, DM, kl}; pg8::StaticOrder S; S.init(M, DM, G, cidx);
                    pg8::EpiBranch E{merged, gates, br * 2048, br == 0 ? 1 : 0};
                    pg8::gemm_phase<pg8::EpiBranch, pg8::StaticOrder>(lds, g, S, E, tid);
                }
            } else if (k == 4 || k == 6) {
                const bool dn = (k == 6);
                pg8::Gemm g{dn ? act : merged, dn ? (const bf16_t*)(ws + WS_WDN) + (size_t)l * DM * DFF : (const bf16_t*)(ws + WS_WOUT) + (size_t)l * DM * DM,
                            dn ? DFF : QKVP, dn ? DFF : DM, M, DM, dn ? DFF : DM};
                pg8::StaticOrder S; S.init(M, DM, G, cidx);
                const float* base = (l == 0 && !dn) ? a.x : a.out;
                const bool lastp = dn && (l == 1);
                pg8::EpiResid E{base, a.out, lastp ? nullptr : xb, lastp ? nullptr : ss + (size_t)(2 * l + (dn ? 2 : 1)) * M};
                pg8::gemm_phase<pg8::EpiResid, pg8::StaticOrder>(lds, g, S, E, tid);
            } else {
                pg8::Gemm g{xb, (const bf16_t*)(ws + WS_WGU) + (size_t)l * NGU * DM, DM, DM, M, NGU, DM}; pg8::StaticOrder S; S.init(M, NGU, G, cidx);
                pg8::EpiGU E{act, ss + (size_t)(2 * l + 1) * M};
                pg8::gemm_phase<pg8::EpiGU, pg8::StaticOrder>(lds, g, S, E, tid);
            }
        }
        }
        if (ph + 1 < ph_hi) {
            if (ph == ph_lo) cg::this_grid().sync();
            else grid_barrier((unsigned*)(a_.ws + WS_CTR) + 256, (unsigned)(ph - ph_lo));
        }
    }
}

__global__ void fill_const(float* o, int n, float v) { for (int i = blockIdx.x * blockDim.x + threadIdx.x; i < n; i += gridDim.x * blockDim.x) o[i] = v; }
extern "C" void kernel_launch(void* const* d_in, const int* in_sizes, int n_in, void* d_out, int out_size, void* d_ws, size_t ws_size, hipStream_t stream) {
    static int grid = 0;
    if (grid == 0) {
        if (n_in != 11 || in_sizes[0] != M * DM || out_size != M * DM || ws_size < WS_END) { fprintf(stderr, "kernel_launch: unexpected shapes / workspace (n_in %d, ws %zu); nothing launched\n", n_in, ws_size); grid = -1; return; }
        int dev = 0, cus = 0, per_cu = 0;
        if (hipGetDevice(&dev) != hipSuccess || hipDeviceGetAttribute(&cus, hipDeviceAttributeMultiprocessorCount, dev) != hipSuccess || cus < 1) cus = 256;
        if (hipOccupancyMaxActiveBlocksPerMultiprocessor(&per_cu, hybrid_fwd, NTHR, 0) != hipSuccess || per_cu < 1) per_cu = 1;
        (void)hipGetLastError();
        grid = cus * per_cu;
    }
    if (grid < 0) return;
    Args a{};
    a.x = (const float*)d_in[0]; a.g_mix = (const float*)d_in[1]; a.w_in = (const float*)d_in[2]; a.q_gain = (const float*)d_in[3]; a.k_gain = (const float*)d_in[4];
    a.w_branch = (const float*)d_in[5]; a.w_out = (const float*)d_in[6]; a.g_ffn = (const float*)d_in[7]; a.w_gu = (const float*)d_in[8]; a.w_down = (const float*)d_in[9];
    a.rel_bias = (const float*)d_in[10]; a.out = (float*)d_out; a.ws = (unsigned char*)d_ws;
#if MK_COOP
    a.ph_lo = 0; a.ph_hi = MK_PH_END;
    void* args[] = {&a};
    hipError_t e = hipLaunchCooperativeKernel((void*)hybrid_fwd, dim3(grid), dim3(NTHR), args, 0, stream);
    if (e != hipSuccess) fprintf(stderr, "kernel_launch: cooperative launch failed: %s (grid %d)\n", hipGetErrorString(e), grid);
#else
    for (int ph = 0; ph < MK_PH_END; ++ph) { a.ph_lo = ph; a.ph_hi = ph + 1; hipLaunchKernelGGL(hybrid_fwd, dim3(grid), dim3(NTHR), 0, stream, a); }
#endif
}
```

```cpp
#include <hip/hip_runtime.h>
#include <hip/hip_cooperative_groups.h>
#include <cstdio>
#include <cstdint>
namespace cg = cooperative_groups;

#ifndef MK_DUP_PRO
#define MK_DUP_PRO 1
#define MK_DUP_BIG 1
#define MK_DUP_BR 1
#define MK_DUP_ATT 1
#define MK_DUP_SYNC 1
#endif
#ifndef MK_PH_END
#define MK_PH_END 15
#endif
#ifndef MK_COOP
#define MK_COOP 1
#endif

namespace pg8 {
#define PG8_LAS __attribute__((address_space(3)))
typedef unsigned short bf16_t;
typedef short bf16x8 __attribute__((ext_vector_type(8)));
typedef float f32x4 __attribute__((ext_vector_type(4)));
typedef unsigned u32x4 __attribute__((ext_vector_type(4)));
typedef unsigned u32x2 __attribute__((ext_vector_type(2)));
constexpr int BM = 256, BK = 64, HALF = 128, HTB = HALF * BK * 2, STAGE_BYTES = 8 * HTB, NXCD = 8, WGM = 8;

__host__ __device__ __forceinline__ int lds_byte(int r, int c) { const int st = (r >> 4) * 2 + (c >> 5), rr = r & 15, cc = c & 31, ob = rr * 64 + cc * 2; return st * 1024 + (ob ^ (((ob >> 9) & 1) << 5)); }
__host__ __device__ __forceinline__ void stage_rc(int b, int& R, int& C) { const int st = b / 1024, sb = b % 1024, swz = sb ^ (((sb >> 9) & 1) << 5); R = (st >> 1) * 16 + swz / 64; C = (st & 1) * 32 + (swz % 64) / 2; }
__host__ __device__ __forceinline__ int perm32(int rho) { const int n = rho >> 4, i = rho & 15; return 8 * (i >> 2) + 4 * n + (i & 3); }

struct Unit { int pm, pn; };
struct Gemm { const bf16_t* A; const bf16_t* Bt; int lda, ldb, M, N, K; };

struct StaticOrder {
    int nM, nN, nwg, G, c;
    __host__ __device__ void init(int M, int N, int G_, int c_) { nM = M / BM; nN = N / BM; nwg = nM * nN; G = G_; c = c_; }
    __host__ __device__ bool next(int i, Unit& u) const {
        const int L = i * G + c; if (L >= nwg) return false;
        int wgid = L; { const int q = nwg / NXCD, r = nwg % NXCD, xcd = wgid % NXCD, off = wgid / NXCD; wgid = (xcd < r ? xcd * (q + 1) : r * (q + 1) + (xcd - r) * q) + off; }
        const int nig = WGM * nN, gid = wgid / nig, fm = gid * WGM, gsz = (nM - fm) < WGM ? (nM - fm) : WGM;
        u.pm = fm + ((wgid % nig) % gsz); u.pn = (wgid % nig) / gsz; return true;
    }
};

typedef float f32x2c_t __attribute__((ext_vector_type(2))); typedef __bf16 bf16x2c_t __attribute__((ext_vector_type(2)));
__device__ __forceinline__ unsigned cvt_pk_bf16(float lo, float hi) { f32x2c_t v = {lo, hi}; bf16x2c_t b = __builtin_convertvector(v, bf16x2c_t); return __builtin_bit_cast(unsigned, b); }
__device__ __forceinline__ float bf_lo(unsigned w) { return __uint_as_float(w << 16); }
__device__ __forceinline__ float bf_hi(unsigned w) { return __uint_as_float(w & 0xffff0000u); }
__device__ __forceinline__ float sigmoidf_(float v) { return __builtin_amdgcn_rcpf(1.0f + __builtin_amdgcn_exp2f(v * -1.4426950408889634f)); }


struct EpiIn {
    static constexpr bool PERM = true;
    bf16_t* qkv; bf16_t* gates; const float* ss; const float* qg; const float* kg; float* kmean; PG8_LAS unsigned char* xl;
    __device__ __forceinline__ void operator()(const f32x4 (&acc)[2][2][4][2], const Unit& u, int wr, int wc, int fr, int fq) const {
        const int row0 = u.pm * BM + wr * 64 + fr; const bool isg = u.pn >= 24;
        bf16_t* base = isg ? gates : qkv; const int col0 = (isg ? u.pn - 24 : u.pn) * BM + wc * 32 + 8 * fq;
        float rsv[2][4];
#pragma unroll
        for (int ai = 0; ai < 2; ++ai)
#pragma unroll
            for (int m = 0; m < 4; ++m) rsv[ai][m] = ss[row0 + ai * HALF + m * 16];
#pragma unroll
        for (int ai = 0; ai < 2; ++ai)
#pragma unroll
            for (int m = 0; m < 4; ++m) rsv[ai][m] = rsqrtf(rsv[ai][m] * (1.0f / 2048.0f) + 1e-6f);
        const int sec = u.pn >> 3, hp = u.pn & 7; const bool soft = (u.pn < 16) && (hp >= 2);
        if (!soft) {
#pragma unroll
            for (int ai = 0; ai < 2; ++ai)
#pragma unroll
                for (int m = 0; m < 4; ++m) { const int row = row0 + ai * HALF + m * 16; const float rs = rsv[ai][m];
                    bf16_t* rowp = base + (size_t)row * 6144 + col0;
#pragma unroll
                    for (int bj = 0; bj < 2; ++bj) { f32x4 v0 = acc[ai][bj][m][0] * rs, v1 = acc[ai][bj][m][1] * rs;
                        if (isg) { v0 = (f32x4){sigmoidf_(v0[0]), sigmoidf_(v0[1]), sigmoidf_(v0[2]), sigmoidf_(v0[3])}; v1 = (f32x4){sigmoidf_(v1[0]), sigmoidf_(v1[1]), sigmoidf_(v1[2]), sigmoidf_(v1[3])}; }
                        u32x4 w; w.x = cvt_pk_bf16(v0[0], v0[1]); w.y = cvt_pk_bf16(v0[2], v0[3]); w.z = cvt_pk_bf16(v1[0], v1[1]); w.w = cvt_pk_bf16(v1[2], v1[3]);
                        *(u32x4*)(rowp + bj * HALF) = w; } }
            return;
        }
        PG8_LAS float* part = (PG8_LAS float*)xl; PG8_LAS float* colsum = (PG8_LAS float*)(xl + 8192);
#pragma unroll
        for (int ai = 0; ai < 2; ++ai)
#pragma unroll
            for (int m = 0; m < 4; ++m)
#pragma unroll
                for (int bj = 0; bj < 2; ++bj) { const f32x4 a0 = acc[ai][bj][m][0] * rsv[ai][m], a1 = acc[ai][bj][m][1] * rsv[ai][m];
                    float s = (a0[0] * a0[0] + a0[1] * a0[1]) + (a0[2] * a0[2] + a0[3] * a0[3]) + (a1[0] * a1[0] + a1[1] * a1[1]) + (a1[2] * a1[2] + a1[3] * a1[3]);
                    s += __shfl_xor(s, 16); s += __shfl_xor(s, 32);
                    if (fq == 0) part[((ai * HALF + wr * 64 + m * 16 + fr) * 2 + bj) * 4 + wc] = s; }
        asm volatile("s_waitcnt lgkmcnt(0)" ::: "memory"); __builtin_amdgcn_s_barrier(); asm volatile("" ::: "memory");
        const bool km = (sec == 1) && (hp <= 4);
        const float* gbase = (sec ? kg : qg) + (2 * hp - 4) * 128 + wc * 32 + 8 * fq;
        float gn[2][8], cs[2][8];
#pragma unroll
        for (int bj = 0; bj < 2; ++bj)
#pragma unroll
            for (int e = 0; e < 8; ++e) { gn[bj][e] = gbase[bj * 128 + e]; cs[bj][e] = 0.f; }
#pragma unroll
        for (int ai = 0; ai < 2; ++ai)
#pragma unroll
            for (int m = 0; m < 4; ++m) { const int rl = ai * HALF + wr * 64 + m * 16 + fr; bf16_t* rowp = base + (size_t)(u.pm * BM + rl) * 6144 + col0;
#pragma unroll
                for (int bj = 0; bj < 2; ++bj) { const f32x4 p = *(const PG8_LAS f32x4*)(part + (rl * 2 + bj) * 4);
                    const float sc = rsv[ai][m] * rsqrtf(((p[0] + p[1]) + (p[2] + p[3])) * (1.0f / 128.0f) + 1e-6f);
                    float r[8];
#pragma unroll
                    for (int e = 0; e < 4; ++e) { r[e] = acc[ai][bj][m][0][e] * sc * gn[bj][e]; r[4 + e] = acc[ai][bj][m][1][e] * sc * gn[bj][4 + e]; }
#pragma unroll
                    for (int e = 0; e < 8; ++e) cs[bj][e] += r[e];
                    u32x4 w; w.x = cvt_pk_bf16(r[0], r[1]); w.y = cvt_pk_bf16(r[2], r[3]); w.z = cvt_pk_bf16(r[4], r[5]); w.w = cvt_pk_bf16(r[6], r[7]);
                    *(u32x4*)(rowp + bj * HALF) = w; } }
        if (km) {
#pragma unroll
            for (int bj = 0; bj < 2; ++bj)
#pragma unroll
                for (int e = 0; e < 8; ++e) { float c = cs[bj][e]; c += __shfl_xor(c, 1); c += __shfl_xor(c, 2); c += __shfl_xor(c, 4); c += __shfl_xor(c, 8);
                    if (fr == 0) colsum[wr * 256 + bj * 128 + wc * 32 + 8 * fq + e] = c; }
            asm volatile("s_waitcnt lgkmcnt(0)" ::: "memory"); __builtin_amdgcn_s_barrier(); asm volatile("" ::: "memory");
            if (wr == 0) { const int c = wc * 64 + fq * 16 + fr;
                const int hs = 2 * hp - 4 + (c >> 7);
                kmean[((size_t)((u.pm >> 4) * 6 + hs) * 16 + (u.pm & 15)) * 128 + (c & 127)] = (colsum[c] + colsum[256 + c]) * (1.0f / 256.0f); }
        }
    }
};
struct EpiGU {
    static constexpr bool PERM = true;
    bf16_t* act; const float* ss;
    __device__ __forceinline__ void operator()(const f32x4 (&acc)[2][2][4][2], const Unit& u, int wr, int wc, int fr, int fq) const {
        const int row0 = u.pm * BM + wr * 64 + fr; const int col0 = u.pn * HALF + wc * 32 + 8 * fq;
        float ssv[2][4];
#pragma unroll
        for (int ai = 0; ai < 2; ++ai)
#pragma unroll
            for (int m = 0; m < 4; ++m) ssv[ai][m] = ss[row0 + ai * HALF + m * 16];
#pragma unroll
        for (int ai = 0; ai < 2; ++ai)
#pragma unroll
            for (int m = 0; m < 4; ++m) { const int row = row0 + ai * HALF + m * 16; const float rs = rsqrtf(ssv[ai][m] * (1.0f / 2048.0f) + 1e-6f);
                float r[8];
#pragma unroll
                for (int n = 0; n < 2; ++n)
#pragma unroll
                    for (int e = 0; e < 4; ++e) { const float g = acc[ai][0][m][n][e] * rs, up = acc[ai][1][m][n][e] * rs; r[n * 4 + e] = g * sigmoidf_(g) * up; }
                u32x4 w; w.x = cvt_pk_bf16(r[0], r[1]); w.y = cvt_pk_bf16(r[2], r[3]); w.z = cvt_pk_bf16(r[4], r[5]); w.w = cvt_pk_bf16(r[6], r[7]);
                *(u32x4*)(act + (size_t)row * 5632 + col0) = w; }
    }
};
struct EpiBranch {
    static constexpr bool PERM = true;
    bf16_t* merged; const bf16_t* gates; int gcol; int first;
    __device__ __forceinline__ void operator()(const f32x4 (&acc)[2][2][4][2], const Unit& u, int wr, int wc, int fr, int fq) const {
        const int row0 = u.pm * BM + wr * 64 + fr; const int col0 = u.pn * BM + wc * 32 + 8 * fq;
#pragma unroll
        for (int aq = 0; aq < 4; ++aq) { const int ai = aq >> 1, m0 = 2 * (aq & 1);
            u32x4 gw[2][2], pw[2][2];
#pragma unroll
            for (int mm = 0; mm < 2; ++mm)
#pragma unroll
                for (int bj = 0; bj < 2; ++bj) { const int row = row0 + ai * HALF + (m0 + mm) * 16, col = col0 + bj * HALF;
                    gw[mm][bj] = *(const u32x4*)(gates + (size_t)row * 6144 + gcol + col);
                    pw[mm][bj] = first ? (u32x4){0u, 0u, 0u, 0u} : *(const u32x4*)(merged + (size_t)row * 6144 + col); }
#pragma unroll
            for (int mm = 0; mm < 2; ++mm)
#pragma unroll
                for (int bj = 0; bj < 2; ++bj) { const int m = m0 + mm; const int row = row0 + ai * HALF + m * 16, col = col0 + bj * HALF;
                    const u32x4 g_ = gw[mm][bj], p_ = pw[mm][bj]; float r[8];
                    r[0] = bf_lo(g_.x) * acc[ai][bj][m][0][0] + bf_lo(p_.x); r[1] = bf_hi(g_.x) * acc[ai][bj][m][0][1] + bf_hi(p_.x);
                    r[2] = bf_lo(g_.y) * acc[ai][bj][m][0][2] + bf_lo(p_.y); r[3] = bf_hi(g_.y) * acc[ai][bj][m][0][3] + bf_hi(p_.y);
                    r[4] = bf_lo(g_.z) * acc[ai][bj][m][1][0] + bf_lo(p_.z); r[5] = bf_hi(g_.z) * acc[ai][bj][m][1][1] + bf_hi(p_.z);
                    r[6] = bf_lo(g_.w) * acc[ai][bj][m][1][2] + bf_lo(p_.w); r[7] = bf_hi(g_.w) * acc[ai][bj][m][1][3] + bf_hi(p_.w);
                    u32x4 w; w.x = cvt_pk_bf16(r[0], r[1]); w.y = cvt_pk_bf16(r[2], r[3]); w.z = cvt_pk_bf16(r[4], r[5]); w.w = cvt_pk_bf16(r[6], r[7]);
                    *(u32x4*)(merged + (size_t)row * 6144 + col) = w; }
            asm volatile("" ::: "memory");
        }
    }
};
struct EpiResid {
    static constexpr bool PERM = true;
    const float* base; float* out; bf16_t* xb; float* ss;
    __device__ __forceinline__ void operator()(const f32x4 (&acc)[2][2][4][2], const Unit& u, int wr, int wc, int fr, int fq) const {
        const int row0 = u.pm * BM + wr * 64 + fr; const int col0 = u.pn * BM + wc * 32 + 8 * fq;
#pragma unroll
        for (int aq = 0; aq < 4; ++aq) { const int ai = aq >> 1, m0 = 2 * (aq & 1);
            f32x4 bv[2][2][2];
#pragma unroll
            for (int mm = 0; mm < 2; ++mm)
#pragma unroll
                for (int bj = 0; bj < 2; ++bj) { const size_t off = (size_t)(row0 + ai * HALF + (m0 + mm) * 16) * 2048 + col0 + bj * HALF;
                    bv[mm][bj][0] = *(const f32x4*)(base + off); bv[mm][bj][1] = *(const f32x4*)(base + off + 4); }
#pragma unroll
            for (int mm = 0; mm < 2; ++mm) { const int m = m0 + mm; const int row = row0 + ai * HALF + m * 16; float sq = 0.f;
#pragma unroll
                for (int bj = 0; bj < 2; ++bj) { const size_t off = (size_t)row * 2048 + col0 + bj * HALF;
                    const f32x4 o0 = bv[mm][bj][0] + acc[ai][bj][m][0], o1 = bv[mm][bj][1] + acc[ai][bj][m][1];
                    *(f32x4*)(out + off) = o0; *(f32x4*)(out + off + 4) = o1;
                    sq += (o0[0] * o0[0] + o0[1] * o0[1]) + (o0[2] * o0[2] + o0[3] * o0[3]) + (o1[0] * o1[0] + o1[1] * o1[1]) + (o1[2] * o1[2] + o1[3] * o1[3]);
                    if (xb) { u32x4 w; w.x = cvt_pk_bf16(o0[0], o0[1]); w.y = cvt_pk_bf16(o0[2], o0[3]); w.z = cvt_pk_bf16(o1[0], o1[1]); w.w = cvt_pk_bf16(o1[2], o1[3]); *(u32x4*)(xb + off) = w; } }
                if (ss) { sq += __shfl_xor(sq, 16); sq += __shfl_xor(sq, 32); if (fq == 0) atomicAdd(ss + row, sq); } }
            asm volatile("" ::: "memory");
        }
    }
};

template <class Epi, class Sched>
__device__ __forceinline__ void gemm_phase(PG8_LAS unsigned char* lds, const Gemm g, const Sched& S, const Epi& E, const int tid) {
    const int wid = __builtin_amdgcn_readfirstlane(tid >> 6), lane = tid & 63, wr = wid >> 2, wc = wid & 3, fr = lane & 15, fq = lane >> 4;
    const int nt = g.K / BK;
    unsigned voffA[2], voffB[2];
#pragma unroll
    for (int i = 0; i < 2; ++i) { int R, C; stage_rc(tid * 16 + i * 8192, R, C); const int Rb = Epi::PERM ? ((R & ~31) + perm32(R & 31)) : R;
        voffA[i] = (unsigned)(R * g.lda + C) * 2u; voffB[i] = (unsigned)(Rb * g.ldb + C) * 2u; }
    const size_t kstep = (size_t)(BK * 2);
    const size_t hstepA = (size_t)HALF * g.lda * 2, hstepB = (size_t)HALF * g.ldb * 2;
    const size_t tstepA = 2 * hstepA, tstepB = 2 * hstepB;
    const unsigned ldsw = (unsigned)wid * 1024u;
    const int aoff = lds_byte(wr * 64 + fr, fq * 8), boff = lds_byte(wc * 32 + fr, fq * 8);
#define PG8_SA(b, h) (((b) * 2 + (h)) * HTB)
#define PG8_SB(b, h) ((4 + (b) * 2 + (h)) * HTB)
#define PG8_STAGE(bufoff, gbase, voff) do { _Pragma("unroll") for (int _i = 0; _i < 2; ++_i) \
        __builtin_amdgcn_global_load_lds((const unsigned*)((const char*)(gbase) + (voff)[_i]), (PG8_LAS unsigned*)(lds + (bufoff) + ldsw + _i * 8192), 16, 0, 0); } while (0)
#define PG8_LDA(dst, b, h) do { _Pragma("unroll") for (int m = 0; m < 4; ++m) _Pragma("unroll") for (int k = 0; k < 2; ++k) dst[m][k] = *(const PG8_LAS bf16x8*)(lds + PG8_SA(b, h) + aoff + m * 2048 + k * 1024); } while (0)
#define PG8_LDB(dst, b, h) do { _Pragma("unroll") for (int n = 0; n < 2; ++n) _Pragma("unroll") for (int k = 0; k < 2; ++k) dst[n][k] = *(const PG8_LAS bf16x8*)(lds + PG8_SB(b, h) + boff + n * 2048 + k * 1024); } while (0)
#define PG8_MMA(ai, bj, At, Bt) do { __builtin_amdgcn_s_setprio(1); _Pragma("unroll") for (int m = 0; m < 4; ++m) _Pragma("unroll") for (int n = 0; n < 2; ++n) _Pragma("unroll") for (int k = 0; k < 2; ++k) \
        acc[ai][bj][m][n] = __builtin_amdgcn_mfma_f32_16x16x32_bf16(Bt[n][k], At[m][k], acc[ai][bj][m][n], 0, 0, 0); __builtin_amdgcn_s_setprio(0); } while (0)
#define PG8_WAIT_V(n) asm volatile("s_waitcnt vmcnt(" #n ")" ::: "memory")
#define PG8_WAIT_L(n) asm volatile("s_waitcnt lgkmcnt(" #n ")" ::: "memory")
#define PG8_BAR __builtin_amdgcn_s_barrier()
#define PG8_SCHED __builtin_amdgcn_sched_barrier(0)
    Unit cur, nxt; int ui = 0;
    if (!S.next(0, cur)) return;
    f32x4 acc[2][2][4][2];
#pragma unroll
    for (int a = 0; a < 2; ++a)
#pragma unroll
        for (int b = 0; b < 2; ++b)
#pragma unroll
            for (int m = 0; m < 4; ++m)
#pragma unroll
                for (int n = 0; n < 2; ++n) acc[a][b][m][n] = (f32x4){0.f, 0.f, 0.f, 0.f};
    bf16x8 At[4][2], B0[2][2], B1[2][2];
    const char* cA = (const char*)g.A + (size_t)cur.pm * tstepA; const char* cB = (const char*)g.Bt + (size_t)cur.pn * tstepB;
    PG8_STAGE(PG8_SB(0, 0), cB, voffB); PG8_STAGE(PG8_SB(0, 1), cB + hstepB, voffB); PG8_STAGE(PG8_SA(0, 0), cA, voffA); PG8_STAGE(PG8_SA(0, 1), cA + hstepA, voffA);
    if (wr == 1) PG8_BAR;
    PG8_WAIT_V(2); PG8_BAR;
    PG8_STAGE(PG8_SB(1, 0), cB + kstep, voffB); PG8_STAGE(PG8_SA(1, 0), cA + kstep, voffA); PG8_STAGE(PG8_SB(1, 1), cB + hstepB + kstep, voffB);
    PG8_WAIT_V(6); PG8_BAR;
    for (;;) {
        const bool has_next = S.next(ui + 1, nxt);
        const char* nA = has_next ? (const char*)g.A + (size_t)nxt.pm * tstepA : cA; const char* nB = has_next ? (const char*)g.Bt + (size_t)nxt.pn * tstepB : cB;
        for (int t = 0; t < nt; t += 2) {
            const bool last = (t == nt - 2);
            const char* a1 = cA + (size_t)(t + 1) * kstep;
            const char* a2 = last ? nA : cA + (size_t)(t + 2) * kstep; const char* b2 = last ? nB : cB + (size_t)(t + 2) * kstep;
            const char* a3 = a2 + kstep; const char* b3 = b2 + kstep;
            PG8_LDB(B0, 0, 0); PG8_LDB(B1, 0, 1); PG8_SCHED; PG8_LDA(At, 0, 0); PG8_STAGE(PG8_SA(1, 1), a1 + hstepA, voffA);
            PG8_WAIT_V(8); PG8_WAIT_L(0); PG8_BAR; PG8_MMA(0, 0, At, B0); PG8_MMA(0, 1, At, B1); PG8_BAR; PG8_SCHED;
            PG8_LDA(At, 0, 1); PG8_STAGE(PG8_SB(0, 0), b2, voffB); PG8_STAGE(PG8_SB(0, 1), b2 + hstepB, voffB); PG8_STAGE(PG8_SA(0, 0), a2, voffA);
            PG8_WAIT_V(8); PG8_WAIT_L(0); PG8_BAR; PG8_MMA(1, 0, At, B0); PG8_MMA(1, 1, At, B1); PG8_BAR; PG8_SCHED;
            PG8_LDB(B0, 1, 0); PG8_LDB(B1, 1, 1); PG8_SCHED; PG8_LDA(At, 1, 0); PG8_STAGE(PG8_SA(0, 1), a2 + hstepA, voffA);
            PG8_WAIT_V(8); PG8_WAIT_L(0); PG8_BAR; PG8_MMA(0, 0, At, B0); PG8_MMA(0, 1, At, B1); PG8_BAR; PG8_SCHED;
            PG8_LDA(At, 1, 1); PG8_STAGE(PG8_SB(1, 0), b3, voffB); PG8_STAGE(PG8_SB(1, 1), b3 + hstepB, voffB); PG8_STAGE(PG8_SA(1, 0), a3, voffA);
            PG8_WAIT_V(8); PG8_WAIT_L(0); PG8_BAR; PG8_MMA(1, 0, At, B0); PG8_MMA(1, 1, At, B1); PG8_BAR; PG8_SCHED;
        }
        if (wr == 0) PG8_BAR;
        E(acc, cur, wr, wc, fr, fq);
        if (!has_next) break;
#pragma unroll
        for (int a = 0; a < 2; ++a)
#pragma unroll
            for (int b = 0; b < 2; ++b)
#pragma unroll
                for (int m = 0; m < 4; ++m)
#pragma unroll
                    for (int n = 0; n < 2; ++n) acc[a][b][m][n] = (f32x4){0.f, 0.f, 0.f, 0.f};
        cur = nxt; cA = nA; cB = nB; ++ui;
        if (wr == 1) PG8_BAR;
    }
    PG8_WAIT_V(0);
    PG8_BAR;
#undef PG8_SA
#undef PG8_SB
#undef PG8_STAGE
#undef PG8_LDA
#undef PG8_LDB
#undef PG8_MMA
#undef PG8_WAIT_V
#undef PG8_WAIT_L
#undef PG8_BAR
#undef PG8_SCHED
}
}

#define GAS __attribute__((address_space(1)))
#define LAS __attribute__((address_space(3)))
typedef unsigned short bf16_t;
typedef short bf16x8 __attribute__((ext_vector_type(8)));
typedef short s16x4 __attribute__((ext_vector_type(4)));
typedef float f32x4 __attribute__((ext_vector_type(4)));
typedef float f32x16 __attribute__((ext_vector_type(16)));
typedef unsigned u32x4 __attribute__((ext_vector_type(4)));
typedef unsigned u32x2 __attribute__((ext_vector_type(2)));

constexpr int DM = 2048, BATCH = 4, SEQ = 4096, M = BATCH * SEQ, DFF = 5632, NIN = 12288, NGU = 11264, QKVP = 6144;
constexpr int NWAVES = 8, NTHR = 512;
constexpr size_t MiB = 1u << 20;
constexpr size_t WS_CTR = 0, WS_SS = 64 * 1024, WS_LUT = 512 * 1024, WS_KM = 1 * MiB;
constexpr size_t WS_WIN = 4 * MiB, WS_WBR = 100 * MiB, WS_WOUT = 116 * MiB, WS_WGU = 132 * MiB, WS_WDN = 220 * MiB;
constexpr size_t WS_XB = 264 * MiB, WS_QKV = 328 * MiB, WS_GATES = 520 * MiB, WS_END = 712 * MiB;
constexpr int LDS_BYTES = 142336;
constexpr int ATT_V_OFF = 0, ATT_LUT_OFF = 65536, ATT_KM_OFF = 81920, MISC_OFF = 131072;

struct Args {
    const float* x; const float* g_mix; const float* w_in; const float* q_gain; const float* k_gain; const float* w_branch; const float* w_out;
    const float* g_ffn; const float* w_gu; const float* w_down; const float* rel_bias;
    float* out; unsigned char* ws; int ph_lo, ph_hi;
};

__device__ __forceinline__ unsigned f2bf(float f) { unsigned u = __builtin_bit_cast(unsigned, f); return (u + 0x7fffu + ((u >> 16) & 1u)) >> 16; }
__device__ __forceinline__ unsigned pk2(float lo, float hi) { return pg8::cvt_pk_bf16(lo, hi); }
__device__ __forceinline__ float wave_sum(float v) {
#pragma unroll
    for (int o = 1; o < 64; o <<= 1) v += __shfl_xor(v, o);
    return v;
}

template <bool GU>
__device__ __forceinline__ void transpose_item(const float* W, const float* gk, int K, int N, bf16_t* WT, LAS float* scr, int item, int lane) {
    const int nblk = N / 32, kb = item / nblk, nb = item % nblk, k0 = 64 * kb, n0 = 32 * nb;
    float v[32];
#pragma unroll
    for (int i = 0; i < 32; ++i) v[i] = W[(size_t)(k0 + 2 * i + (lane >> 5)) * N + n0 + (lane & 31)];
#pragma unroll
    for (int i = 0; i < 32; ++i) { const int kk = 2 * i + (lane >> 5); if (gk) v[i] *= gk[k0 + kk]; scr[kk * 33 + (lane & 31)] = v[i]; }
    asm volatile("s_waitcnt lgkmcnt(0)" ::: "memory");
    const int c = lane & 7;
#pragma unroll
    for (int j = 0; j < 4; ++j) { const int n = (lane >> 3) + 8 * j; const LAS float* s = scr + (8 * c) * 33 + n;
        u32x4 o; o.x = pk2(s[0 * 33], s[1 * 33]); o.y = pk2(s[2 * 33], s[3 * 33]); o.z = pk2(s[4 * 33], s[5 * 33]); o.w = pk2(s[6 * 33], s[7 * 33]);
        int col = n0 + n, drow;
        if (GU) { const int half = col >= DFF ? 1 : 0, jj = col - half * DFF; drow = 256 * (jj >> 7) + 128 * half + (jj & 127); } else drow = col;
        *(u32x4*)(WT + (size_t)drow * K + k0 + 8 * c) = o; }
    asm volatile("s_waitcnt lgkmcnt(0)" ::: "memory");
}

__device__ __forceinline__ void phase_prologue(const Args& a, LAS unsigned char* lds, int tid, int lane, int wave) {
    unsigned char* ws = a.ws;
    LAS float* scr = (LAS float*)(lds + wave * 16384);
    int NGW = gridDim.x * NWAVES; asm volatile("" : "+s"(NGW));
    const int gw = blockIdx.x * NWAVES + wave;
    constexpr int I_IN = (DM / 64) * (NIN / 32), I_BR = (DM / 64) * (DM / 32), I_OUT = I_BR, I_GU = (DM / 64) * (NGU / 32), I_DN = (DFF / 64) * (DM / 32);
    constexpr int I_LAYER = I_IN + I_BR + I_OUT + I_GU + I_DN;
    for (int it = gw; it < 2 * I_LAYER; it += NGW) {
        const int l = it / I_LAYER; int r = it % I_LAYER;
        if (r < I_IN) { transpose_item<false>(a.w_in + (size_t)l * DM * NIN, a.g_mix + l * DM, DM, NIN, (bf16_t*)(ws + WS_WIN) + (size_t)l * NIN * DM, scr, r, lane); continue; } r -= I_IN;
        if (r < I_BR) { transpose_item<false>(a.w_branch + (size_t)l * DM * DM, nullptr, DM, DM, (bf16_t*)(ws + WS_WBR) + (size_t)l * DM * DM, scr, r, lane); continue; } r -= I_BR;
        if (r < I_OUT) { transpose_item<false>(a.w_out + (size_t)l * DM * DM, nullptr, DM, DM, (bf16_t*)(ws + WS_WOUT) + (size_t)l * DM * DM, scr, r, lane); continue; } r -= I_OUT;
        if (r < I_GU) { transpose_item<true>(a.w_gu + (size_t)l * DM * NGU, a.g_ffn + l * DM, DM, NGU, (bf16_t*)(ws + WS_WGU) + (size_t)l * NGU * DM, scr, r, lane); continue; } r -= I_GU;
        transpose_item<false>(a.w_down + (size_t)l * DFF * DM, nullptr, DFF, DM, (bf16_t*)(ws + WS_WDN) + (size_t)l * DM * DFF, scr, r, lane);
    }
    float* ss = (float*)(ws + WS_SS);
    for (int m = gw; m < M; m += NGW) {
        const f32x4* xr = (const f32x4*)(a.x + (size_t)m * DM) + lane; u32x2* o8 = (u32x2*)((bf16_t*)(ws + WS_XB) + (size_t)m * DM) + lane;
        float s = 0.f;
#pragma unroll
        for (int j = 0; j < 8; ++j) { const f32x4 v = xr[64 * j]; s += (v.x * v.x + v.y * v.y) + (v.z * v.z + v.w * v.w); u32x2 w; w.x = pk2(v.x, v.y); w.y = pk2(v.z, v.w); o8[64 * j] = w; }
        s = wave_sum(s);
        if (lane == 0) ss[m] = s;
    }
    int NGT = gridDim.x * NTHR; asm volatile("" : "+s"(NGT));
    const int gt = blockIdx.x * NTHR + tid;
    for (int i = gt; i < 3 * M; i += NGT) ss[M + i] = 0.f;
    if (gt < 1024) ((unsigned*)(ws + WS_CTR))[gt] = 0u;
    float* lut = (float*)(ws + WS_LUT);
    for (int i = gt; i < 12 * 4096; i += NGT) { const int hs = i >> 12, d = i & 4095; int bucket;
        if (d < 16) bucket = d; else { const float df = (float)d; int large = 16 + (int)(logf(df / 16.0f) / 4.852030263919617f * 16.0f); bucket = large < 31 ? large : 31; }
        lut[i] = a.rel_bias[bucket * 12 + hs] * 1.4426950408889634f; }
}

__device__ __forceinline__ void phase_qknorm(const Args& a, int l, LAS unsigned char* lds, int tid, int lane, int wave) {
    bf16_t* qkv = (bf16_t*)(a.ws + WS_QKV); float* kmean = (float*)(a.ws + WS_KM);
    LAS float* red = (LAS float*)lds;
    for (int it = blockIdx.x; it < 1536; it += gridDim.x) {
        const int kind = it / 768, rem = it % 768, b = rem / 192, hs = (rem % 192) / 16, blk = rem % 16;
        const float* gain = (kind ? a.k_gain : a.q_gain) + (size_t)l * 12 * 128 + hs * 128 + (lane & 15) * 8;
        float gn[8];
#pragma unroll
        for (int e = 0; e < 8; ++e) gn[e] = gain[e];
        bf16_t* base = qkv + (size_t)(b * SEQ + blk * 256 + wave * 32) * QKVP + kind * 2048 + (4 + hs) * 128 + (lane & 15) * 8;
        float ks[8];
#pragma unroll
        for (int e = 0; e < 8; ++e) ks[e] = 0.f;
        u32x4 wv[8];
#pragma unroll
        for (int ii = 0; ii < 8; ++ii) wv[ii] = *(const u32x4*)(base + (size_t)(4 * ii + (lane >> 4)) * QKVP);
#pragma unroll
        for (int ii = 0; ii < 8; ++ii) { bf16_t* p = base + (size_t)(4 * ii + (lane >> 4)) * QKVP;
            const u32x4 w = wv[ii]; float v[8];
            v[0] = pg8::bf_lo(w.x); v[1] = pg8::bf_hi(w.x); v[2] = pg8::bf_lo(w.y); v[3] = pg8::bf_hi(w.y); v[4] = pg8::bf_lo(w.z); v[5] = pg8::bf_hi(w.z); v[6] = pg8::bf_lo(w.w); v[7] = pg8::bf_hi(w.w);
            float s = 0.f;
#pragma unroll
            for (int e = 0; e < 8; ++e) s += v[e] * v[e];
            s += __shfl_xor(s, 1); s += __shfl_xor(s, 2); s += __shfl_xor(s, 4); s += __shfl_xor(s, 8);
            const float rs = rsqrtf(s * (1.0f / 128.0f) + 1e-6f);
#pragma unroll
            for (int e = 0; e < 8; ++e) { v[e] = v[e] * rs * gn[e]; ks[e] += v[e]; }
            u32x4 o; o.x = pk2(v[0], v[1]); o.y = pk2(v[2], v[3]); o.z = pk2(v[4], v[5]); o.w = pk2(v[6], v[7]);
            *(u32x4*)p = o; }
        const bool km = (kind == 1) && (hs < 6);
        if (km) {
#pragma unroll
            for (int e = 0; e < 8; ++e) { ks[e] += __shfl_xor(ks[e], 16); ks[e] += __shfl_xor(ks[e], 32); }
            if (lane < 16) {
#pragma unroll
                for (int e = 0; e < 8; ++e) red[wave * 128 + lane * 8 + e] = ks[e]; }
        }
        __syncthreads();
        if (km && tid < 128) { float s = 0.f;
#pragma unroll
            for (int w = 0; w < 8; ++w) s += red[w * 128 + tid];
            kmean[((size_t)(b * 6 + hs) * 16 + blk) * 128 + tid] = s * (1.0f / 256.0f); }
        __syncthreads();
    }
}

namespace att {
constexpr float SCALE = 0.08838834764831845f, LOG2E = 1.4426950408889634f, NEG = -1e30f, C1 = SCALE * LOG2E;
__device__ __forceinline__ unsigned offa(unsigned row, unsigned ch) { return 2048u * (row >> 3) + 512u * (ch >> 2) + 64u * (row & 7u) + 16u * ((ch & 3u) ^ ((row >> 2) & 3u)); }
__device__ __forceinline__ int clamp_s(int s) { return s < 0 ? 0 : (s > SEQ - 1 ? SEQ - 1 : s); }
__device__ __forceinline__ void load_k(bf16x8 (&kf)[8], const bf16_t* Kb, int s0, int stride, int lane) {
    const int s = clamp_s(s0 + stride * (lane & 31));
    const GAS bf16x8* p = (const GAS bf16x8*)(Kb + (size_t)s * QKVP + 8 * (lane >> 5));
#pragma unroll
    for (int j = 0; j < 8; ++j) kf[j] = p[2 * j];
}
__device__ __forceinline__ void load_v(u32x4 (&vr)[8], const bf16_t* Vb, int s0, int stride, int lane) {
#pragma unroll
    for (int ii = 0; ii < 8; ++ii) { const int s = clamp_s(s0 + stride * ((lane >> 4) + 4 * ii)); vr[ii] = *(const GAS u32x4*)(Vb + (size_t)s * QKVP + (lane & 15) * 8); }
}
__device__ __forceinline__ void stage_v(LAS unsigned char* vl, const u32x4 (&vr)[8], int lane) {
    const unsigned ch = lane & 15, wl = 512u * (ch >> 2) + 64u * (unsigned)(lane >> 4);
#pragma unroll
    for (int ii = 0; ii < 8; ++ii) *(LAS u32x4*)(vl + wl + 16u * ((ch & 3u) ^ (unsigned)(ii & 3)) + 2048 * (ii >> 1) + 256 * (ii & 1)) = vr[ii];
}
__device__ __forceinline__ f32x16 qk(const bf16x8 (&kf)[8], const bf16x8 (&qf)[8]) {
    f32x16 acc = {0.f, 0.f, 0.f, 0.f, 0.f, 0.f, 0.f, 0.f, 0.f, 0.f, 0.f, 0.f, 0.f, 0.f, 0.f, 0.f};
#pragma unroll
    for (int j = 0; j < 8; ++j) acc = __builtin_amdgcn_mfma_f32_32x32x16_bf16(kf[j], qf[j], acc, 0, 0, 0);
    return acc;
}
typedef short v4i16_t __attribute__((ext_vector_type(4)));
__device__ __forceinline__ s16x4 vtr(LAS unsigned char* p) { return __builtin_bit_cast(s16x4, __builtin_amdgcn_ds_read_tr16_b64_v4i16((LAS v4i16_t*)p)); }
__device__ __forceinline__ void pv(f32x16 (&o)[4], LAS unsigned char* vl, bf16x8 P0, bf16x8 P1, int lane) {
    const unsigned h = lane >> 5, blk = (lane >> 4) & 1, q = (lane & 15) >> 2, p = lane & 3;
    const unsigned lb = 64u * (4u * h + q) + 16u * ((p >> 1) ^ h) + 8u * (p & 1u);
    LAS unsigned char* b0 = vl + lb + 32u * blk; LAS unsigned char* b1 = vl + lb + 32u * (blk ^ 1u) + 2048u;
#pragma unroll
    for (int hf = 0; hf < 2; ++hf) {
        s16x4 lo[2][2], hi[2][2];
#pragma unroll
        for (int cc = 0; cc < 2; ++cc)
#pragma unroll
            for (int s = 0; s < 2; ++s) { lo[cc][s] = vtr(b0 + 4096 * s + 512 * (2 * hf + cc)); hi[cc][s] = vtr(b1 + 4096 * s + 512 * (2 * hf + cc)); }
        asm volatile("s_waitcnt lgkmcnt(0)" ::: "memory");
        __builtin_amdgcn_sched_barrier(0);
#pragma unroll
        for (int cc = 0; cc < 2; ++cc)
#pragma unroll
            for (int s = 0; s < 2; ++s) {
                const bf16x8 A = {lo[cc][s][0], lo[cc][s][1], lo[cc][s][2], lo[cc][s][3], hi[cc][s][0], hi[cc][s][1], hi[cc][s][2], hi[cc][s][3]};
                o[2 * hf + cc] = __builtin_amdgcn_mfma_f32_32x32x16_bf16(A, s ? P1 : P0, o[2 * hf + cc], 0, 0, 0);
            }
        __builtin_amdgcn_sched_barrier(0);
    }
}
typedef float f32x2_t __attribute__((ext_vector_type(2))); typedef __bf16 bf16x2_t __attribute__((ext_vector_type(2)));
__device__ __forceinline__ unsigned cvtpk(float lo, float hi) { f32x2_t v = {lo, hi}; bf16x2_t b = __builtin_convertvector(v, bf16x2_t); return __builtin_bit_cast(unsigned, b); }
__device__ __forceinline__ void pack_p(const float (&p)[16], bf16x8& P0, bf16x8& P1) {
    u32x4 a, b; a.x = cvtpk(p[0], p[1]); a.y = cvtpk(p[2], p[3]); a.z = cvtpk(p[4], p[5]); a.w = cvtpk(p[6], p[7]);
    b.x = cvtpk(p[8], p[9]); b.y = cvtpk(p[10], p[11]); b.z = cvtpk(p[12], p[13]); b.w = cvtpk(p[14], p[15]);
    P0 = __builtin_bit_cast(bf16x8, a); P1 = __builtin_bit_cast(bf16x8, b);
}
__device__ __forceinline__ void softmax_step(float (&x)[16], float& m, float& l, f32x16 (&o)[4], bf16x8& P0, bf16x8& P1) {
    float mx = fmaxf(x[0], x[1]);
#pragma unroll
    for (int r = 2; r < 16; ++r) mx = fmaxf(mx, x[r]);
    mx = fmaxf(mx, __shfl_xor(mx, 32));
    const float mn = fmaxf(m, mx);
    const float alpha = __builtin_amdgcn_exp2f(m - mn);
    float ls = 0.f;
#pragma unroll
    for (int r = 0; r < 16; ++r) { const float p = __builtin_amdgcn_exp2f(x[r] - mn); ls += p; x[r] = p; }
    l = l * alpha + ls; m = mn;
    if (__any(alpha != 1.0f)) {
#pragma unroll
        for (int c = 0; c < 4; ++c) o[c] = o[c] * alpha;
    }
    pack_p(x, P0, P1);
}
__device__ __forceinline__ void softmax_fixed(float (&x)[16], float& l, bf16x8& P0, bf16x8& P1) {
    float ls = 0.f;
#pragma unroll
    for (int r = 0; r < 16; ++r) { const float p = __builtin_amdgcn_exp2f(x[r]); ls += p; x[r] = p; }
    l += ls;
    pack_p(x, P0, P1);
}
__device__ __forceinline__ float softmax_ref(const Args& a, int l, int hs, const bf16x8 (&qf)[8], int lane) {
    const float* kg = a.k_gain + (size_t)l * 12 * 128 + hs * 128;
    float gm = fmaxf(fabsf(kg[lane]), fabsf(kg[lane + 64]));
    float bm = a.rel_bias[(lane & 31) * 12 + hs];
#pragma unroll
    for (int o_ = 1; o_ < 64; o_ <<= 1) { gm = fmaxf(gm, __shfl_xor(gm, o_)); bm = fmaxf(bm, __shfl_xor(bm, o_)); }
    float qs = 0.f;
#pragma unroll
    for (int j = 0; j < 8; ++j) { const u32x4 qw = __builtin_bit_cast(u32x4, qf[j]);
        const float q0 = pg8::bf_lo(qw.x), q1 = pg8::bf_hi(qw.x), q2 = pg8::bf_lo(qw.y), q3 = pg8::bf_hi(qw.y), q4 = pg8::bf_lo(qw.z), q5 = pg8::bf_hi(qw.z), q6 = pg8::bf_lo(qw.w), q7 = pg8::bf_hi(qw.w);
        qs += (q0 * q0 + q1 * q1) + (q2 * q2 + q3 * q3) + (q4 * q4 + q5 * q5) + (q6 * q6 + q7 * q7); }
    qs += __shfl_xor(qs, 32);
    return C1 * sqrtf(qs) * (11.3137085f * 1.004f * gm) + bm * LOG2E + 1e-3f;
}
__device__ __forceinline__ void store_o(const f32x16 (&o)[4], float inv, bf16_t* orow, int lane) {
    const int h = lane >> 5;
#pragma unroll
    for (int c = 0; c < 4; ++c)
#pragma unroll
        for (int i = 0; i < 4; ++i) { u32x2 w; w.x = cvtpk(o[c][4 * i] * inv, o[c][4 * i + 1] * inv); w.y = cvtpk(o[c][4 * i + 2] * inv, o[c][4 * i + 3] * inv);
            *(GAS u32x2*)(orow + 32 * c + 8 * i + 4 * h) = w; }
}
__device__ __forceinline__ void load_q(bf16x8 (&qf)[8], const bf16_t* qrow, int lane) {
    const GAS bf16x8* p = (const GAS bf16x8*)(qrow + 8 * (lane >> 5));
#pragma unroll
    for (int j = 0; j < 8; ++j) qf[j] = p[2 * j];
}

__device__ __forceinline__ void unit_moba(const Args& a, int lyr, bf16_t* Ob, int OP, int b, int hm, int qb, LAS unsigned char* lds, int tid, int lane, int wave) {
    asm volatile("" : "+v"(lane));
    const bf16_t* qkv = (const bf16_t*)(a.ws + WS_QKV);
    LAS float* lutL = (LAS float*)(lds + ATT_LUT_OFF); LAS float* kmL = (LAS float*)(lds + ATT_KM_OFF);
    { const float* lutG = (const float*)(a.ws + WS_LUT) + hm * 4096;
#pragma unroll
      for (int k_ = 0; k_ < 8; ++k_) lutL[tid + k_ * NTHR] = lutG[tid + k_ * NTHR];
      const float* kmG = (const float*)(a.ws + WS_KM) + (size_t)(b * 6 + hm) * 16 * 128;
#pragma unroll
      for (int k_ = 0; k_ < 4; ++k_) kmL[tid + k_ * NTHR] = kmG[tid + k_ * NTHR]; }
    __syncthreads();
    const int h = lane >> 5, t0 = qb * 256, tw = t0 + 32 * wave, t = tw + (lane & 31), hg = 4 + hm;
    const bf16_t* Kb = qkv + (size_t)b * SEQ * QKVP + 2048 + hg * 128; const bf16_t* Vb = Kb + 2048;
    bf16x8 qf[8]; load_q(qf, qkv + (size_t)(b * SEQ + t) * QKVP + hg * 128, lane);
    unsigned selmask = 0u, anymask = 0u;
    if (qb > 0) {
        float v1 = -3e38f, v2 = -3e38f, v3 = -3e38f; int i1 = -1, i2 = -1, i3 = -1;
        for (int n = 0; n < qb; ++n) {
            float g = 0.f;
#pragma unroll
            for (int j = 0; j < 8; ++j) { const LAS f32x4* kp = (const LAS f32x4*)(kmL + n * 128 + 16 * j + 8 * h); const f32x4 k0 = kp[0], k1 = kp[1];
                const u32x4 qw = __builtin_bit_cast(u32x4, qf[j]);
                g += pg8::bf_lo(qw.x) * k0[0] + pg8::bf_hi(qw.x) * k0[1] + pg8::bf_lo(qw.y) * k0[2] + pg8::bf_hi(qw.y) * k0[3]
                   + pg8::bf_lo(qw.z) * k1[0] + pg8::bf_hi(qw.z) * k1[1] + pg8::bf_lo(qw.w) * k1[2] + pg8::bf_hi(qw.w) * k1[3]; }
            g += __shfl_xor(g, 32);
            if (g > v1) { v3 = v2; i3 = i2; v2 = v1; i2 = i1; v1 = g; i1 = n; } else if (g > v2) { v3 = v2; i3 = i2; v2 = g; i2 = n; } else if (g > v3) { v3 = g; i3 = n; }
        }
        if (i1 >= 0) selmask |= 1u << i1; if (i2 >= 0) selmask |= 1u << i2; if (i3 >= 0) selmask |= 1u << i3;
        for (int n = 0; n < qb; ++n) if (__ballot((selmask >> n) & 1u) != 0ull) anymask |= 1u << n;
    }
    volatile LAS unsigned* misc = (volatile LAS unsigned*)(lds + MISC_OFF);
    if (tid == 0) misc[4] = 0u;
    __syncthreads();
    if (lane == 0 && anymask != 0u) __hip_atomic_fetch_or((LAS unsigned*)(lds + MISC_OFF + 16), anymask, __ATOMIC_RELAXED, __HIP_MEMORY_SCOPE_WORKGROUP);
    __syncthreads();
    const unsigned anywg = misc[4];
    const float nref = -softmax_ref(a, lyr, hm, qf, lane);
    float l = 0.f; f32x16 o[4];
#pragma unroll
    for (int c = 0; c < 4; ++c) o[c] = (f32x16){0.f, 0.f, 0.f, 0.f, 0.f, 0.f, 0.f, 0.f, 0.f, 0.f, 0.f, 0.f, 0.f, 0.f, 0.f, 0.f};
    const int srow = 8 * (wave >> 1) + ((lane >> 2) & 7), sch = 4 * (2 * (wave & 1) + (lane >> 5)) + ((lane & 3) ^ ((srow >> 2) & 3));
    const bf16_t* kg = Kb + (size_t)srow * QKVP + sch * 8; const bf16_t* vg = Vb + (size_t)srow * QKVP + sch * 8;
    const int r31 = lane & 31; const unsigned x0 = (r31 >> 2) & 1, x1 = (r31 >> 3) & 1;
    const unsigned kb_l = 2048u * (r31 >> 3) + 64u * (r31 & 7) + 16u * ((unsigned)h ^ x0);
    const unsigned ke0 = kb_l + 32u * x1, ke1 = kb_l + 32u * (x1 ^ 1u);
#define MOBA_STAGE(buf, nblk, stp) do { const size_t ro_ = (size_t)(256 * (nblk) + 64 * (stp)) * QKVP; LAS unsigned char* d_ = lds + ATT_V_OFF + (buf) * 32768 + wave * 1024; \
        __builtin_amdgcn_global_load_lds((const unsigned*)(kg + ro_), (LAS unsigned*)(d_), 16, 0, 0); \
        __builtin_amdgcn_global_load_lds((const unsigned*)(kg + ro_ + 32 * QKVP), (LAS unsigned*)(d_ + 8192), 16, 0, 0); \
        __builtin_amdgcn_global_load_lds((const unsigned*)(vg + ro_), (LAS unsigned*)(d_ + 16384), 16, 0, 0); \
        __builtin_amdgcn_global_load_lds((const unsigned*)(vg + ro_ + 32 * QKVP), (LAS unsigned*)(d_ + 24576), 16, 0, 0); } while (0)
    int n = qb, st = 3;
    MOBA_STAGE(0, n, st);
    asm volatile("s_waitcnt vmcnt(0)" ::: "memory");
    __syncthreads();
    int cur = 0;
    for (;;) {
        int nn = n, nst = st; bool has_next = true;
        if (n == qb) { if (st > 0) nst = st - 1; else { if (anywg == 0u) has_next = false; else { nn = __builtin_ctz(anywg); nst = 0; } } }
        else { if (st < 3) nst = st + 1; else { const unsigned rest = anywg & ~((2u << n) - 1u); if (rest == 0u) has_next = false; else { nn = __builtin_ctz(rest); nst = 0; } } }
        if (has_next) MOBA_STAGE(cur ^ 1, nn, nst);
        const bool own = (n == qb);
        const bool active = own ? (2 * st <= wave) : (((anymask >> (n & 31)) & 1u) != 0u);
        if (active) {
            LAS unsigned char* kl = lds + ATT_V_OFF + cur * 32768;
            const int dbase = t - (256 * n + 64 * st);
            const float lanebias = own ? nref : (((selmask >> (n & 31)) & 1u) ? nref : NEG);
            bf16x8 PA0, PA1, PB0, PB1;
#pragma unroll
            for (int tt = 0; tt < 2; ++tt) {
                bf16x8 kc[8];
#pragma unroll
                for (int s = 0; s < 8; ++s) kc[s] = *(const LAS bf16x8*)(kl + 8192 * tt + ((s & 1) ? ke1 : ke0) + 512 * (s >> 1));
                asm volatile("s_waitcnt lgkmcnt(0)" ::: "memory"); __builtin_amdgcn_sched_barrier(0);
                const f32x16 sacc = qk(kc, qf);
                const int db = dbase - 32 * tt;
                float x[16];
                if (own) {
#pragma unroll
                    for (int r = 0; r < 16; ++r) { const int dist = db - (8 * (r >> 2) + 4 * h + (r & 3)); const float lvv = lutL[dist < 0 ? 0 : dist];
                        const float xx = __builtin_fmaf(sacc[r], C1, lvv) + nref; x[r] = (dist >= 0) ? xx : NEG; }
                } else {
                    const LAS float* lp = lutL + (db - 4 * h);
#pragma unroll
                    for (int r = 0; r < 16; ++r) x[r] = __builtin_fmaf(sacc[r], C1, lp[-(8 * (r >> 2) + (r & 3))]) + lanebias;
                }
                if (tt == 0) softmax_fixed(x, l, PA0, PA1); else softmax_fixed(x, l, PB0, PB1);
            }
            pv(o, kl + 16384, PA0, PA1, lane);
            pv(o, kl + 24576, PB0, PB1, lane);
        }
        if (!has_next) break;
        asm volatile("s_waitcnt vmcnt(0)" ::: "memory");
        __syncthreads();
        n = nn; st = nst; cur ^= 1;
    }
#undef MOBA_STAGE
    l += __shfl_xor(l, 32);
    store_o(o, 1.0f / l, Ob + (size_t)(b * SEQ + t) * OP + hg * 128, lane);
}

__device__ __forceinline__ void dil_desc(int idx, int tb, int c4, int i, int& s0, int& stride, int& delta0, int& pat, int& aa) {
    if (idx < 5) { const int kt = 4 - idx; stride = 4; s0 = tb + c4 + 4 * (-128 + 32 * kt); delta0 = i + 128 - 32 * kt; pat = 0; aa = 0; }
    else if (idx < 13) { const int kt = idx - 5; stride = 1; s0 = tb - 128 + 32 * kt; delta0 = c4 + 4 * i + 128 - 32 * kt; pat = 1; aa = 0; }
    else { aa = (idx - 13) / 5; const int kt = (idx - 13) % 5; stride = 16; s0 = tb + c4 + 4 * aa + 16 * (-128 + 32 * kt); delta0 = (i >> 2) + 128 - 32 * kt; pat = 2; }
}
__device__ __forceinline__ void unit_dilated(const Args& a, int lyr, bf16_t* Ob, int OP, int b, int hd, int qb, LAS unsigned char* lds, int tid, int lane, int wave) {
    asm volatile("" : "+v"(lane));
    const bf16_t* qkv = (const bf16_t*)(a.ws + WS_QKV);
    LAS float* lut3 = (LAS float*)(lds + ATT_LUT_OFF);
    { const float* lutG = (const float*)(a.ws + WS_LUT) + (6 + hd) * 4096;

#pragma unroll
      for (int k_ = 0; k_ < 3; ++k_) { const int e = tid + k_ * NTHR; if (e >= 3 * 384) break; const int p = e / 384, d = e % 384 - 128; const int st = p == 0 ? 4 : (p == 1 ? 1 : 16); lut3[e] = (d >= 0 && d <= 128) ? lutG[st * d] : 0.f; } }
    __syncthreads();
    LAS unsigned char* vl = lds + ATT_V_OFF + wave * 8192;
    const int h = lane >> 5, i = lane & 31, t0 = qb * 256, tb = t0 + 128 * (wave >> 2), c4 = wave & 3, t = tb + c4 + 4 * i, hg = 10 + hd;
    const bf16_t* Kb = qkv + (size_t)b * SEQ * QKVP + 2048 + hg * 128; const bf16_t* Vb = Kb + 2048;
    bf16x8 qf[8]; load_q(qf, qkv + (size_t)(b * SEQ + t) * QKVP + hg * 128, lane);
    const float nref = -softmax_ref(a, lyr, 6 + hd, qf, lane);
    const unsigned dmax4 = (unsigned)((t >> 2) < 128 ? (t >> 2) : 128), dmax1 = (unsigned)(t < 128 ? t : 128), dmax16 = (unsigned)((t >> 4) < 128 ? (t >> 4) : 128);
    float l = 0.f; f32x16 o[4];
#pragma unroll
    for (int c = 0; c < 4; ++c) o[c] = (f32x16){0.f, 0.f, 0.f, 0.f, 0.f, 0.f, 0.f, 0.f, 0.f, 0.f, 0.f, 0.f, 0.f, 0.f, 0.f, 0.f};
    bf16x8 kc[8]; u32x4 vr[8];
    int s0, stride, delta0, pat, aa;
    dil_desc(0, tb, c4, i, s0, stride, delta0, pat, aa);
    load_k(kc, Kb, s0, stride, lane); load_v(vr, Vb, s0, stride, lane);
    for (int idx = 0; idx < 33; ++idx) {
        const f32x16 sacc = qk(kc, qf);
        stage_v(vl, vr, lane);
        int s0n = 0, stn = 1, d0n = 0, patn = 0, aan = 0;
        if (idx + 1 < 33) { dil_desc(idx + 1, tb, c4, i, s0n, stn, d0n, patn, aan); load_k(kc, Kb, s0n, stn, lane); }
        const unsigned dmax = pat == 0 ? dmax4 : (pat == 1 ? dmax1 : dmax16);
        const float lb = (pat == 2 && (i & 3) != aa) ? NEG : nref;
        const int dk = delta0 - 4 * h;
        const LAS float* lp = lut3 + pat * 384 + 128 + dk;
        float x[16];
#pragma unroll
        for (int r = 0; r < 16; ++r) { const float lvv = lp[-(8 * (r >> 2) + (r & 3))]; const float xx = __builtin_fmaf(sacc[r], C1, lvv) + lb;
            const unsigned delta = (unsigned)(dk - (8 * (r >> 2) + (r & 3))); x[r] = (delta <= dmax) ? xx : NEG; }
        bf16x8 P0, P1; softmax_fixed(x, l, P0, P1);
        if (idx + 1 < 33) load_v(vr, Vb, s0n, stn, lane);
        pv(o, vl, P0, P1, lane);
        s0 = s0n; stride = stn; delta0 = d0n; pat = patn; aa = aan;
    }
    l += __shfl_xor(l, 32);
    store_o(o, 1.0f / l, Ob + (size_t)(b * SEQ + t) * OP + hg * 128, lane);
}

__device__ __forceinline__ void unit_sb(const Args& a, bf16_t* Ob, int OP, int b, int ha, int qb, LAS unsigned char* lds, int tid, int lane, int wave) {
    asm volatile("" : "+v"(lane));
    const bf16_t* qkv = (const bf16_t*)(a.ws + WS_QKV);
    LAS unsigned char* vl = lds + ATT_V_OFF + wave * 8192;
    const int h = lane >> 5, t0 = qb * 256, tw = t0 + 32 * wave, t = tw + (lane & 31);
    const bf16_t* Kb = qkv + (size_t)b * SEQ * QKVP + 2048 + ha * 128; const bf16_t* Vb = Kb + 2048;
    bf16x8 qf[8]; load_q(qf, qkv + (size_t)(b * SEQ + t) * QKVP + ha * 128, lane);
    f32x16 o[4];
#pragma unroll
    for (int c = 0; c < 4; ++c) o[c] = (f32x16){0.f, 0.f, 0.f, 0.f, 0.f, 0.f, 0.f, 0.f, 0.f, 0.f, 0.f, 0.f, 0.f, 0.f, 0.f, 0.f};
    float R = 0.f;
    for (int kt = tw >> 5; kt >= 0; --kt) {
        f32x16 sacc;
        { bf16x8 kc[8]; load_k(kc, Kb, 32 * kt, 1, lane); sacc = qk(kc, qf); }
        { u32x4 vr[8]; load_v(vr, Vb, 32 * kt, 1, lane); stage_v(vl, vr, lane); }
        const int dbase = t - 32 * kt;
        float lb[16], g[4], gp[4];
#pragma unroll
        for (int i = 0; i < 4; ++i) { g[i] = 0.f;
#pragma unroll
            for (int j = 0; j < 4; ++j) { const int r = 4 * i + j; const int kap = 8 * i + 4 * h + j; const bool past = kap < dbase;
                const float z = sacc[r] * SCALE; const float sp = __logf(1.0f + __expf(-fabsf(z)));
                lb[r] = fminf(z, 0.f) - sp; g[i] += past ? (lb[r] - z) : 0.f; }
            gp[i] = __shfl_xor(g[i], 32); }
        float sg[4]; sg[3] = 0.f; sg[2] = g[3] + gp[3]; sg[1] = sg[2] + g[2] + gp[2]; sg[0] = sg[1] + g[1] + gp[1];
        const float tot = sg[0] + g[0] + gp[0];
#pragma unroll
        for (int i = 0; i < 4; ++i) { const float basei = sg[i] + R + (h == 0 ? gp[i] : 0.f);
            float suf = 0.f;
#pragma unroll
            for (int j = 3; j >= 0; --j) { const int r = 4 * i + j; const int kap = 8 * i + 4 * h + j; const bool past = kap < dbase;
                const float l1 = past ? (lb[r] - sacc[r] * SCALE) : 0.f;
                lb[r] = past ? __expf(lb[r] + suf + basei) : 0.f; suf += l1; } }
        R += tot;
        bf16x8 P0, P1; pack_p(lb, P0, P1);
        pv(o, vl, P0, P1, lane);
        if (__all(R < -110.0f)) break;
    }
    store_o(o, 1.0f, Ob + (size_t)(b * SEQ + t) * OP + ha * 128, lane);
}

__device__ __forceinline__ void phase_attention(const Args& a, int l, int rep, LAS unsigned char* lds, int tid, int lane, int wave) {
    unsigned* ctr0 = (unsigned*)(a.ws + WS_CTR) + (l + 2 * rep) * 64;
    bf16_t* Ob = l == 0 ? (bf16_t*)a.out : (bf16_t*)(a.ws + WS_QKV); const int OP = l == 0 ? DM : QKVP;
    volatile LAS unsigned* misc = (volatile LAS unsigned*)(lds + MISC_OFF);
    int xq = (int)((unsigned)__builtin_amdgcn_s_getreg((3 << 11) | 20) & 7u), left = 8;
    for (;;) {
        __syncthreads();
        if (tid == 0) misc[0] = atomicAdd(ctr0 + xq * 8, 1u);
        __syncthreads();
        const int j = (int)misc[0];
        if (j >= 128) { if (--left == 0) break; xq = (xq + 1) & 7; continue; }
        if (j < 48) { const int qb = 15 - j / 3, bh = 3 * xq + j % 3; unit_moba(a, l, Ob, OP, bh / 6, bh % 6, qb, lds, tid, lane, wave); }
        else if (j < 96) { const int jj = j - 48, qb = jj % 16, bh = 3 * xq + jj / 16; unit_dilated(a, l, Ob, OP, bh / 6, bh % 6, qb, lds, tid, lane, wave); }
        else { const int jj = j - 96, qb = 15 - jj / 2, bh = 2 * xq + jj % 2; unit_sb(a, Ob, OP, bh / 4, bh % 4, qb, lds, tid, lane, wave); }
    }
}
}

__device__ __forceinline__ void grid_barrier(unsigned* bar, unsigned k) {
    asm volatile("s_waitcnt vmcnt(0) lgkmcnt(0)" ::: "memory");
    __syncthreads();
    if (threadIdx.x == 0) {
        const unsigned G = gridDim.x, g = blockIdx.x & 7u, nloc = (G - g + 7u) >> 3, ngrp = G < 8u ? G : 8u;
        __builtin_amdgcn_fence(__ATOMIC_RELEASE, "agent");
        asm volatile("s_waitcnt vmcnt(0)" ::: "memory");
        const unsigned old = __hip_atomic_fetch_add(bar + 64 * g, 1u, __ATOMIC_RELAXED, __HIP_MEMORY_SCOPE_AGENT);
        if (old + 1u == nloc * k) __hip_atomic_fetch_add(bar + 512, 1u, __ATOMIC_RELAXED, __HIP_MEMORY_SCOPE_AGENT);
        unsigned spins = 0;
        while (__hip_atomic_load(bar + 512, __ATOMIC_RELAXED, __HIP_MEMORY_SCOPE_AGENT) < ngrp * k) { __builtin_amdgcn_s_sleep(2); if (++spins > (1u << 24)) break; }
        __builtin_amdgcn_fence(__ATOMIC_ACQUIRE, "agent");
        asm volatile("s_waitcnt vmcnt(0)" ::: "memory");
    }
    __syncthreads();
}

__global__ void __launch_bounds__(NTHR, 2) hybrid_fwd(Args a_) {
    __shared__ __attribute__((aligned(16))) unsigned char lds_raw[LDS_BYTES];
    LAS unsigned char* lds = (LAS unsigned char*)lds_raw;
    const int ph_lo = a_.ph_lo, ph_hi = a_.ph_hi;
    int n_grid = 0;
    for (int ph = ph_lo; ph < ph_hi; ++ph) {
        {
        constexpr int rep = 0;
        int tid = threadIdx.x; asm volatile("" : "+v"(tid));
        const int lane = tid & 63, wave = __builtin_amdgcn_readfirstlane(tid >> 6);
        const __attribute__((address_space(4))) Args* ap = (const __attribute__((address_space(4))) Args*)__builtin_amdgcn_kernarg_segment_ptr(); asm volatile("" : "+s"(ap));
        Args a; a.x = ap->x; a.g_mix = ap->g_mix; a.w_in = ap->w_in; a.q_gain = ap->q_gain; a.k_gain = ap->k_gain; a.w_branch = ap->w_branch; a.w_out = ap->w_out;
        a.g_ffn = ap->g_ffn; a.w_gu = ap->w_gu; a.w_down = ap->w_down; a.rel_bias = ap->rel_bias; a.out = ap->out; a.ws = ap->ws; a.ph_lo = 0; a.ph_hi = 0;
        unsigned char* ws = a.ws;
        const int G = gridDim.x, cidx = blockIdx.x;
        float* ss = (float*)(ws + WS_SS);
        bf16_t* xb = (bf16_t*)(ws + WS_XB); bf16_t* qkv = (bf16_t*)(ws + WS_QKV); bf16_t* gates = (bf16_t*)(ws + WS_GATES);
        bf16_t* ob = qkv; bf16_t* merged = qkv + 2048; bf16_t* act = qkv;
        if (ph == 0) phase_prologue(a, lds, tid, lane, wave);
        else {
            const int l = (ph - 1) / 7, k = (ph - 1) % 7;
            if (k == 0) {
                pg8::Gemm g{xb, (const bf16_t*)(ws + WS_WIN) + (size_t)l * NIN * DM, DM, DM, M, NIN, DM}; pg8::StaticOrder S; S.init(M, NIN, G, cidx);
                pg8::EpiIn E{qkv, gates, ss + (size_t)(2 * l) * M, a.q_gain + (size_t)l * 12 * 128, a.k_gain + (size_t)l * 12 * 128, (float*)(ws + WS_KM), lds + 132096};
                pg8::gemm_phase<pg8::EpiIn, pg8::StaticOrder>(lds, g, S, E, tid);
            } else if (k == 1) {   }
            else if (k == 2) att::phase_attention(a, l, rep, lds, tid, lane, wave);
            else if (k == 3) {
                const bf16_t* wbt = (const bf16_t*)(ws + WS_WBR) + (size_t)l * DM * DM;
                for (int br = 0; br < 3; ++br) {
                    const int k0 = br == 0 ? 0 : (br == 1 ? 512 : 1280), kl = br == 0 ? 512 : 768;
                    pg8::Gemm g{(l == 0 ? (const bf16_t*)a.out : ob) + k0, wbt + k0, l == 0 ? DM : QKVP, DM, M, DM, kl}; pg8::StaticOrder S; S.init(M, DM, G, cidx);
                    pg8::EpiBranch E{merged, gates, br * 2048, br == 0 ? 1 : 0};
                    pg8::gemm_phase<pg8::EpiBranch, pg8::StaticOrder>(lds, g, S, E, tid);
                }
            } else if (k == 4 || k == 6) {
                const bool dn = (k == 6);
                pg8::Gemm g{dn ? act : merged, dn ? (const bf16_t*)(ws + WS_WDN) + (size_t)l * DM * DFF : (const bf16_t*)(ws + WS_WOUT) + (size_t)l * DM * DM,
                            dn ? DFF : QKVP, dn ? DFF : DM, M, DM, dn ? DFF : DM};
                pg8::StaticOrder S; S.init(M, DM, G, cidx);
                const float* base = (l == 0 && !dn) ? a.x : a.out;
                const bool lastp = dn && (l == 1);
                pg8::EpiResid E{base, a.out, lastp ? nullptr : xb, lastp ? nullptr : ss + (size_t)(2 * l + (dn ? 2 : 1)) * M};
                pg8::gemm_phase<pg8::EpiResid, pg8::StaticOrder>(lds, g, S, E, tid);
            } else {
                pg8::Gemm g{xb, (const bf16_t*)(ws + WS_WGU) + (size_t)l * NGU * DM, DM, DM, M, NGU, DM}; pg8::StaticOrder S; S.init(M, NGU, G, cidx);
                pg8::EpiGU E{act, ss + (size_t)(2 * l + 1) * M};
                pg8::gemm_phase<pg8::EpiGU, pg8::StaticOrder>(lds, g, S, E, tid);
            }
        }
        }
        if (ph + 1 < ph_hi) {
            if (ph == ph_lo) cg::this_grid().sync();
            else if ((ph - 1) % 7 != 0) { ++n_grid; grid_barrier((unsigned*)(a_.ws + WS_CTR) + 256, (unsigned)n_grid); }
        }
    }
}

__global__ void fill_const(float* o, int n, float v) { for (int i = blockIdx.x * blockDim.x + threadIdx.x; i < n; i += gridDim.x * blockDim.x) o[i] = v; }
extern "C" void kernel_launch(void* const* d_in, const int* in_sizes, int n_in, void* d_out, int out_size, void* d_ws, size_t ws_size, hipStream_t stream) {
    static int grid = 0;
    if (grid == 0) {
        if (n_in != 11 || in_sizes[0] != M * DM || out_size != M * DM || ws_size < WS_END) { fprintf(stderr, "kernel_launch: unexpected shapes / workspace (n_in %d, ws %zu); nothing launched\n", n_in, ws_size); grid = -1; return; }
        int dev = 0, cus = 0, per_cu = 0;
        if (hipGetDevice(&dev) != hipSuccess || hipDeviceGetAttribute(&cus, hipDeviceAttributeMultiprocessorCount, dev) != hipSuccess || cus < 1) cus = 256;
        if (hipOccupancyMaxActiveBlocksPerMultiprocessor(&per_cu, hybrid_fwd, NTHR, 0) != hipSuccess || per_cu < 1) per_cu = 1;
        (void)hipGetLastError();
        grid = cus * per_cu;
    }
    if (grid < 0) return;
    Args a{};
    a.x = (const float*)d_in[0]; a.g_mix = (const float*)d_in[1]; a.w_in = (const float*)d_in[2]; a.q_gain = (const float*)d_in[3]; a.k_gain = (const float*)d_in[4];
    a.w_branch = (const float*)d_in[5]; a.w_out = (const float*)d_in[6]; a.g_ffn = (const float*)d_in[7]; a.w_gu = (const float*)d_in[8]; a.w_down = (const float*)d_in[9];
    a.rel_bias = (const float*)d_in[10]; a.out = (float*)d_out; a.ws = (unsigned char*)d_ws;
#if MK_COOP
    a.ph_lo = 0; a.ph_hi = MK_PH_END;
    void* args[] = {&a};
    hipError_t e = hipLaunchCooperativeKernel((void*)hybrid_fwd, dim3(grid), dim3(NTHR), args, 0, stream);
    if (e != hipSuccess) fprintf(stderr, "kernel_launch: cooperative launch failed: %s (grid %d)\n", hipGetErrorString(e), grid);
#else
    for (int ph = 0; ph < MK_PH_END; ++ph) { a.ph_lo = ph; a.ph_hi = ph + 1; hipLaunchKernelGGL(hybrid_fwd, dim3(grid), dim3(NTHR), 0, stream, a); }
#endif
}
```

```cpp
#include <hip/hip_runtime.h>
#include <hip/hip_cooperative_groups.h>
#include <cstdio>
#include <cstdint>
namespace cg = cooperative_groups;

#ifndef MK_DUP_PRO
#define MK_DUP_PRO 1
#define MK_DUP_BIG 1
#define MK_DUP_BR 1
#define MK_DUP_ATT 1
#define MK_DUP_SYNC 1
#endif
#ifndef MK_PH_END
#define MK_PH_END 15
#endif
#ifndef MK_COOP
#define MK_COOP 1
#endif

namespace pg8 {
#define PG8_LAS __attribute__((address_space(3)))
typedef unsigned short bf16_t;
typedef short bf16x8 __attribute__((ext_vector_type(8)));
typedef float f32x4 __attribute__((ext_vector_type(4)));
typedef unsigned u32x4 __attribute__((ext_vector_type(4)));
typedef unsigned u32x2 __attribute__((ext_vector_type(2)));
constexpr int BM = 256, BK = 64, HALF = 128, HTB = HALF * BK * 2, STAGE_BYTES = 8 * HTB, NXCD = 8, WGM = 8;

__host__ __device__ __forceinline__ int lds_byte(int r, int c) { const int st = (r >> 4) * 2 + (c >> 5), rr = r & 15, cc = c & 31, ob = rr * 64 + cc * 2; return st * 1024 + (ob ^ (((ob >> 9) & 1) << 5)); }
__host__ __device__ __forceinline__ void stage_rc(int b, int& R, int& C) { const int st = b / 1024, sb = b % 1024, swz = sb ^ (((sb >> 9) & 1) << 5); R = (st >> 1) * 16 + swz / 64; C = (st & 1) * 32 + (swz % 64) / 2; }
__host__ __device__ __forceinline__ int perm32(int rho) { const int n = rho >> 4, i = rho & 15; return 8 * (i >> 2) + 4 * n + (i & 3); }

struct Unit { int pm, pn; };
struct Gemm { const bf16_t* A; const bf16_t* Bt; int lda, ldb, M, N, K; };

struct StaticOrder {
    int nM, nN, nwg, G, c;
    __host__ __device__ void init(int M, int N, int G_, int c_) { nM = M / BM; nN = N / BM; nwg = nM * nN; G = G_; c = c_; }
    __host__ __device__ bool next(int i, Unit& u) const {
        const int L = i * G + c; if (L >= nwg) return false;
        int wgid = L; { const int q = nwg / NXCD, r = nwg % NXCD, xcd = wgid % NXCD, off = wgid / NXCD; wgid = (xcd < r ? xcd * (q + 1) : r * (q + 1) + (xcd - r) * q) + off; }
        const int nig = WGM * nN, gid = wgid / nig, fm = gid * WGM, gsz = (nM - fm) < WGM ? (nM - fm) : WGM;
        u.pm = fm + ((wgid % nig) % gsz); u.pn = (wgid % nig) / gsz; return true;
    }
};

typedef float f32x2c_t __attribute__((ext_vector_type(2))); typedef __bf16 bf16x2c_t __attribute__((ext_vector_type(2)));
__device__ __forceinline__ unsigned cvt_pk_bf16(float lo, float hi) { f32x2c_t v = {lo, hi}; bf16x2c_t b = __builtin_convertvector(v, bf16x2c_t); return __builtin_bit_cast(unsigned, b); }
__device__ __forceinline__ float bf_lo(unsigned w) { return __uint_as_float(w << 16); }
__device__ __forceinline__ float bf_hi(unsigned w) { return __uint_as_float(w & 0xffff0000u); }
__device__ __forceinline__ float sigmoidf_(float v) { return __builtin_amdgcn_rcpf(1.0f + __builtin_amdgcn_exp2f(v * -1.4426950408889634f)); }


struct EpiIn {
    static constexpr bool PERM = true;
    bf16_t* qkv; bf16_t* gates; const float* ss; const float* qg; const float* kg; float* kmean; PG8_LAS unsigned char* xl;
    __device__ __forceinline__ void operator()(const f32x4 (&acc)[2][2][4][2], const Unit& u, int wr, int wc, int fr, int fq) const {
        const int row0 = u.pm * BM + wr * 64 + fr; const bool isg = u.pn >= 24;
        bf16_t* base = isg ? gates : qkv; const int col0 = (isg ? u.pn - 24 : u.pn) * BM + wc * 32 + 8 * fq;
        float rsv[2][4];
#pragma unroll
        for (int ai = 0; ai < 2; ++ai)
#pragma unroll
            for (int m = 0; m < 4; ++m) rsv[ai][m] = ss[row0 + ai * HALF + m * 16];
#pragma unroll
        for (int ai = 0; ai < 2; ++ai)
#pragma unroll
            for (int m = 0; m < 4; ++m) rsv[ai][m] = rsqrtf(rsv[ai][m] * (1.0f / 2048.0f) + 1e-6f);
        const int sec = u.pn >> 3, hp = u.pn & 7; const bool soft = (u.pn < 16) && (hp >= 2);
        if (!soft) {
#pragma unroll
            for (int ai = 0; ai < 2; ++ai)
#pragma unroll
                for (int m = 0; m < 4; ++m) { const int row = row0 + ai * HALF + m * 16; const float rs = rsv[ai][m];
                    bf16_t* rowp = base + (size_t)row * 6144 + col0;
#pragma unroll
                    for (int bj = 0; bj < 2; ++bj) { f32x4 v0 = acc[ai][bj][m][0] * rs, v1 = acc[ai][bj][m][1] * rs;
                        if (isg) { v0 = (f32x4){sigmoidf_(v0[0]), sigmoidf_(v0[1]), sigmoidf_(v0[2]), sigmoidf_(v0[3])}; v1 = (f32x4){sigmoidf_(v1[0]), sigmoidf_(v1[1]), sigmoidf_(v1[2]), sigmoidf_(v1[3])}; }
                        u32x4 w; w.x = cvt_pk_bf16(v0[0], v0[1]); w.y = cvt_pk_bf16(v0[2], v0[3]); w.z = cvt_pk_bf16(v1[0], v1[1]); w.w = cvt_pk_bf16(v1[2], v1[3]);
                        *(u32x4*)(rowp + bj * HALF) = w; } }
            return;
        }
        PG8_LAS float* part = (PG8_LAS float*)xl; PG8_LAS float* colsum = (PG8_LAS float*)(xl + 8192);
#pragma unroll
        for (int ai = 0; ai < 2; ++ai)
#pragma unroll
            for (int m = 0; m < 4; ++m)
#pragma unroll
                for (int bj = 0; bj < 2; ++bj) { const f32x4 a0 = acc[ai][bj][m][0] * rsv[ai][m], a1 = acc[ai][bj][m][1] * rsv[ai][m];
                    float s = (a0[0] * a0[0] + a0[1] * a0[1]) + (a0[2] * a0[2] + a0[3] * a0[3]) + (a1[0] * a1[0] + a1[1] * a1[1]) + (a1[2] * a1[2] + a1[3] * a1[3]);
                    s += __shfl_xor(s, 16); s += __shfl_xor(s, 32);
                    if (fq == 0) part[((ai * HALF + wr * 64 + m * 16 + fr) * 2 + bj) * 4 + wc] = s; }
        asm volatile("s_waitcnt lgkmcnt(0)" ::: "memory"); __builtin_amdgcn_s_barrier(); asm volatile("" ::: "memory");
        const bool km = (sec == 1) && (hp <= 4);
        const float* gbase = (sec ? kg : qg) + (2 * hp - 4) * 128 + wc * 32 + 8 * fq;
        float gn[2][8], cs[2][8];
#pragma unroll
        for (int bj = 0; bj < 2; ++bj)
#pragma unroll
            for (int e = 0; e < 8; ++e) { gn[bj][e] = gbase[bj * 128 + e]; cs[bj][e] = 0.f; }
#pragma unroll
        for (int ai = 0; ai < 2; ++ai)
#pragma unroll
            for (int m = 0; m < 4; ++m) { const int rl = ai * HALF + wr * 64 + m * 16 + fr; bf16_t* rowp = base + (size_t)(u.pm * BM + rl) * 6144 + col0;
#pragma unroll
                for (int bj = 0; bj < 2; ++bj) { const f32x4 p = *(const PG8_LAS f32x4*)(part + (rl * 2 + bj) * 4);
                    const float sc = rsv[ai][m] * rsqrtf(((p[0] + p[1]) + (p[2] + p[3])) * (1.0f / 128.0f) + 1e-6f);
                    float r[8];
#pragma unroll
                    for (int e = 0; e < 4; ++e) { r[e] = acc[ai][bj][m][0][e] * sc * gn[bj][e]; r[4 + e] = acc[ai][bj][m][1][e] * sc * gn[bj][4 + e]; }
#pragma unroll
                    for (int e = 0; e < 8; ++e) cs[bj][e] += r[e];
                    u32x4 w; w.x = cvt_pk_bf16(r[0], r[1]); w.y = cvt_pk_bf16(r[2], r[3]); w.z = cvt_pk_bf16(r[4], r[5]); w.w = cvt_pk_bf16(r[6], r[7]);
                    *(u32x4*)(rowp + bj * HALF) = w; } }
        if (km) {
#pragma unroll
            for (int bj = 0; bj < 2; ++bj)
#pragma unroll
                for (int e = 0; e < 8; ++e) { float c = cs[bj][e]; c += __shfl_xor(c, 1); c += __shfl_xor(c, 2); c += __shfl_xor(c, 4); c += __shfl_xor(c, 8);
                    if (fr == 0) colsum[wr * 256 + bj * 128 + wc * 32 + 8 * fq + e] = c; }
            asm volatile("s_waitcnt lgkmcnt(0)" ::: "memory"); __builtin_amdgcn_s_barrier(); asm volatile("" ::: "memory");
            if (wr == 0) { const int c = wc * 64 + fq * 16 + fr;
                const int hs = 2 * hp - 4 + (c >> 7);
                kmean[((size_t)((u.pm >> 4) * 6 + hs) * 16 + (u.pm & 15)) * 128 + (c & 127)] = (colsum[c] + colsum[256 + c]) * (1.0f / 256.0f); }
        }
    }
};
struct EpiGU {
    static constexpr bool PERM = true;
    bf16_t* act; const float* ss;
    __device__ __forceinline__ void operator()(const f32x4 (&acc)[2][2][4][2], const Unit& u, int wr, int wc, int fr, int fq) const {
        const int row0 = u.pm * BM + wr * 64 + fr; const int col0 = u.pn * HALF + wc * 32 + 8 * fq;
        float ssv[2][4];
#pragma unroll
        for (int ai = 0; ai < 2; ++ai)
#pragma unroll
            for (int m = 0; m < 4; ++m) ssv[ai][m] = ss[row0 + ai * HALF + m * 16];
#pragma unroll
        for (int ai = 0; ai < 2; ++ai)
#pragma unroll
            for (int m = 0; m < 4; ++m) { const int row = row0 + ai * HALF + m * 16; const float rs = rsqrtf(ssv[ai][m] * (1.0f / 2048.0f) + 1e-6f);
                float r[8];
#pragma unroll
                for (int n = 0; n < 2; ++n)
#pragma unroll
                    for (int e = 0; e < 4; ++e) { const float g = acc[ai][0][m][n][e] * rs, up = acc[ai][1][m][n][e] * rs; r[n * 4 + e] = g * sigmoidf_(g) * up; }
                u32x4 w; w.x = cvt_pk_bf16(r[0], r[1]); w.y = cvt_pk_bf16(r[2], r[3]); w.z = cvt_pk_bf16(r[4], r[5]); w.w = cvt_pk_bf16(r[6], r[7]);
                *(u32x4*)(act + (size_t)row * 5632 + col0) = w; }
    }
};
struct EpiBranch {
    static constexpr bool PERM = true;
    bf16_t* merged; const bf16_t* gates; int gcol; int first;
    __device__ __forceinline__ void operator()(const f32x4 (&acc)[2][2][4][2], const Unit& u, int wr, int wc, int fr, int fq) const {
        const int row0 = u.pm * BM + wr * 64 + fr; const int col0 = u.pn * BM + wc * 32 + 8 * fq;
#pragma unroll
        for (int aq = 0; aq < 4; ++aq) { const int ai = aq >> 1, m0 = 2 * (aq & 1);
            u32x4 gw[2][2], pw[2][2];
#pragma unroll
            for (int mm = 0; mm < 2; ++mm)
#pragma unroll
                for (int bj = 0; bj < 2; ++bj) { const int row = row0 + ai * HALF + (m0 + mm) * 16, col = col0 + bj * HALF;
                    gw[mm][bj] = *(const u32x4*)(gates + (size_t)row * 6144 + gcol + col);
                    pw[mm][bj] = first ? (u32x4){0u, 0u, 0u, 0u} : *(const u32x4*)(merged + (size_t)row * 6144 + col); }
#pragma unroll
            for (int mm = 0; mm < 2; ++mm)
#pragma unroll
                for (int bj = 0; bj < 2; ++bj) { const int m = m0 + mm; const int row = row0 + ai * HALF + m * 16, col = col0 + bj * HALF;
                    const u32x4 g_ = gw[mm][bj], p_ = pw[mm][bj]; float r[8];
                    r[0] = bf_lo(g_.x) * acc[ai][bj][m][0][0] + bf_lo(p_.x); r[1] = bf_hi(g_.x) * acc[ai][bj][m][0][1] + bf_hi(p_.x);
                    r[2] = bf_lo(g_.y) * acc[ai][bj][m][0][2] + bf_lo(p_.y); r[3] = bf_hi(g_.y) * acc[ai][bj][m][0][3] + bf_hi(p_.y);
                    r[4] = bf_lo(g_.z) * acc[ai][bj][m][1][0] + bf_lo(p_.z); r[5] = bf_hi(g_.z) * acc[ai][bj][m][1][1] + bf_hi(p_.z);
                    r[6] = bf_lo(g_.w) * acc[ai][bj][m][1][2] + bf_lo(p_.w); r[7] = bf_hi(g_.w) * acc[ai][bj][m][1][3] + bf_hi(p_.w);
                    u32x4 w; w.x = cvt_pk_bf16(r[0], r[1]); w.y = cvt_pk_bf16(r[2], r[3]); w.z = cvt_pk_bf16(r[4], r[5]); w.w = cvt_pk_bf16(r[6], r[7]);
                    *(u32x4*)(merged + (size_t)row * 6144 + col) = w; }
            asm volatile("" ::: "memory");
        }
    }
};
struct EpiResid {
    static constexpr bool PERM = true;
    const float* base; float* out; bf16_t* xb; float* ss;
    __device__ __forceinline__ void operator()(const f32x4 (&acc)[2][2][4][2], const Unit& u, int wr, int wc, int fr, int fq) const {
        const int row0 = u.pm * BM + wr * 64 + fr; const int col0 = u.pn * BM + wc * 32 + 8 * fq;
#pragma unroll
        for (int aq = 0; aq < 4; ++aq) { const int ai = aq >> 1, m0 = 2 * (aq & 1);
            f32x4 bv[2][2][2];
#pragma unroll
            for (int mm = 0; mm < 2; ++mm)
#pragma unroll
                for (int bj = 0; bj < 2; ++bj) { const size_t off = (size_t)(row0 + ai * HALF + (m0 + mm) * 16) * 2048 + col0 + bj * HALF;
                    bv[mm][bj][0] = *(const f32x4*)(base + off); bv[mm][bj][1] = *(const f32x4*)(base + off + 4); }
#pragma unroll
            for (int mm = 0; mm < 2; ++mm) { const int m = m0 + mm; const int row = row0 + ai * HALF + m * 16; float sq = 0.f;
#pragma unroll
                for (int bj = 0; bj < 2; ++bj) { const size_t off = (size_t)row * 2048 + col0 + bj * HALF;
                    const f32x4 o0 = bv[mm][bj][0] + acc[ai][bj][m][0], o1 = bv[mm][bj][1] + acc[ai][bj][m][1];
                    *(f32x4*)(out + off) = o0; *(f32x4*)(out + off + 4) = o1;
                    sq += (o0[0] * o0[0] + o0[1] * o0[1]) + (o0[2] * o0[2] + o0[3] * o0[3]) + (o1[0] * o1[0] + o1[1] * o1[1]) + (o1[2] * o1[2] + o1[3] * o1[3]);
                    if (xb) { u32x4 w; w.x = cvt_pk_bf16(o0[0], o0[1]); w.y = cvt_pk_bf16(o0[2], o0[3]); w.z = cvt_pk_bf16(o1[0], o1[1]); w.w = cvt_pk_bf16(o1[2], o1[3]); *(u32x4*)(xb + off) = w; } }
                if (ss) { sq += __shfl_xor(sq, 16); sq += __shfl_xor(sq, 32); if (fq == 0) atomicAdd(ss + row, sq); } }
            asm volatile("" ::: "memory");
        }
    }
};

template <class Epi, class Sched>
__device__ __forceinline__ void gemm_phase(PG8_LAS unsigned char* lds, const Gemm g, const Sched& S, const Epi& E, const int tid) {
    const int wid = __builtin_amdgcn_readfirstlane(tid >> 6), lane = tid & 63, wr = wid >> 2, wc = wid & 3, fr = lane & 15, fq = lane >> 4;
    const int nt = g.K / BK;
    unsigned voffA[2], voffB[2];
#pragma unroll
    for (int i = 0; i < 2; ++i) { int R, C; stage_rc(tid * 16 + i * 8192, R, C); const int Rb = Epi::PERM ? ((R & ~31) + perm32(R & 31)) : R;
        voffA[i] = (unsigned)(R * g.lda + C) * 2u; voffB[i] = (unsigned)(Rb * g.ldb + C) * 2u; }
    const size_t kstep = (size_t)(BK * 2);
    const size_t hstepA = (size_t)HALF * g.lda * 2, hstepB = (size_t)HALF * g.ldb * 2;
    const size_t tstepA = 2 * hstepA, tstepB = 2 * hstepB;
    const unsigned ldsw = (unsigned)wid * 1024u;
    const int aoff = lds_byte(wr * 64 + fr, fq * 8), boff = lds_byte(wc * 32 + fr, fq * 8);
#define PG8_SA(b, h) (((b) * 2 + (h)) * HTB)
#define PG8_SB(b, h) ((4 + (b) * 2 + (h)) * HTB)
#define PG8_STAGE(bufoff, gbase, voff) do { _Pragma("unroll") for (int _i = 0; _i < 2; ++_i) \
        __builtin_amdgcn_global_load_lds((const unsigned*)((const char*)(gbase) + (voff)[_i]), (PG8_LAS unsigned*)(lds + (bufoff) + ldsw + _i * 8192), 16, 0, 0); } while (0)
#define PG8_LDA(dst, b, h) do { _Pragma("unroll") for (int m = 0; m < 4; ++m) _Pragma("unroll") for (int k = 0; k < 2; ++k) dst[m][k] = *(const PG8_LAS bf16x8*)(lds + PG8_SA(b, h) + aoff + m * 2048 + k * 1024); } while (0)
#define PG8_LDB(dst, b, h) do { _Pragma("unroll") for (int n = 0; n < 2; ++n) _Pragma("unroll") for (int k = 0; k < 2; ++k) dst[n][k] = *(const PG8_LAS bf16x8*)(lds + PG8_SB(b, h) + boff + n * 2048 + k * 1024); } while (0)
#define PG8_MMA(ai, bj, At, Bt) do { __builtin_amdgcn_s_setprio(1); _Pragma("unroll") for (int m = 0; m < 4; ++m) _Pragma("unroll") for (int n = 0; n < 2; ++n) _Pragma("unroll") for (int k = 0; k < 2; ++k) \
        acc[ai][bj][m][n] = __builtin_amdgcn_mfma_f32_16x16x32_bf16(Bt[n][k], At[m][k], acc[ai][bj][m][n], 0, 0, 0); __builtin_amdgcn_s_setprio(0); } while (0)
#define PG8_WAIT_V(n) asm volatile("s_waitcnt vmcnt(" #n ")" ::: "memory")
#define PG8_WAIT_L(n) asm volatile("s_waitcnt lgkmcnt(" #n ")" ::: "memory")
#define PG8_BAR __builtin_amdgcn_s_barrier()
#define PG8_SCHED __builtin_amdgcn_sched_barrier(0)
    Unit cur, nxt; int ui = 0;
    if (!S.next(0, cur)) return;
    f32x4 acc[2][2][4][2];
#pragma unroll
    for (int a = 0; a < 2; ++a)
#pragma unroll
        for (int b = 0; b < 2; ++b)
#pragma unroll
            for (int m = 0; m < 4; ++m)
#pragma unroll
                for (int n = 0; n < 2; ++n) acc[a][b][m][n] = (f32x4){0.f, 0.f, 0.f, 0.f};
    bf16x8 At[4][2], B0[2][2], B1[2][2];
    const char* cA = (const char*)g.A + (size_t)cur.pm * tstepA; const char* cB = (const char*)g.Bt + (size_t)cur.pn * tstepB;
    PG8_STAGE(PG8_SB(0, 0), cB, voffB); PG8_STAGE(PG8_SB(0, 1), cB + hstepB, voffB); PG8_STAGE(PG8_SA(0, 0), cA, voffA); PG8_STAGE(PG8_SA(0, 1), cA + hstepA, voffA);
    if (wr == 1) PG8_BAR;
    PG8_WAIT_V(2); PG8_BAR;
    PG8_STAGE(PG8_SB(1, 0), cB + kstep, voffB); PG8_STAGE(PG8_SA(1, 0), cA + kstep, voffA); PG8_STAGE(PG8_SB(1, 1), cB + hstepB + kstep, voffB);
    PG8_WAIT_V(6); PG8_BAR;
    for (;;) {
        const bool has_next = S.next(ui + 1, nxt);
        const char* nA = has_next ? (const char*)g.A + (size_t)nxt.pm * tstepA : cA; const char* nB = has_next ? (const char*)g.Bt + (size_t)nxt.pn * tstepB : cB;
        for (int t = 0; t < nt; t += 2) {
            const bool last = (t == nt - 2);
            const char* a1 = cA + (size_t)(t + 1) * kstep;
            const char* a2 = last ? nA : cA + (size_t)(t + 2) * kstep; const char* b2 = last ? nB : cB + (size_t)(t + 2) * kstep;
            const char* a3 = a2 + kstep; const char* b3 = b2 + kstep;
            PG8_LDB(B0, 0, 0); PG8_LDB(B1, 0, 1); PG8_SCHED; PG8_LDA(At, 0, 0); PG8_STAGE(PG8_SA(1, 1), a1 + hstepA, voffA);
            PG8_WAIT_V(8); PG8_WAIT_L(0); PG8_BAR; PG8_MMA(0, 0, At, B0); PG8_MMA(0, 1, At, B1); PG8_BAR; PG8_SCHED;
            PG8_LDA(At, 0, 1); PG8_STAGE(PG8_SB(0, 0), b2, voffB); PG8_STAGE(PG8_SB(0, 1), b2 + hstepB, voffB); PG8_STAGE(PG8_SA(0, 0), a2, voffA);
            PG8_WAIT_V(8); PG8_WAIT_L(0); PG8_BAR; PG8_MMA(1, 0, At, B0); PG8_MMA(1, 1, At, B1); PG8_BAR; PG8_SCHED;
            PG8_LDB(B0, 1, 0); PG8_LDB(B1, 1, 1); PG8_SCHED; PG8_LDA(At, 1, 0); PG8_STAGE(PG8_SA(0, 1), a2 + hstepA, voffA);
            PG8_WAIT_V(8); PG8_WAIT_L(0); PG8_BAR; PG8_MMA(0, 0, At, B0); PG8_MMA(0, 1, At, B1); PG8_BAR; PG8_SCHED;
            PG8_LDA(At, 1, 1); PG8_STAGE(PG8_SB(1, 0), b3, voffB); PG8_STAGE(PG8_SB(1, 1), b3 + hstepB, voffB); PG8_STAGE(PG8_SA(1, 0), a3, voffA);
            PG8_WAIT_V(8); PG8_WAIT_L(0); PG8_BAR; PG8_MMA(1, 0, At, B0); PG8_MMA(1, 1, At, B1); PG8_BAR; PG8_SCHED;
        }
        if (wr == 0) PG8_BAR;
        E(acc, cur, wr, wc, fr, fq);
        if (!has_next) break;
#pragma unroll
        for (int a = 0; a < 2; ++a)
#pragma unroll
            for (int b = 0; b < 2; ++b)
#pragma unroll
                for (int m = 0; m < 4; ++m)
#pragma unroll
                    for (int n = 0; n < 2; ++n) acc[a][b][m][n] = (f32x4){0.f, 0.f, 0.f, 0.f};
        cur = nxt; cA = nA; cB = nB; ++ui;
        if (wr == 1) PG8_BAR;
    }
    PG8_WAIT_V(0);
    PG8_BAR;
#undef PG8_SA
#undef PG8_SB
#undef PG8_STAGE
#undef PG8_LDA
#undef PG8_LDB
#undef PG8_MMA
#undef PG8_WAIT_V
#undef PG8_WAIT_L
#undef PG8_BAR
#undef PG8_SCHED
}
}

#define GAS __attribute__((address_space(1)))
#define LAS __attribute__((address_space(3)))
typedef unsigned short bf16_t;
typedef short bf16x8 __attribute__((ext_vector_type(8)));
typedef short s16x4 __attribute__((ext_vector_type(4)));
typedef float f32x4 __attribute__((ext_vector_type(4)));
typedef float f32x16 __attribute__((ext_vector_type(16)));
typedef unsigned u32x4 __attribute__((ext_vector_type(4)));
typedef unsigned u32x2 __attribute__((ext_vector_type(2)));

constexpr int DM = 2048, BATCH = 4, SEQ = 4096, M = BATCH * SEQ, DFF = 5632, NIN = 12288, NGU = 11264, QKVP = 6144;
constexpr int NWAVES = 8, NTHR = 512;
constexpr size_t MiB = 1u << 20;
constexpr size_t WS_CTR = 0, WS_SS = 64 * 1024, WS_LUT = 512 * 1024, WS_KM = 1 * MiB;
constexpr size_t WS_WIN = 4 * MiB, WS_WBR = 100 * MiB, WS_WOUT = 116 * MiB, WS_WGU = 132 * MiB, WS_WDN = 220 * MiB;
constexpr size_t WS_XB = 264 * MiB, WS_QKV = 328 * MiB, WS_GATES = 520 * MiB, WS_END = 712 * MiB;
constexpr int LDS_BYTES = 143360;
constexpr int ATT_V_OFF = 0, ATT_LUT_OFF = 65536, ATT_KM_OFF = 81920, DIL_K_OFF = 73728, MISC_OFF = 142336;

struct Args {
    const float* x; const float* g_mix; const float* w_in; const float* q_gain; const float* k_gain; const float* w_branch; const float* w_out;
    const float* g_ffn; const float* w_gu; const float* w_down; const float* rel_bias;
    float* out; unsigned char* ws; int ph_lo, ph_hi;
};

__device__ __forceinline__ unsigned f2bf(float f) { unsigned u = __builtin_bit_cast(unsigned, f); return (u + 0x7fffu + ((u >> 16) & 1u)) >> 16; }
__device__ __forceinline__ unsigned pk2(float lo, float hi) { return pg8::cvt_pk_bf16(lo, hi); }
__device__ __forceinline__ float wave_sum(float v) {
#pragma unroll
    for (int o = 1; o < 64; o <<= 1) v += __shfl_xor(v, o);
    return v;
}

template <bool GU>
__device__ __forceinline__ void transpose_item(const float* W, const float* gk, int K, int N, bf16_t* WT, LAS float* scr, int item, int lane) {
    const int nblk = N / 32, kb = item / nblk, nb = item % nblk, k0 = 64 * kb, n0 = 32 * nb;
    float v[32];
#pragma unroll
    for (int i = 0; i < 32; ++i) v[i] = W[(size_t)(k0 + 2 * i + (lane >> 5)) * N + n0 + (lane & 31)];
#pragma unroll
    for (int i = 0; i < 32; ++i) { const int kk = 2 * i + (lane >> 5); if (gk) v[i] *= gk[k0 + kk]; scr[kk * 33 + (lane & 31)] = v[i]; }
    asm volatile("s_waitcnt lgkmcnt(0)" ::: "memory");
    const int c = lane & 7;
#pragma unroll
    for (int j = 0; j < 4; ++j) { const int n = (lane >> 3) + 8 * j; const LAS float* s = scr + (8 * c) * 33 + n;
        u32x4 o; o.x = pk2(s[0 * 33], s[1 * 33]); o.y = pk2(s[2 * 33], s[3 * 33]); o.z = pk2(s[4 * 33], s[5 * 33]); o.w = pk2(s[6 * 33], s[7 * 33]);
        int col = n0 + n, drow;
        if (GU) { const int half = col >= DFF ? 1 : 0, jj = col - half * DFF; drow = 256 * (jj >> 7) + 128 * half + (jj & 127); } else drow = col;
        *(u32x4*)(WT + (size_t)drow * K + k0 + 8 * c) = o; }
    asm volatile("s_waitcnt lgkmcnt(0)" ::: "memory");
}

__device__ __forceinline__ void phase_prologue(const Args& a, LAS unsigned char* lds, int tid, int lane, int wave) {
    unsigned char* ws = a.ws;
    LAS float* scr = (LAS float*)(lds + wave * 16384);
    int NGW = gridDim.x * NWAVES; asm volatile("" : "+s"(NGW));
    const int gw = blockIdx.x * NWAVES + wave;
    constexpr int I_IN = (DM / 64) * (NIN / 32), I_BR = (DM / 64) * (DM / 32), I_OUT = I_BR, I_GU = (DM / 64) * (NGU / 32), I_DN = (DFF / 64) * (DM / 32);
    constexpr int I_LAYER = I_IN + I_BR + I_OUT + I_GU + I_DN;
    for (int it = gw; it < 2 * I_LAYER; it += NGW) {
        const int l = it / I_LAYER; int r = it % I_LAYER;
        if (r < I_IN) { transpose_item<false>(a.w_in + (size_t)l * DM * NIN, a.g_mix + l * DM, DM, NIN, (bf16_t*)(ws + WS_WIN) + (size_t)l * NIN * DM, scr, r, lane); continue; } r -= I_IN;
        if (r < I_BR) { transpose_item<false>(a.w_branch + (size_t)l * DM * DM, nullptr, DM, DM, (bf16_t*)(ws + WS_WBR) + (size_t)l * DM * DM, scr, r, lane); continue; } r -= I_BR;
        if (r < I_OUT) { transpose_item<false>(a.w_out + (size_t)l * DM * DM, nullptr, DM, DM, (bf16_t*)(ws + WS_WOUT) + (size_t)l * DM * DM, scr, r, lane); continue; } r -= I_OUT;
        if (r < I_GU) { transpose_item<true>(a.w_gu + (size_t)l * DM * NGU, a.g_ffn + l * DM, DM, NGU, (bf16_t*)(ws + WS_WGU) + (size_t)l * NGU * DM, scr, r, lane); continue; } r -= I_GU;
        transpose_item<false>(a.w_down + (size_t)l * DFF * DM, nullptr, DFF, DM, (bf16_t*)(ws + WS_WDN) + (size_t)l * DM * DFF, scr, r, lane);
    }
    float* ss = (float*)(ws + WS_SS);
    for (int m = gw; m < M; m += NGW) {
        const f32x4* xr = (const f32x4*)(a.x + (size_t)m * DM) + lane; u32x2* o8 = (u32x2*)((bf16_t*)(ws + WS_XB) + (size_t)m * DM) + lane;
        float s = 0.f;
#pragma unroll
        for (int j = 0; j < 8; ++j) { const f32x4 v = xr[64 * j]; s += (v.x * v.x + v.y * v.y) + (v.z * v.z + v.w * v.w); u32x2 w; w.x = pk2(v.x, v.y); w.y = pk2(v.z, v.w); o8[64 * j] = w; }
        s = wave_sum(s);
        if (lane == 0) ss[m] = s;
    }
    int NGT = gridDim.x * NTHR; asm volatile("" : "+s"(NGT));
    const int gt = blockIdx.x * NTHR + tid;
    for (int i = gt; i < 3 * M; i += NGT) ss[M + i] = 0.f;
    if (gt < 1024) ((unsigned*)(ws + WS_CTR))[gt] = 0u;
    float* lut = (float*)(ws + WS_LUT);
    for (int i = gt; i < 12 * 4096; i += NGT) { const int hs = i >> 12, d = i & 4095; int bucket;
        if (d < 16) bucket = d; else { const float df = (float)d; int large = 16 + (int)(logf(df / 16.0f) / 4.852030263919617f * 16.0f); bucket = large < 31 ? large : 31; }
        lut[i] = a.rel_bias[bucket * 12 + hs] * 1.4426950408889634f; }
}

__device__ __forceinline__ void phase_qknorm(const Args& a, int l, LAS unsigned char* lds, int tid, int lane, int wave) {
    bf16_t* qkv = (bf16_t*)(a.ws + WS_QKV); float* kmean = (float*)(a.ws + WS_KM);
    LAS float* red = (LAS float*)lds;
    for (int it = blockIdx.x; it < 1536; it += gridDim.x) {
        const int kind = it / 768, rem = it % 768, b = rem / 192, hs = (rem % 192) / 16, blk = rem % 16;
        const float* gain = (kind ? a.k_gain : a.q_gain) + (size_t)l * 12 * 128 + hs * 128 + (lane & 15) * 8;
        float gn[8];
#pragma unroll
        for (int e = 0; e < 8; ++e) gn[e] = gain[e];
        bf16_t* base = qkv + (size_t)(b * SEQ + blk * 256 + wave * 32) * QKVP + kind * 2048 + (4 + hs) * 128 + (lane & 15) * 8;
        float ks[8];
#pragma unroll
        for (int e = 0; e < 8; ++e) ks[e] = 0.f;
        u32x4 wv[8];
#pragma unroll
        for (int ii = 0; ii < 8; ++ii) wv[ii] = *(const u32x4*)(base + (size_t)(4 * ii + (lane >> 4)) * QKVP);
#pragma unroll
        for (int ii = 0; ii < 8; ++ii) { bf16_t* p = base + (size_t)(4 * ii + (lane >> 4)) * QKVP;
            const u32x4 w = wv[ii]; float v[8];
            v[0] = pg8::bf_lo(w.x); v[1] = pg8::bf_hi(w.x); v[2] = pg8::bf_lo(w.y); v[3] = pg8::bf_hi(w.y); v[4] = pg8::bf_lo(w.z); v[5] = pg8::bf_hi(w.z); v[6] = pg8::bf_lo(w.w); v[7] = pg8::bf_hi(w.w);
            float s = 0.f;
#pragma unroll
            for (int e = 0; e < 8; ++e) s += v[e] * v[e];
            s += __shfl_xor(s, 1); s += __shfl_xor(s, 2); s += __shfl_xor(s, 4); s += __shfl_xor(s, 8);
            const float rs = rsqrtf(s * (1.0f / 128.0f) + 1e-6f);
#pragma unroll
            for (int e = 0; e < 8; ++e) { v[e] = v[e] * rs * gn[e]; ks[e] += v[e]; }
            u32x4 o; o.x = pk2(v[0], v[1]); o.y = pk2(v[2], v[3]); o.z = pk2(v[4], v[5]); o.w = pk2(v[6], v[7]);
            *(u32x4*)p = o; }
        const bool km = (kind == 1) && (hs < 6);
        if (km) {
#pragma unroll
            for (int e = 0; e < 8; ++e) { ks[e] += __shfl_xor(ks[e], 16); ks[e] += __shfl_xor(ks[e], 32); }
            if (lane < 16) {
#pragma unroll
                for (int e = 0; e < 8; ++e) red[wave * 128 + lane * 8 + e] = ks[e]; }
        }
        __syncthreads();
        if (km && tid < 128) { float s = 0.f;
#pragma unroll
            for (int w = 0; w < 8; ++w) s += red[w * 128 + tid];
            kmean[((size_t)(b * 6 + hs) * 16 + blk) * 128 + tid] = s * (1.0f / 256.0f); }
        __syncthreads();
    }
}

namespace att {
constexpr float SCALE = 0.08838834764831845f, LOG2E = 1.4426950408889634f, NEG = -1e30f, C1 = SCALE * LOG2E;
__device__ __forceinline__ unsigned offa(unsigned row, unsigned ch) { return 2048u * (row >> 3) + 512u * (ch >> 2) + 64u * (row & 7u) + 16u * ((ch & 3u) ^ ((row >> 2) & 3u)); }
__device__ __forceinline__ int clamp_s(int s) { return s < 0 ? 0 : (s > SEQ - 1 ? SEQ - 1 : s); }
__device__ __forceinline__ void load_k(bf16x8 (&kf)[8], const bf16_t* Kb, int s0, int stride, int lane) {
    const int s = clamp_s(s0 + stride * (lane & 31));
    const GAS bf16x8* p = (const GAS bf16x8*)(Kb + (size_t)s * QKVP + 8 * (lane >> 5));
#pragma unroll
    for (int j = 0; j < 8; ++j) kf[j] = p[2 * j];
}
__device__ __forceinline__ void load_v(u32x4 (&vr)[8], const bf16_t* Vb, int s0, int stride, int lane) {
#pragma unroll
    for (int ii = 0; ii < 8; ++ii) { const int s = clamp_s(s0 + stride * ((lane >> 4) + 4 * ii)); vr[ii] = *(const GAS u32x4*)(Vb + (size_t)s * QKVP + (lane & 15) * 8); }
}
__device__ __forceinline__ void stage_v(LAS unsigned char* vl, const u32x4 (&vr)[8], int lane) {
    const unsigned ch = lane & 15, wl = 512u * (ch >> 2) + 64u * (unsigned)(lane >> 4);
#pragma unroll
    for (int ii = 0; ii < 8; ++ii) *(LAS u32x4*)(vl + wl + 16u * ((ch & 3u) ^ (unsigned)(ii & 3)) + 2048 * (ii >> 1) + 256 * (ii & 1)) = vr[ii];
}
__device__ __forceinline__ f32x16 qk(const bf16x8 (&kf)[8], const bf16x8 (&qf)[8]) {
    f32x16 acc = {0.f, 0.f, 0.f, 0.f, 0.f, 0.f, 0.f, 0.f, 0.f, 0.f, 0.f, 0.f, 0.f, 0.f, 0.f, 0.f};
#pragma unroll
    for (int j = 0; j < 8; ++j) acc = __builtin_amdgcn_mfma_f32_32x32x16_bf16(kf[j], qf[j], acc, 0, 0, 0);
    return acc;
}
typedef short v4i16_t __attribute__((ext_vector_type(4)));
__device__ __forceinline__ s16x4 vtr(LAS unsigned char* p) { return __builtin_bit_cast(s16x4, __builtin_amdgcn_ds_read_tr16_b64_v4i16((LAS v4i16_t*)p)); }
__device__ __forceinline__ void pv(f32x16 (&o)[4], LAS unsigned char* vl, bf16x8 P0, bf16x8 P1, int lane) {
    const unsigned h = lane >> 5, blk = (lane >> 4) & 1, q = (lane & 15) >> 2, p = lane & 3;
    const unsigned lb = 64u * (4u * h + q) + 16u * ((p >> 1) ^ h) + 8u * (p & 1u);
    LAS unsigned char* b0 = vl + lb + 32u * blk; LAS unsigned char* b1 = vl + lb + 32u * (blk ^ 1u) + 2048u;
#pragma unroll
    for (int hf = 0; hf < 2; ++hf) {
        s16x4 lo[2][2], hi[2][2];
#pragma unroll
        for (int cc = 0; cc < 2; ++cc)
#pragma unroll
            for (int s = 0; s < 2; ++s) { lo[cc][s] = vtr(b0 + 4096 * s + 512 * (2 * hf + cc)); hi[cc][s] = vtr(b1 + 4096 * s + 512 * (2 * hf + cc)); }
        asm volatile("s_waitcnt lgkmcnt(0)" ::: "memory");
        __builtin_amdgcn_sched_barrier(0);
#pragma unroll
        for (int cc = 0; cc < 2; ++cc)
#pragma unroll
            for (int s = 0; s < 2; ++s) {
                const bf16x8 A = {lo[cc][s][0], lo[cc][s][1], lo[cc][s][2], lo[cc][s][3], hi[cc][s][0], hi[cc][s][1], hi[cc][s][2], hi[cc][s][3]};
                o[2 * hf + cc] = __builtin_amdgcn_mfma_f32_32x32x16_bf16(A, s ? P1 : P0, o[2 * hf + cc], 0, 0, 0);
            }
        __builtin_amdgcn_sched_barrier(0);
    }
}
typedef float f32x2_t __attribute__((ext_vector_type(2))); typedef __bf16 bf16x2_t __attribute__((ext_vector_type(2)));
__device__ __forceinline__ unsigned cvtpk(float lo, float hi) { f32x2_t v = {lo, hi}; bf16x2_t b = __builtin_convertvector(v, bf16x2_t); return __builtin_bit_cast(unsigned, b); }
__device__ __forceinline__ void pack_p(const float (&p)[16], bf16x8& P0, bf16x8& P1) {
    u32x4 a, b; a.x = cvtpk(p[0], p[1]); a.y = cvtpk(p[2], p[3]); a.z = cvtpk(p[4], p[5]); a.w = cvtpk(p[6], p[7]);
    b.x = cvtpk(p[8], p[9]); b.y = cvtpk(p[10], p[11]); b.z = cvtpk(p[12], p[13]); b.w = cvtpk(p[14], p[15]);
    P0 = __builtin_bit_cast(bf16x8, a); P1 = __builtin_bit_cast(bf16x8, b);
}
__device__ __forceinline__ void softmax_step(float (&x)[16], float& m, float& l, f32x16 (&o)[4], bf16x8& P0, bf16x8& P1) {
    float mx = fmaxf(x[0], x[1]);
#pragma unroll
    for (int r = 2; r < 16; ++r) mx = fmaxf(mx, x[r]);
    mx = fmaxf(mx, __shfl_xor(mx, 32));
    const float mn = fmaxf(m, mx);
    const float alpha = __builtin_amdgcn_exp2f(m - mn);
    float ls = 0.f;
#pragma unroll
    for (int r = 0; r < 16; ++r) { const float p = __builtin_amdgcn_exp2f(x[r] - mn); ls += p; x[r] = p; }
    l = l * alpha + ls; m = mn;
    if (__any(alpha != 1.0f)) {
#pragma unroll
        for (int c = 0; c < 4; ++c) o[c] = o[c] * alpha;
    }
    pack_p(x, P0, P1);
}
__device__ __forceinline__ void softmax_fixed(float (&x)[16], float& l, bf16x8& P0, bf16x8& P1) {
    float ls = 0.f;
#pragma unroll
    for (int r = 0; r < 16; ++r) { const float p = __builtin_amdgcn_exp2f(x[r]); ls += p; x[r] = p; }
    l += ls;
    pack_p(x, P0, P1);
}
__device__ __forceinline__ float softmax_ref(const Args& a, int l, int hs, const bf16x8 (&qf)[8], int lane) {
    const float* kg = a.k_gain + (size_t)l * 12 * 128 + hs * 128;
    float gm = fmaxf(fabsf(kg[lane]), fabsf(kg[lane + 64]));
    float bm = a.rel_bias[(lane & 31) * 12 + hs];
#pragma unroll
    for (int o_ = 1; o_ < 64; o_ <<= 1) { gm = fmaxf(gm, __shfl_xor(gm, o_)); bm = fmaxf(bm, __shfl_xor(bm, o_)); }
    float qs = 0.f;
#pragma unroll
    for (int j = 0; j < 8; ++j) { const u32x4 qw = __builtin_bit_cast(u32x4, qf[j]);
        const float q0 = pg8::bf_lo(qw.x), q1 = pg8::bf_hi(qw.x), q2 = pg8::bf_lo(qw.y), q3 = pg8::bf_hi(qw.y), q4 = pg8::bf_lo(qw.z), q5 = pg8::bf_hi(qw.z), q6 = pg8::bf_lo(qw.w), q7 = pg8::bf_hi(qw.w);
        qs += (q0 * q0 + q1 * q1) + (q2 * q2 + q3 * q3) + (q4 * q4 + q5 * q5) + (q6 * q6 + q7 * q7); }
    qs += __shfl_xor(qs, 32);
    return C1 * sqrtf(qs) * (11.3137085f * 1.004f * gm) + bm * LOG2E + 1e-3f;
}
__device__ __forceinline__ void store_o(const f32x16 (&o)[4], float inv, bf16_t* orow, int lane) {
    const int h = lane >> 5;
#pragma unroll
    for (int c = 0; c < 4; ++c)
#pragma unroll
        for (int i = 0; i < 4; ++i) { u32x2 w; w.x = cvtpk(o[c][4 * i] * inv, o[c][4 * i + 1] * inv); w.y = cvtpk(o[c][4 * i + 2] * inv, o[c][4 * i + 3] * inv);
            *(GAS u32x2*)(orow + 32 * c + 8 * i + 4 * h) = w; }
}
__device__ __forceinline__ void load_q(bf16x8 (&qf)[8], const bf16_t* qrow, int lane) {
    const GAS bf16x8* p = (const GAS bf16x8*)(qrow + 8 * (lane >> 5));
#pragma unroll
    for (int j = 0; j < 8; ++j) qf[j] = p[2 * j];
}

__device__ __forceinline__ void unit_moba(const Args& a, int lyr, bf16_t* Ob, int OP, int b, int hm, int qb, LAS unsigned char* lds, int tid, int lane, int wave) {
    asm volatile("" : "+v"(lane));
    const bf16_t* qkv = (const bf16_t*)(a.ws + WS_QKV);
    LAS float* lutL = (LAS float*)(lds + ATT_LUT_OFF); LAS float* kmL = (LAS float*)(lds + ATT_KM_OFF);
    { const float* lutG = (const float*)(a.ws + WS_LUT) + hm * 4096;
#pragma unroll
      for (int k_ = 0; k_ < 8; ++k_) lutL[tid + k_ * NTHR] = lutG[tid + k_ * NTHR];
      const float* kmG = (const float*)(a.ws + WS_KM) + (size_t)(b * 6 + hm) * 16 * 128;
#pragma unroll
      for (int k_ = 0; k_ < 4; ++k_) kmL[tid + k_ * NTHR] = kmG[tid + k_ * NTHR]; }
    __syncthreads();
    const int h = lane >> 5, t0 = qb * 256, tw = t0 + 32 * wave, t = tw + (lane & 31), hg = 4 + hm;
    const bf16_t* Kb = qkv + (size_t)b * SEQ * QKVP + 2048 + hg * 128; const bf16_t* Vb = Kb + 2048;
    bf16x8 qf[8]; load_q(qf, qkv + (size_t)(b * SEQ + t) * QKVP + hg * 128, lane);
    unsigned selmask = 0u, anymask = 0u;
    if (qb > 0) {
        float v1 = -3e38f, v2 = -3e38f, v3 = -3e38f; int i1 = -1, i2 = -1, i3 = -1;
        for (int n = 0; n < qb; ++n) {
            float g = 0.f;
#pragma unroll
            for (int j = 0; j < 8; ++j) { const LAS f32x4* kp = (const LAS f32x4*)(kmL + n * 128 + 16 * j + 8 * h); const f32x4 k0 = kp[0], k1 = kp[1];
                const u32x4 qw = __builtin_bit_cast(u32x4, qf[j]);
                g += pg8::bf_lo(qw.x) * k0[0] + pg8::bf_hi(qw.x) * k0[1] + pg8::bf_lo(qw.y) * k0[2] + pg8::bf_hi(qw.y) * k0[3]
                   + pg8::bf_lo(qw.z) * k1[0] + pg8::bf_hi(qw.z) * k1[1] + pg8::bf_lo(qw.w) * k1[2] + pg8::bf_hi(qw.w) * k1[3]; }
            g += __shfl_xor(g, 32);
            if (g > v1) { v3 = v2; i3 = i2; v2 = v1; i2 = i1; v1 = g; i1 = n; } else if (g > v2) { v3 = v2; i3 = i2; v2 = g; i2 = n; } else if (g > v3) { v3 = g; i3 = n; }
        }
        if (i1 >= 0) selmask |= 1u << i1; if (i2 >= 0) selmask |= 1u << i2; if (i3 >= 0) selmask |= 1u << i3;
        for (int n = 0; n < qb; ++n) if (__ballot((selmask >> n) & 1u) != 0ull) anymask |= 1u << n;
    }
    volatile LAS unsigned* misc = (volatile LAS unsigned*)(lds + MISC_OFF);
    if (tid == 0) misc[4] = 0u;
    __syncthreads();
    if (lane == 0 && anymask != 0u) __hip_atomic_fetch_or((LAS unsigned*)(lds + MISC_OFF + 16), anymask, __ATOMIC_RELAXED, __HIP_MEMORY_SCOPE_WORKGROUP);
    __syncthreads();
    const unsigned anywg = misc[4];
    const float nref = -softmax_ref(a, lyr, hm, qf, lane);
    float l = 0.f; f32x16 o[4];
#pragma unroll
    for (int c = 0; c < 4; ++c) o[c] = (f32x16){0.f, 0.f, 0.f, 0.f, 0.f, 0.f, 0.f, 0.f, 0.f, 0.f, 0.f, 0.f, 0.f, 0.f, 0.f, 0.f};
    const int srow = 8 * (wave >> 1) + ((lane >> 2) & 7), sch = 4 * (2 * (wave & 1) + (lane >> 5)) + ((lane & 3) ^ ((srow >> 2) & 3));
    const bf16_t* kg = Kb + (size_t)srow * QKVP + sch * 8; const bf16_t* vg = Vb + (size_t)srow * QKVP + sch * 8;
    const int r31 = lane & 31; const unsigned x0 = (r31 >> 2) & 1, x1 = (r31 >> 3) & 1;
    const unsigned kb_l = 2048u * (r31 >> 3) + 64u * (r31 & 7) + 16u * ((unsigned)h ^ x0);
    const unsigned ke0 = kb_l + 32u * x1, ke1 = kb_l + 32u * (x1 ^ 1u);
#define MOBA_STAGE(buf, nblk, stp) do { const size_t ro_ = (size_t)(256 * (nblk) + 64 * (stp)) * QKVP; LAS unsigned char* d_ = lds + ATT_V_OFF + (buf) * 32768 + wave * 1024; \
        __builtin_amdgcn_global_load_lds((const unsigned*)(kg + ro_), (LAS unsigned*)(d_), 16, 0, 0); \
        __builtin_amdgcn_global_load_lds((const unsigned*)(kg + ro_ + 32 * QKVP), (LAS unsigned*)(d_ + 8192), 16, 0, 0); \
        __builtin_amdgcn_global_load_lds((const unsigned*)(vg + ro_), (LAS unsigned*)(d_ + 16384), 16, 0, 0); \
        __builtin_amdgcn_global_load_lds((const unsigned*)(vg + ro_ + 32 * QKVP), (LAS unsigned*)(d_ + 24576), 16, 0, 0); } while (0)
    int n = qb, st = 3;
    MOBA_STAGE(0, n, st);
    asm volatile("s_waitcnt vmcnt(0)" ::: "memory");
    __syncthreads();
    int cur = 0;
    for (;;) {
        int nn = n, nst = st; bool has_next = true;
        if (n == qb) { if (st > 0) nst = st - 1; else { if (anywg == 0u) has_next = false; else { nn = __builtin_ctz(anywg); nst = 0; } } }
        else { if (st < 3) nst = st + 1; else { const unsigned rest = anywg & ~((2u << n) - 1u); if (rest == 0u) has_next = false; else { nn = __builtin_ctz(rest); nst = 0; } } }
        if (has_next) MOBA_STAGE(cur ^ 1, nn, nst);
        const bool own = (n == qb);
        const bool active = own ? (2 * st <= wave) : (((anymask >> (n & 31)) & 1u) != 0u);
        if (active) {
            LAS unsigned char* kl = lds + ATT_V_OFF + cur * 32768;
            const int dbase = t - (256 * n + 64 * st);
            const float lanebias = own ? nref : (((selmask >> (n & 31)) & 1u) ? nref : NEG);
            bf16x8 PA0, PA1, PB0, PB1;
#pragma unroll
            for (int tt = 0; tt < 2; ++tt) {
                bf16x8 kc[8];
#pragma unroll
                for (int s = 0; s < 8; ++s) kc[s] = *(const LAS bf16x8*)(kl + 8192 * tt + ((s & 1) ? ke1 : ke0) + 512 * (s >> 1));
                asm volatile("s_waitcnt lgkmcnt(0)" ::: "memory"); __builtin_amdgcn_sched_barrier(0);
                const f32x16 sacc = qk(kc, qf);
                const int db = dbase - 32 * tt;
                float x[16];
                if (own) {
#pragma unroll
                    for (int r = 0; r < 16; ++r) { const int dist = db - (8 * (r >> 2) + 4 * h + (r & 3)); const float lvv = lutL[dist < 0 ? 0 : dist];
                        const float xx = __builtin_fmaf(sacc[r], C1, lvv) + nref; x[r] = (dist >= 0) ? xx : NEG; }
                } else {
                    const LAS float* lp = lutL + (db - 4 * h);
#pragma unroll
                    for (int r = 0; r < 16; ++r) x[r] = __builtin_fmaf(sacc[r], C1, lp[-(8 * (r >> 2) + (r & 3))]) + lanebias;
                }
                if (tt == 0) softmax_fixed(x, l, PA0, PA1); else softmax_fixed(x, l, PB0, PB1);
            }
            pv(o, kl + 16384, PA0, PA1, lane);
            pv(o, kl + 24576, PB0, PB1, lane);
        }
        if (!has_next) break;
        asm volatile("s_waitcnt vmcnt(0)" ::: "memory");
        __syncthreads();
        n = nn; st = nst; cur ^= 1;
    }
#undef MOBA_STAGE
    l += __shfl_xor(l, 32);
    store_o(o, 1.0f / l, Ob + (size_t)(b * SEQ + t) * OP + hg * 128, lane);
}

__device__ __forceinline__ void dil_desc(int idx, int tb, int c4, int i, int& s0, int& stride, int& delta0, int& pat, int& aa) {
    if (idx < 5) { const int kt = 4 - idx; stride = 4; s0 = tb + c4 + 4 * (-128 + 32 * kt); delta0 = i + 128 - 32 * kt; pat = 0; aa = 0; }
    else if (idx < 13) { const int kt = idx - 5; stride = 1; s0 = tb - 128 + 32 * kt; delta0 = c4 + 4 * i + 128 - 32 * kt; pat = 1; aa = 0; }
    else { aa = (idx - 13) / 5; const int kt = (idx - 13) % 5; stride = 16; s0 = tb + c4 + 4 * aa + 16 * (-128 + 32 * kt); delta0 = (i >> 2) + 128 - 32 * kt; pat = 2; }
}
__device__ __forceinline__ void unit_dilated(const Args& a, int lyr, bf16_t* Ob, int OP, int b, int hd, int qb, LAS unsigned char* lds, int tid, int lane, int wave) {
    asm volatile("" : "+v"(lane));
    const bf16_t* qkv = (const bf16_t*)(a.ws + WS_QKV);
    LAS float* lut3 = (LAS float*)(lds + ATT_LUT_OFF);
    { const float* lutG = (const float*)(a.ws + WS_LUT) + (6 + hd) * 4096;

#pragma unroll
      for (int k_ = 0; k_ < 3; ++k_) { const int e = tid + k_ * NTHR; if (e >= 3 * 384) break; const int p = e / 384, d = e % 384 - 128; const int st = p == 0 ? 4 : (p == 1 ? 1 : 16); lut3[e] = (d >= 0 && d <= 128) ? lutG[st * d] : 0.f; } }
    __syncthreads();
    LAS unsigned char* vl = lds + ATT_V_OFF + wave * 8192;
    const int h = lane >> 5, i = lane & 31, t0 = qb * 256, tb = t0 + 128 * (wave >> 2), c4 = wave & 3, t = tb + c4 + 4 * i, hg = 10 + hd;
    const bf16_t* Kb = qkv + (size_t)b * SEQ * QKVP + 2048 + hg * 128; const bf16_t* Vb = Kb + 2048;
    bf16x8 qf[8]; load_q(qf, qkv + (size_t)(b * SEQ + t) * QKVP + hg * 128, lane);
    const float nref = -softmax_ref(a, lyr, 6 + hd, qf, lane);
    const unsigned dmax4 = (unsigned)((t >> 2) < 128 ? (t >> 2) : 128), dmax1 = (unsigned)(t < 128 ? t : 128), dmax16 = (unsigned)((t >> 4) < 128 ? (t >> 4) : 128);
    float l = 0.f; f32x16 o[4];
#pragma unroll
    for (int c = 0; c < 4; ++c) o[c] = (f32x16){0.f, 0.f, 0.f, 0.f, 0.f, 0.f, 0.f, 0.f, 0.f, 0.f, 0.f, 0.f, 0.f, 0.f, 0.f, 0.f};
    LAS unsigned char* kl = lds + DIL_K_OFF + wave * 8192;
    const int kc_ = (lane >> 2) & 7, kd_ = lane & 3;
#define DIL_KDMA(s0v, strv) do { _Pragma("unroll") for (int i_ = 0; i_ < 8; ++i_) { const int row_ = 8 * (i_ >> 1) + kc_; const int ch_ = 4 * (2 * (i_ & 1) + (lane >> 5)) + (kd_ ^ ((row_ >> 2) & 3)); \
        const int s_ = clamp_s((s0v) + (strv) * row_); \
        __builtin_amdgcn_global_load_lds((const unsigned*)(Kb + (size_t)s_ * QKVP + ch_ * 8), (LAS unsigned*)(kl + 1024 * i_), 16, 0, 0); } } while (0)
    const int r31 = lane & 31; const unsigned kx0 = (r31 >> 2) & 1, kx1 = (r31 >> 3) & 1;
    const unsigned kb_l = 2048u * (r31 >> 3) + 64u * (r31 & 7) + 16u * ((unsigned)h ^ kx0);
    const unsigned ke0 = kb_l + 32u * kx1, ke1 = kb_l + 32u * (kx1 ^ 1u);
    u32x4 vr[8];
    int s0, stride, delta0, pat, aa;
    dil_desc(0, tb, c4, i, s0, stride, delta0, pat, aa);
    DIL_KDMA(s0, stride); load_v(vr, Vb, s0, stride, lane);
    for (int idx = 0; idx < 33; ++idx) {
        asm volatile("s_waitcnt vmcnt(0)" ::: "memory");
        bf16x8 kc[8];
#pragma unroll
        for (int s = 0; s < 8; ++s) kc[s] = *(const LAS bf16x8*)(kl + ((s & 1) ? ke1 : ke0) + 512 * (s >> 1));
        asm volatile("s_waitcnt lgkmcnt(0)" ::: "memory"); __builtin_amdgcn_sched_barrier(0);
        int s0n = 0, stn = 1, d0n = 0, patn = 0, aan = 0;
        if (idx + 1 < 33) { dil_desc(idx + 1, tb, c4, i, s0n, stn, d0n, patn, aan); DIL_KDMA(s0n, stn); }
        const f32x16 sacc = qk(kc, qf);
        stage_v(vl, vr, lane);
        if (idx + 1 < 33) load_v(vr, Vb, s0n, stn, lane);
        const unsigned dmax = pat == 0 ? dmax4 : (pat == 1 ? dmax1 : dmax16);
        const float lb = (pat == 2 && (i & 3) != aa) ? NEG : nref;
        const int dk = delta0 - 4 * h;
        const LAS float* lp = lut3 + pat * 384 + 128 + dk;
        float x[16];
#pragma unroll
        for (int r = 0; r < 16; ++r) { const float lvv = lp[-(8 * (r >> 2) + (r & 3))]; const float xx = __builtin_fmaf(sacc[r], C1, lvv) + lb;
            const unsigned delta = (unsigned)(dk - (8 * (r >> 2) + (r & 3))); x[r] = (delta <= dmax) ? xx : NEG; }
        bf16x8 P0, P1; softmax_fixed(x, l, P0, P1);
        pv(o, vl, P0, P1, lane);
        s0 = s0n; stride = stn; delta0 = d0n; pat = patn; aa = aan;
    }
#undef DIL_KDMA
    l += __shfl_xor(l, 32);
    store_o(o, 1.0f / l, Ob + (size_t)(b * SEQ + t) * OP + hg * 128, lane);
}

__device__ __forceinline__ void unit_sb(const Args& a, bf16_t* Ob, int OP, int b, int ha, int qb, LAS unsigned char* lds, int tid, int lane, int wave) {
    asm volatile("" : "+v"(lane));
    const bf16_t* qkv = (const bf16_t*)(a.ws + WS_QKV);
    LAS unsigned char* vl = lds + ATT_V_OFF + wave * 8192;
    const int h = lane >> 5, t0 = qb * 256, tw = t0 + 32 * wave, t = tw + (lane & 31);
    const bf16_t* Kb = qkv + (size_t)b * SEQ * QKVP + 2048 + ha * 128; const bf16_t* Vb = Kb + 2048;
    bf16x8 qf[8]; load_q(qf, qkv + (size_t)(b * SEQ + t) * QKVP + ha * 128, lane);
    f32x16 o[4];
#pragma unroll
    for (int c = 0; c < 4; ++c) o[c] = (f32x16){0.f, 0.f, 0.f, 0.f, 0.f, 0.f, 0.f, 0.f, 0.f, 0.f, 0.f, 0.f, 0.f, 0.f, 0.f, 0.f};
    float R = 0.f;
    bf16x8 kc[8];
    int kt = tw >> 5;
    load_k(kc, Kb, 32 * kt, 1, lane);
    for (;;) {
        u32x4 vr[8]; load_v(vr, Vb, 32 * kt, 1, lane);
        const f32x16 sacc = qk(kc, qf);
        const bool more = kt > 0;
        if (more) load_k(kc, Kb, 32 * (kt - 1), 1, lane);
        stage_v(vl, vr, lane);
        const int dbase = t - 32 * kt;
        float lb[16], g[4], gp[4];
#pragma unroll
        for (int i = 0; i < 4; ++i) { g[i] = 0.f;
#pragma unroll
            for (int j = 0; j < 4; ++j) { const int r = 4 * i + j; const int kap = 8 * i + 4 * h + j; const bool past = kap < dbase;
                const float z = sacc[r] * SCALE; const float sp = __logf(1.0f + __expf(-fabsf(z)));
                lb[r] = fminf(z, 0.f) - sp; g[i] += past ? (lb[r] - z) : 0.f; }
            gp[i] = __shfl_xor(g[i], 32); }
        float sg[4]; sg[3] = 0.f; sg[2] = g[3] + gp[3]; sg[1] = sg[2] + g[2] + gp[2]; sg[0] = sg[1] + g[1] + gp[1];
        const float tot = sg[0] + g[0] + gp[0];
#pragma unroll
        for (int i = 0; i < 4; ++i) { const float basei = sg[i] + R + (h == 0 ? gp[i] : 0.f);
            float suf = 0.f;
#pragma unroll
            for (int j = 3; j >= 0; --j) { const int r = 4 * i + j; const int kap = 8 * i + 4 * h + j; const bool past = kap < dbase;
                const float l1 = past ? (lb[r] - sacc[r] * SCALE) : 0.f;
                lb[r] = past ? __expf(lb[r] + suf + basei) : 0.f; suf += l1; } }
        R += tot;
        bf16x8 P0, P1; pack_p(lb, P0, P1);
        pv(o, vl, P0, P1, lane);
        if (!more || __all(R < -110.0f)) break;
        --kt;
    }
    store_o(o, 1.0f, Ob + (size_t)(b * SEQ + t) * OP + ha * 128, lane);
}

__device__ __forceinline__ void phase_attention(const Args& a, int l, int rep, LAS unsigned char* lds, int tid, int lane, int wave) {
    unsigned* ctr0 = (unsigned*)(a.ws + WS_CTR) + (l + 2 * rep) * 64;
    bf16_t* Ob = l == 0 ? (bf16_t*)a.out : (bf16_t*)(a.ws + WS_QKV); const int OP = l == 0 ? DM : QKVP;
    volatile LAS unsigned* misc = (volatile LAS unsigned*)(lds + MISC_OFF);
    int xq = (int)((unsigned)__builtin_amdgcn_s_getreg((3 << 11) | 20) & 7u), left = 8;
    for (;;) {
        __syncthreads();
        if (tid == 0) misc[0] = atomicAdd(ctr0 + xq * 8, 1u);
        __syncthreads();
        const int j = (int)misc[0];
        if (j >= 128) { if (--left == 0) break; xq = (xq + 1) & 7; continue; }
        if (j < 48) { const int qb = 15 - j / 3, bh = 3 * xq + j % 3; unit_moba(a, l, Ob, OP, bh / 6, bh % 6, qb, lds, tid, lane, wave); }
        else if (j < 96) { const int jj = j - 48, qb = jj % 16, bh = 3 * xq + jj / 16; unit_dilated(a, l, Ob, OP, bh / 6, bh % 6, qb, lds, tid, lane, wave); }
        else { const int jj = j - 96, qb = 15 - jj / 2, bh = 2 * xq + jj % 2; unit_sb(a, Ob, OP, bh / 4, bh % 4, qb, lds, tid, lane, wave); }
    }
}
}

__device__ __forceinline__ void grid_barrier(unsigned* bar, unsigned k) {
    asm volatile("s_waitcnt vmcnt(0) lgkmcnt(0)" ::: "memory");
    __syncthreads();
    if (threadIdx.x == 0) {
        const unsigned G = gridDim.x, g = blockIdx.x & 7u, nloc = (G - g + 7u) >> 3, ngrp = G < 8u ? G : 8u;
        __builtin_amdgcn_fence(__ATOMIC_RELEASE, "agent");
        asm volatile("s_waitcnt vmcnt(0)" ::: "memory");
        const unsigned old = __hip_atomic_fetch_add(bar + 64 * g, 1u, __ATOMIC_RELAXED, __HIP_MEMORY_SCOPE_AGENT);
        if (old + 1u == nloc * k) __hip_atomic_fetch_add(bar + 512, 1u, __ATOMIC_RELAXED, __HIP_MEMORY_SCOPE_AGENT);
        unsigned spins = 0;
        while (__hip_atomic_load(bar + 512, __ATOMIC_RELAXED, __HIP_MEMORY_SCOPE_AGENT) < ngrp * k) { __builtin_amdgcn_s_sleep(2); if (++spins > (1u << 24)) break; }
        __builtin_amdgcn_fence(__ATOMIC_ACQUIRE, "agent");
        asm volatile("s_waitcnt vmcnt(0)" ::: "memory");
    }
    __syncthreads();
}

__global__ void __launch_bounds__(NTHR, 2) hybrid_fwd(Args a_) {
    __shared__ __attribute__((aligned(16))) unsigned char lds_raw[LDS_BYTES];
    LAS unsigned char* lds = (LAS unsigned char*)lds_raw;
    const int ph_lo = a_.ph_lo, ph_hi = a_.ph_hi;
    int n_grid = 0;
    for (int ph = ph_lo; ph < ph_hi; ++ph) {
        {
        constexpr int rep = 0;
        int tid = threadIdx.x; asm volatile("" : "+v"(tid));
        const int lane = tid & 63, wave = __builtin_amdgcn_readfirstlane(tid >> 6);
        const __attribute__((address_space(4))) Args* ap = (const __attribute__((address_space(4))) Args*)__builtin_amdgcn_kernarg_segment_ptr(); asm volatile("" : "+s"(ap));
        Args a; a.x = ap->x; a.g_mix = ap->g_mix; a.w_in = ap->w_in; a.q_gain = ap->q_gain; a.k_gain = ap->k_gain; a.w_branch = ap->w_branch; a.w_out = ap->w_out;
        a.g_ffn = ap->g_ffn; a.w_gu = ap->w_gu; a.w_down = ap->w_down; a.rel_bias = ap->rel_bias; a.out = ap->out; a.ws = ap->ws; a.ph_lo = 0; a.ph_hi = 0;
        unsigned char* ws = a.ws;
        const int G = gridDim.x, cidx = blockIdx.x;
        float* ss = (float*)(ws + WS_SS);
        bf16_t* xb = (bf16_t*)(ws + WS_XB); bf16_t* qkv = (bf16_t*)(ws + WS_QKV); bf16_t* gates = (bf16_t*)(ws + WS_GATES);
        bf16_t* ob = qkv; bf16_t* merged = qkv + 2048; bf16_t* act = qkv;
        if (ph == 0) phase_prologue(a, lds, tid, lane, wave);
        else {
            const int l = (ph - 1) / 7, k = (ph - 1) % 7;
            if (k == 0) {
                pg8::Gemm g{xb, (const bf16_t*)(ws + WS_WIN) + (size_t)l * NIN * DM, DM, DM, M, NIN, DM}; pg8::StaticOrder S; S.init(M, NIN, G, cidx);
                pg8::EpiIn E{qkv, gates, ss + (size_t)(2 * l) * M, a.q_gain + (size_t)l * 12 * 128, a.k_gain + (size_t)l * 12 * 128, (float*)(ws + WS_KM), lds + 132096};
                pg8::gemm_phase<pg8::EpiIn, pg8::StaticOrder>(lds, g, S, E, tid);
            } else if (k == 1) {   }
            else if (k == 2) att::phase_attention(a, l, rep, lds, tid, lane, wave);
            else if (k == 3) {
                const bf16_t* wbt = (const bf16_t*)(ws + WS_WBR) + (size_t)l * DM * DM;
                for (int br = 0; br < 3; ++br) {
                    const int k0 = br == 0 ? 0 : (br == 1 ? 512 : 1280), kl = br == 0 ? 512 : 768;
                    pg8::Gemm g{(l == 0 ? (const bf16_t*)a.out : ob) + k0, wbt + k0, l == 0 ? DM : QKVP, DM, M, DM, kl}; pg8::StaticOrder S; S.init(M, DM, G, cidx);
                    pg8::EpiBranch E{merged, gates, br * 2048, br == 0 ? 1 : 0};
                    pg8::gemm_phase<pg8::EpiBranch, pg8::StaticOrder>(lds, g, S, E, tid);
                }
            } else if (k == 4 || k == 6) {
                const bool dn = (k == 6);
                pg8::Gemm g{dn ? act : merged, dn ? (const bf16_t*)(ws + WS_WDN) + (size_t)l * DM * DFF : (const bf16_t*)(ws + WS_WOUT) + (size_t)l * DM * DM,
                            dn ? DFF : QKVP, dn ? DFF : DM, M, DM, dn ? DFF : DM};
                pg8::StaticOrder S; S.init(M, DM, G, cidx);
                const float* base = (l == 0 && !dn) ? a.x : a.out;
                const bool lastp = dn && (l == 1);
                pg8::EpiResid E{base, a.out, lastp ? nullptr : xb, lastp ? nullptr : ss + (size_t)(2 * l + (dn ? 2 : 1)) * M};
                pg8::gemm_phase<pg8::EpiResid, pg8::StaticOrder>(lds, g, S, E, tid);
            } else {
                pg8::Gemm g{xb, (const bf16_t*)(ws + WS_WGU) + (size_t)l * NGU * DM, DM, DM, M, NGU, DM}; pg8::StaticOrder S; S.init(M, NGU, G, cidx);
                pg8::EpiGU E{act, ss + (size_t)(2 * l + 1) * M};
                pg8::gemm_phase<pg8::EpiGU, pg8::StaticOrder>(lds, g, S, E, tid);
            }
        }
        }
        if (ph + 1 < ph_hi) {
            if (ph == ph_lo) cg::this_grid().sync();
            else if ((ph - 1) % 7 != 0) { ++n_grid; grid_barrier((unsigned*)(a_.ws + WS_CTR) + 256, (unsigned)n_grid); }
        }
    }
}

__global__ void fill_const(float* o, int n, float v) { for (int i = blockIdx.x * blockDim.x + threadIdx.x; i < n; i += gridDim.x * blockDim.x) o[i] = v; }
extern "C" void kernel_launch(void* const* d_in, const int* in_sizes, int n_in, void* d_out, int out_size, void* d_ws, size_t ws_size, hipStream_t stream) {
    static int grid = 0;
    if (grid == 0) {
        if (n_in != 11 || in_sizes[0] != M * DM || out_size != M * DM || ws_size < WS_END) { fprintf(stderr, "kernel_launch: unexpected shapes / workspace (n_in %d, ws %zu); nothing launched\n", n_in, ws_size); grid = -1; return; }
        int dev = 0, cus = 0, per_cu = 0;
        if (hipGetDevice(&dev) != hipSuccess || hipDeviceGetAttribute(&cus, hipDeviceAttributeMultiprocessorCount, dev) != hipSuccess || cus < 1) cus = 256;
        if (hipOccupancyMaxActiveBlocksPerMultiprocessor(&per_cu, hybrid_fwd, NTHR, 0) != hipSuccess || per_cu < 1) per_cu = 1;
        (void)hipGetLastError();
        grid = cus * per_cu;
    }
    if (grid < 0) return;
    Args a{};
    a.x = (const float*)d_in[0]; a.g_mix = (const float*)d_in[1]; a.w_in = (const float*)d_in[2]; a.q_gain = (const float*)d_in[3]; a.k_gain = (const float*)d_in[4];
    a.w_branch = (const float*)d_in[5]; a.w_out = (const float*)d_in[6]; a.g_ffn = (const float*)d_in[7]; a.w_gu = (const float*)d_in[8]; a.w_down = (const float*)d_in[9];
    a.rel_bias = (const float*)d_in[10]; a.out = (float*)d_out; a.ws = (unsigned char*)d_ws;
#if MK_COOP
    a.ph_lo = 0; a.ph_hi = MK_PH_END;
    void* args[] = {&a};
    hipError_t e = hipLaunchCooperativeKernel((void*)hybrid_fwd, dim3(grid), dim3(NTHR), args, 0, stream);
    if (e != hipSuccess) fprintf(stderr, "kernel_launch: cooperative launch failed: %s (grid %d)\n", hipGetErrorString(e), grid);
#else
    for (int ph = 0; ph < MK_PH_END; ++ph) { a.ph_lo = ph; a.ph_hi = ph + 1; hipLaunchKernelGGL(hybrid_fwd, dim3(grid), dim3(NTHR), 0, stream, a); }
#endif
}
```

```cpp
#include <hip/hip_runtime.h>
#include <hip/hip_cooperative_groups.h>
#include <cstdio>
#include <cstdint>
namespace cg = cooperative_groups;

#ifndef MK_DUP_PRO
#define MK_DUP_PRO 1
#define MK_DUP_BIG 1
#define MK_DUP_BR 1
#define MK_DUP_ATT 1
#define MK_DUP_SYNC 1
#endif
#ifndef MK_PH_END
#define MK_PH_END 15
#endif
#ifndef MK_COOP
#define MK_COOP 1
#endif

namespace pg8 {
#define PG8_LAS __attribute__((address_space(3)))
typedef unsigned short bf16_t;
typedef short bf16x8 __attribute__((ext_vector_type(8)));
typedef float f32x4 __attribute__((ext_vector_type(4)));
typedef unsigned u32x4 __attribute__((ext_vector_type(4)));
typedef unsigned u32x2 __attribute__((ext_vector_type(2)));
constexpr int BM = 256, BK = 64, HALF = 128, HTB = HALF * BK * 2, STAGE_BYTES = 8 * HTB, NXCD = 8, WGM = 8;

__host__ __device__ __forceinline__ int lds_byte(int r, int c) { const int st = (r >> 4) * 2 + (c >> 5), rr = r & 15, cc = c & 31, ob = rr * 64 + cc * 2; return st * 1024 + (ob ^ (((ob >> 9) & 1) << 5)); }
__host__ __device__ __forceinline__ void stage_rc(int b, int& R, int& C) { const int st = b / 1024, sb = b % 1024, swz = sb ^ (((sb >> 9) & 1) << 5); R = (st >> 1) * 16 + swz / 64; C = (st & 1) * 32 + (swz % 64) / 2; }
__host__ __device__ __forceinline__ int perm32(int rho) { const int n = rho >> 4, i = rho & 15; return 8 * (i >> 2) + 4 * n + (i & 3); }

struct Unit { int pm, pn; };
struct Gemm { const bf16_t* A; const bf16_t* Bt; int lda, ldb, M, N, K; };

struct StaticOrder {
    int nM, nN, nwg, G, c;
    __host__ __device__ void init(int M, int N, int G_, int c_) { nM = M / BM; nN = N / BM; nwg = nM * nN; G = G_; c = c_; }
    __host__ __device__ bool next(int i, Unit& u) const {
        const int L = i * G + c; if (L >= nwg) return false;
        int wgid = L; { const int q = nwg / NXCD, r = nwg % NXCD, xcd = wgid % NXCD, off = wgid / NXCD; wgid = (xcd < r ? xcd * (q + 1) : r * (q + 1) + (xcd - r) * q) + off; }
        const int nig = WGM * nN, gid = wgid / nig, fm = gid * WGM, gsz = (nM - fm) < WGM ? (nM - fm) : WGM;
        u.pm = fm + ((wgid % nig) % gsz); u.pn = (wgid % nig) / gsz; return true;
    }
};

typedef float f32x2c_t __attribute__((ext_vector_type(2))); typedef __bf16 bf16x2c_t __attribute__((ext_vector_type(2)));
__device__ __forceinline__ unsigned cvt_pk_bf16(float lo, float hi) { f32x2c_t v = {lo, hi}; bf16x2c_t b = __builtin_convertvector(v, bf16x2c_t); return __builtin_bit_cast(unsigned, b); }
__device__ __forceinline__ float bf_lo(unsigned w) { return __uint_as_float(w << 16); }
__device__ __forceinline__ float bf_hi(unsigned w) { return __uint_as_float(w & 0xffff0000u); }
__device__ __forceinline__ float sigmoidf_(float v) { return __builtin_amdgcn_rcpf(1.0f + __builtin_amdgcn_exp2f(v * -1.4426950408889634f)); }


struct EpiIn {
    static constexpr bool PERM = true;
    bf16_t* qkv; bf16_t* gates; const float* ss; const float* qg; const float* kg; float* kmean; PG8_LAS unsigned char* xl;
    __device__ __forceinline__ void operator()(const f32x4 (&acc)[2][2][4][2], const Unit& u, int wr, int wc, int fr, int fq) const {
        const int row0 = u.pm * BM + wr * 64 + fr; const bool isg = u.pn >= 24;
        bf16_t* base = isg ? gates : qkv; const int col0 = (isg ? u.pn - 24 : u.pn) * BM + wc * 32 + 8 * fq;
        float rsv[2][4];
#pragma unroll
        for (int ai = 0; ai < 2; ++ai)
#pragma unroll
            for (int m = 0; m < 4; ++m) rsv[ai][m] = ss[row0 + ai * HALF + m * 16];
#pragma unroll
        for (int ai = 0; ai < 2; ++ai)
#pragma unroll
            for (int m = 0; m < 4; ++m) rsv[ai][m] = rsqrtf(rsv[ai][m] * (1.0f / 2048.0f) + 1e-6f);
        const int sec = u.pn >> 3, hp = u.pn & 7; const bool soft = (u.pn < 16) && (hp >= 2);
        if (!soft) {
#pragma unroll
            for (int ai = 0; ai < 2; ++ai)
#pragma unroll
                for (int m = 0; m < 4; ++m) { const int row = row0 + ai * HALF + m * 16; const float rs = rsv[ai][m];
                    bf16_t* rowp = base + (size_t)row * 6144 + col0;
#pragma unroll
                    for (int bj = 0; bj < 2; ++bj) { f32x4 v0 = acc[ai][bj][m][0] * rs, v1 = acc[ai][bj][m][1] * rs;
                        if (isg) { v0 = (f32x4){sigmoidf_(v0[0]), sigmoidf_(v0[1]), sigmoidf_(v0[2]), sigmoidf_(v0[3])}; v1 = (f32x4){sigmoidf_(v1[0]), sigmoidf_(v1[1]), sigmoidf_(v1[2]), sigmoidf_(v1[3])}; }
                        u32x4 w; w.x = cvt_pk_bf16(v0[0], v0[1]); w.y = cvt_pk_bf16(v0[2], v0[3]); w.z = cvt_pk_bf16(v1[0], v1[1]); w.w = cvt_pk_bf16(v1[2], v1[3]);
                        *(u32x4*)(rowp + bj * HALF) = w; } }
            return;
        }
        PG8_LAS float* part = (PG8_LAS float*)xl; PG8_LAS float* colsum = (PG8_LAS float*)(xl + 8192);
#pragma unroll
        for (int ai = 0; ai < 2; ++ai)
#pragma unroll
            for (int m = 0; m < 4; ++m)
#pragma unroll
                for (int bj = 0; bj < 2; ++bj) { const f32x4 a0 = acc[ai][bj][m][0] * rsv[ai][m], a1 = acc[ai][bj][m][1] * rsv[ai][m];
                    float s = (a0[0] * a0[0] + a0[1] * a0[1]) + (a0[2] * a0[2] + a0[3] * a0[3]) + (a1[0] * a1[0] + a1[1] * a1[1]) + (a1[2] * a1[2] + a1[3] * a1[3]);
                    s += __shfl_xor(s, 16); s += __shfl_xor(s, 32);
                    if (fq == 0) part[((ai * HALF + wr * 64 + m * 16 + fr) * 2 + bj) * 4 + wc] = s; }
        asm volatile("s_waitcnt lgkmcnt(0)" ::: "memory"); __builtin_amdgcn_s_barrier(); asm volatile("" ::: "memory");
        const bool km = (sec == 1) && (hp <= 4);
        const float* gbase = (sec ? kg : qg) + (2 * hp - 4) * 128 + wc * 32 + 8 * fq;
        float gn[2][8], cs[2][8];
#pragma unroll
        for (int bj = 0; bj < 2; ++bj)
#pragma unroll
            for (int e = 0; e < 8; ++e) { gn[bj][e] = gbase[bj * 128 + e]; cs[bj][e] = 0.f; }
#pragma unroll
        for (int ai = 0; ai < 2; ++ai)
#pragma unroll
            for (int m = 0; m < 4; ++m) { const int rl = ai * HALF + wr * 64 + m * 16 + fr; bf16_t* rowp = base + (size_t)(u.pm * BM + rl) * 6144 + col0;
#pragma unroll
                for (int bj = 0; bj < 2; ++bj) { const f32x4 p = *(const PG8_LAS f32x4*)(part + (rl * 2 + bj) * 4);
                    const float sc = rsv[ai][m] * rsqrtf(((p[0] + p[1]) + (p[2] + p[3])) * (1.0f / 128.0f) + 1e-6f);
                    float r[8];
#pragma unroll
                    for (int e = 0; e < 4; ++e) { r[e] = acc[ai][bj][m][0][e] * sc * gn[bj][e]; r[4 + e] = acc[ai][bj][m][1][e] * sc * gn[bj][4 + e]; }
#pragma unroll
                    for (int e = 0; e < 8; ++e) cs[bj][e] += r[e];
                    u32x4 w; w.x = cvt_pk_bf16(r[0], r[1]); w.y = cvt_pk_bf16(r[2], r[3]); w.z = cvt_pk_bf16(r[4], r[5]); w.w = cvt_pk_bf16(r[6], r[7]);
                    *(u32x4*)(rowp + bj * HALF) = w; } }
        if (km) {
#pragma unroll
            for (int bj = 0; bj < 2; ++bj)
#pragma unroll
                for (int e = 0; e < 8; ++e) { float c = cs[bj][e]; c += __shfl_xor(c, 1); c += __shfl_xor(c, 2); c += __shfl_xor(c, 4); c += __shfl_xor(c, 8);
                    if (fr == 0) colsum[wr * 256 + bj * 128 + wc * 32 + 8 * fq + e] = c; }
            asm volatile("s_waitcnt lgkmcnt(0)" ::: "memory"); __builtin_amdgcn_s_barrier(); asm volatile("" ::: "memory");
            if (wr == 0) { const int c = wc * 64 + fq * 16 + fr;
                const int hs = 2 * hp - 4 + (c >> 7);
                kmean[((size_t)((u.pm >> 4) * 6 + hs) * 16 + (u.pm & 15)) * 128 + (c & 127)] = (colsum[c] + colsum[256 + c]) * (1.0f / 256.0f); }
        }
    }
};
struct EpiGU {
    static constexpr bool PERM = true;
    bf16_t* act; const float* ss;
    __device__ __forceinline__ void operator()(const f32x4 (&acc)[2][2][4][2], const Unit& u, int wr, int wc, int fr, int fq) const {
        const int row0 = u.pm * BM + wr * 64 + fr; const int col0 = u.pn * HALF + wc * 32 + 8 * fq;
        float ssv[2][4];
#pragma unroll
        for (int ai = 0; ai < 2; ++ai)
#pragma unroll
            for (int m = 0; m < 4; ++m) ssv[ai][m] = ss[row0 + ai * HALF + m * 16];
#pragma unroll
        for (int ai = 0; ai < 2; ++ai)
#pragma unroll
            for (int m = 0; m < 4; ++m) { const int row = row0 + ai * HALF + m * 16; const float rs = rsqrtf(ssv[ai][m] * (1.0f / 2048.0f) + 1e-6f);
                float r[8];
#pragma unroll
                for (int n = 0; n < 2; ++n)
#pragma unroll
                    for (int e = 0; e < 4; ++e) { const float g = acc[ai][0][m][n][e] * rs, up = acc[ai][1][m][n][e] * rs; r[n * 4 + e] = g * sigmoidf_(g) * up; }
                u32x4 w; w.x = cvt_pk_bf16(r[0], r[1]); w.y = cvt_pk_bf16(r[2], r[3]); w.z = cvt_pk_bf16(r[4], r[5]); w.w = cvt_pk_bf16(r[6], r[7]);
                *(u32x4*)(act + (size_t)row * 5632 + col0) = w; }
    }
};
struct EpiBranch {
    static constexpr bool PERM = true;
    bf16_t* merged; const bf16_t* gates; int gcol; int first;
    __device__ __forceinline__ void operator()(const f32x4 (&acc)[2][2][4][2], const Unit& u, int wr, int wc, int fr, int fq) const {
        const int row0 = u.pm * BM + wr * 64 + fr; const int col0 = u.pn * BM + wc * 32 + 8 * fq;
#pragma unroll
        for (int aq = 0; aq < 4; ++aq) { const int ai = aq >> 1, m0 = 2 * (aq & 1);
            u32x4 gw[2][2], pw[2][2];
#pragma unroll
            for (int mm = 0; mm < 2; ++mm)
#pragma unroll
                for (int bj = 0; bj < 2; ++bj) { const int row = row0 + ai * HALF + (m0 + mm) * 16, col = col0 + bj * HALF;
                    gw[mm][bj] = *(const u32x4*)(gates + (size_t)row * 6144 + gcol + col);
                    pw[mm][bj] = first ? (u32x4){0u, 0u, 0u, 0u} : *(const u32x4*)(merged + (size_t)row * 6144 + col); }
#pragma unroll
            for (int mm = 0; mm < 2; ++mm)
#pragma unroll
                for (int bj = 0; bj < 2; ++bj) { const int m = m0 + mm; const int row = row0 + ai * HALF + m * 16, col = col0 + bj * HALF;
                    const u32x4 g_ = gw[mm][bj], p_ = pw[mm][bj]; float r[8];
                    r[0] = bf_lo(g_.x) * acc[ai][bj][m][0][0] + bf_lo(p_.x); r[1] = bf_hi(g_.x) * acc[ai][bj][m][0][1] + bf_hi(p_.x);
                    r[2] = bf_lo(g_.y) * acc[ai][bj][m][0][2] + bf_lo(p_.y); r[3] = bf_hi(g_.y) * acc[ai][bj][m][0][3] + bf_hi(p_.y);
                    r[4] = bf_lo(g_.z) * acc[ai][bj][m][1][0] + bf_lo(p_.z); r[5] = bf_hi(g_.z) * acc[ai][bj][m][1][1] + bf_hi(p_.z);
                    r[6] = bf_lo(g_.w) * acc[ai][bj][m][1][2] + bf_lo(p_.w); r[7] = bf_hi(g_.w) * acc[ai][bj][m][1][3] + bf_hi(p_.w);
                    u32x4 w; w.x = cvt_pk_bf16(r[0], r[1]); w.y = cvt_pk_bf16(r[2], r[3]); w.z = cvt_pk_bf16(r[4], r[5]); w.w = cvt_pk_bf16(r[6], r[7]);
                    *(u32x4*)(merged + (size_t)row * 6144 + col) = w; }
            asm volatile("" ::: "memory");
        }
    }
};
struct EpiResid {
    static constexpr bool PERM = true;
    const float* base; float* out; bf16_t* xb; float* ss;
    __device__ __forceinline__ void operator()(const f32x4 (&acc)[2][2][4][2], const Unit& u, int wr, int wc, int fr, int fq) const {
        const int row0 = u.pm * BM + wr * 64 + fr; const int col0 = u.pn * BM + wc * 32 + 8 * fq;
#pragma unroll
        for (int aq = 0; aq < 4; ++aq) { const int ai = aq >> 1, m0 = 2 * (aq & 1);
            f32x4 bv[2][2][2];
#pragma unroll
            for (int mm = 0; mm < 2; ++mm)
#pragma unroll
                for (int bj = 0; bj < 2; ++bj) { const size_t off = (size_t)(row0 + ai * HALF + (m0 + mm) * 16) * 2048 + col0 + bj * HALF;
                    bv[mm][bj][0] = *(const f32x4*)(base + off); bv[mm][bj][1] = *(const f32x4*)(base + off + 4); }
#pragma unroll
            for (int mm = 0; mm < 2; ++mm) { const int m = m0 + mm; const int row = row0 + ai * HALF + m * 16; float sq = 0.f;
#pragma unroll
                for (int bj = 0; bj < 2; ++bj) { const size_t off = (size_t)row * 2048 + col0 + bj * HALF;
                    const f32x4 o0 = bv[mm][bj][0] + acc[ai][bj][m][0], o1 = bv[mm][bj][1] + acc[ai][bj][m][1];
                    *(f32x4*)(out + off) = o0; *(f32x4*)(out + off + 4) = o1;
                    sq += (o0[0] * o0[0] + o0[1] * o0[1]) + (o0[2] * o0[2] + o0[3] * o0[3]) + (o1[0] * o1[0] + o1[1] * o1[1]) + (o1[2] * o1[2] + o1[3] * o1[3]);
                    if (xb) { u32x4 w; w.x = cvt_pk_bf16(o0[0], o0[1]); w.y = cvt_pk_bf16(o0[2], o0[3]); w.z = cvt_pk_bf16(o1[0], o1[1]); w.w = cvt_pk_bf16(o1[2], o1[3]); *(u32x4*)(xb + off) = w; } }
                if (ss) { sq += __shfl_xor(sq, 16); sq += __shfl_xor(sq, 32); if (fq == 0) atomicAdd(ss + row, sq); } }
            asm volatile("" ::: "memory");
        }
    }
};

template <class Epi, class Sched>
__device__ __forceinline__ void gemm_phase(PG8_LAS unsigned char* lds, const Gemm g, const Sched& S, const Epi& E, const int tid) {
    const int wid = __builtin_amdgcn_readfirstlane(tid >> 6), lane = tid & 63, wr = wid >> 2, wc = wid & 3, fr = lane & 15, fq = lane >> 4;
    const int nt = g.K / BK;
    unsigned voffA[2], voffB[2];
#pragma unroll
    for (int i = 0; i < 2; ++i) { int R, C; stage_rc(tid * 16 + i * 8192, R, C); const int Rb = Epi::PERM ? ((R & ~31) + perm32(R & 31)) : R;
        voffA[i] = (unsigned)(R * g.lda + C) * 2u; voffB[i] = (unsigned)(Rb * g.ldb + C) * 2u; }
    const size_t kstep = (size_t)(BK * 2);
    const size_t hstepA = (size_t)HALF * g.lda * 2, hstepB = (size_t)HALF * g.ldb * 2;
    const size_t tstepA = 2 * hstepA, tstepB = 2 * hstepB;
    const unsigned ldsw = (unsigned)wid * 1024u;
    const int aoff = lds_byte(wr * 64 + fr, fq * 8), boff = lds_byte(wc * 32 + fr, fq * 8);
#define PG8_SA(b, h) (((b) * 2 + (h)) * HTB)
#define PG8_SB(b, h) ((4 + (b) * 2 + (h)) * HTB)
#define PG8_STAGE(bufoff, gbase, voff) do { _Pragma("unroll") for (int _i = 0; _i < 2; ++_i) \
        __builtin_amdgcn_global_load_lds((const unsigned*)((const char*)(gbase) + (voff)[_i]), (PG8_LAS unsigned*)(lds + (bufoff) + ldsw + _i * 8192), 16, 0, 0); } while (0)
#define PG8_LDA(dst, b, h) do { _Pragma("unroll") for (int m = 0; m < 4; ++m) _Pragma("unroll") for (int k = 0; k < 2; ++k) dst[m][k] = *(const PG8_LAS bf16x8*)(lds + PG8_SA(b, h) + aoff + m * 2048 + k * 1024); } while (0)
#define PG8_LDB(dst, b, h) do { _Pragma("unroll") for (int n = 0; n < 2; ++n) _Pragma("unroll") for (int k = 0; k < 2; ++k) dst[n][k] = *(const PG8_LAS bf16x8*)(lds + PG8_SB(b, h) + boff + n * 2048 + k * 1024); } while (0)
#define PG8_MMA(ai, bj, At, Bt) do { __builtin_amdgcn_s_setprio(1); _Pragma("unroll") for (int m = 0; m < 4; ++m) _Pragma("unroll") for (int n = 0; n < 2; ++n) _Pragma("unroll") for (int k = 0; k < 2; ++k) \
        acc[ai][bj][m][n] = __builtin_amdgcn_mfma_f32_16x16x32_bf16(Bt[n][k], At[m][k], acc[ai][bj][m][n], 0, 0, 0); __builtin_amdgcn_s_setprio(0); } while (0)
#define PG8_WAIT_V(n) asm volatile("s_waitcnt vmcnt(" #n ")" ::: "memory")
#define PG8_WAIT_L(n) asm volatile("s_waitcnt lgkmcnt(" #n ")" ::: "memory")
#define PG8_BAR __builtin_amdgcn_s_barrier()
#define PG8_SCHED __builtin_amdgcn_sched_barrier(0)
    Unit cur, nxt; int ui = 0;
    if (!S.next(0, cur)) return;
    f32x4 acc[2][2][4][2];
#pragma unroll
    for (int a = 0; a < 2; ++a)
#pragma unroll
        for (int b = 0; b < 2; ++b)
#pragma unroll
            for (int m = 0; m < 4; ++m)
#pragma unroll
                for (int n = 0; n < 2; ++n) acc[a][b][m][n] = (f32x4){0.f, 0.f, 0.f, 0.f};
    bf16x8 At[4][2], B0[2][2], B1[2][2];
    const char* cA = (const char*)g.A + (size_t)cur.pm * tstepA; const char* cB = (const char*)g.Bt + (size_t)cur.pn * tstepB;
    PG8_STAGE(PG8_SB(0, 0), cB, voffB); PG8_STAGE(PG8_SB(0, 1), cB + hstepB, voffB); PG8_STAGE(PG8_SA(0, 0), cA, voffA); PG8_STAGE(PG8_SA(0, 1), cA + hstepA, voffA);
    if (wr == 1) PG8_BAR;
    PG8_WAIT_V(2); PG8_BAR;
    PG8_STAGE(PG8_SB(1, 0), cB + kstep, voffB); PG8_STAGE(PG8_SA(1, 0), cA + kstep, voffA); PG8_STAGE(PG8_SB(1, 1), cB + hstepB + kstep, voffB);
    PG8_WAIT_V(6); PG8_BAR;
    for (;;) {
        const bool has_next = S.next(ui + 1, nxt);
        const char* nA = has_next ? (const char*)g.A + (size_t)nxt.pm * tstepA : cA; const char* nB = has_next ? (const char*)g.Bt + (size_t)nxt.pn * tstepB : cB;
        for (int t = 0; t < nt; t += 2) {
            const bool last = (t == nt - 2);
            const char* a1 = cA + (size_t)(t + 1) * kstep;
            const char* a2 = last ? nA : cA + (size_t)(t + 2) * kstep; const char* b2 = last ? nB : cB + (size_t)(t + 2) * kstep;
            const char* a3 = a2 + kstep; const char* b3 = b2 + kstep;
            PG8_LDB(B0, 0, 0); PG8_LDB(B1, 0, 1); PG8_SCHED; PG8_LDA(At, 0, 0); PG8_STAGE(PG8_SA(1, 1), a1 + hstepA, voffA);
            PG8_WAIT_V(8); PG8_WAIT_L(0); PG8_BAR; PG8_MMA(0, 0, At, B0); PG8_MMA(0, 1, At, B1); PG8_BAR; PG8_SCHED;
            PG8_LDA(At, 0, 1); PG8_STAGE(PG8_SB(0, 0), b2, voffB); PG8_STAGE(PG8_SB(0, 1), b2 + hstepB, voffB); PG8_STAGE(PG8_SA(0, 0), a2, voffA);
            PG8_WAIT_V(8); PG8_WAIT_L(0); PG8_BAR; PG8_MMA(1, 0, At, B0); PG8_MMA(1, 1, At, B1); PG8_BAR; PG8_SCHED;
            PG8_LDB(B0, 1, 0); PG8_LDB(B1, 1, 1); PG8_SCHED; PG8_LDA(At, 1, 0); PG8_STAGE(PG8_SA(0, 1), a2 + hstepA, voffA);
            PG8_WAIT_V(8); PG8_WAIT_L(0); PG8_BAR; PG8_MMA(0, 0, At, B0); PG8_MMA(0, 1, At, B1); PG8_BAR; PG8_SCHED;
            PG8_LDA(At, 1, 1); PG8_STAGE(PG8_SB(1, 0), b3, voffB); PG8_STAGE(PG8_SB(1, 1), b3 + hstepB, voffB); PG8_STAGE(PG8_SA(1, 0), a3, voffA);
            PG8_WAIT_V(8); PG8_WAIT_L(0); PG8_BAR; PG8_MMA(1, 0, At, B0); PG8_MMA(1, 1, At, B1); PG8_BAR; PG8_SCHED;
        }
        if (wr == 0) PG8_BAR;
        E(acc, cur, wr, wc, fr, fq);
        if (!has_next) break;
#pragma unroll
        for (int a = 0; a < 2; ++a)
#pragma unroll
            for (int b = 0; b < 2; ++b)
#pragma unroll
                for (int m = 0; m < 4; ++m)
#pragma unroll
                    for (int n = 0; n < 2; ++n) acc[a][b][m][n] = (f32x4){0.f, 0.f, 0.f, 0.f};
        cur = nxt; cA = nA; cB = nB; ++ui;
        if (wr == 1) PG8_BAR;
    }
    PG8_WAIT_V(0);
    PG8_BAR;
#undef PG8_SA
#undef PG8_SB
#undef PG8_STAGE
#undef PG8_LDA
#undef PG8_LDB
#undef PG8_MMA
#undef PG8_WAIT_V
#undef PG8_WAIT_L
#undef PG8_BAR
#undef PG8_SCHED
}
}

#define GAS __attribute__((address_space(1)))
#define LAS __attribute__((address_space(3)))
typedef unsigned short bf16_t;
typedef short bf16x8 __attribute__((ext_vector_type(8)));
typedef short s16x4 __attribute__((ext_vector_type(4)));
typedef float f32x4 __attribute__((ext_vector_type(4)));
typedef float f32x16 __attribute__((ext_vector_type(16)));
typedef unsigned u32x4 __attribute__((ext_vector_type(4)));
typedef unsigned u32x2 __attribute__((ext_vector_type(2)));

constexpr int DM = 2048, BATCH = 4, SEQ = 4096, M = BATCH * SEQ, DFF = 5632, NIN = 12288, NGU = 11264, QKVP = 6144;
constexpr int NWAVES = 8, NTHR = 512;
constexpr size_t MiB = 1u << 20;
constexpr size_t WS_CTR = 0, WS_SS = 64 * 1024, WS_LUT = 512 * 1024, WS_KM = 1 * MiB;
constexpr size_t WS_WIN = 4 * MiB, WS_WBR = 100 * MiB, WS_WOUT = 116 * MiB, WS_WGU = 132 * MiB, WS_WDN = 220 * MiB;
constexpr size_t WS_XB = 264 * MiB, WS_QKV = 328 * MiB, WS_GATES = 520 * MiB, WS_END = 712 * MiB;
constexpr int LDS_BYTES = 143360;
constexpr int ATT_V_OFF = 0, ATT_LUT_OFF = 65536, ATT_KM_OFF = 81920, DIL_K_OFF = 73728, MISC_OFF = 142336;

struct Args {
    const float* x; const float* g_mix; const float* w_in; const float* q_gain; const float* k_gain; const float* w_branch; const float* w_out;
    const float* g_ffn; const float* w_gu; const float* w_down; const float* rel_bias;
    float* out; unsigned char* ws; int ph_lo, ph_hi;
};

__device__ __forceinline__ unsigned f2bf(float f) { unsigned u = __builtin_bit_cast(unsigned, f); return (u + 0x7fffu + ((u >> 16) & 1u)) >> 16; }
__device__ __forceinline__ unsigned pk2(float lo, float hi) { return pg8::cvt_pk_bf16(lo, hi); }
__device__ __forceinline__ float wave_sum(float v) {
#pragma unroll
    for (int o = 1; o < 64; o <<= 1) v += __shfl_xor(v, o);
    return v;
}

template <bool GU>
__device__ __forceinline__ void transpose_item(const float* W, const float* gk, int K, int N, bf16_t* WT, LAS float* scr, int item, int lane) {
    const int nblk = N / 32, kb = item / nblk, nb = item % nblk, k0 = 64 * kb, n0 = 32 * nb;
    float v[32];
#pragma unroll
    for (int i = 0; i < 32; ++i) v[i] = W[(size_t)(k0 + 2 * i + (lane >> 5)) * N + n0 + (lane & 31)];
#pragma unroll
    for (int i = 0; i < 32; ++i) { const int kk = 2 * i + (lane >> 5); if (gk) v[i] *= gk[k0 + kk]; scr[kk * 33 + (lane & 31)] = v[i]; }
    asm volatile("s_waitcnt lgkmcnt(0)" ::: "memory");
    const int c = lane & 7;
#pragma unroll
    for (int j = 0; j < 4; ++j) { const int n = (lane >> 3) + 8 * j; const LAS float* s = scr + (8 * c) * 33 + n;
        u32x4 o; o.x = pk2(s[0 * 33], s[1 * 33]); o.y = pk2(s[2 * 33], s[3 * 33]); o.z = pk2(s[4 * 33], s[5 * 33]); o.w = pk2(s[6 * 33], s[7 * 33]);
        int col = n0 + n, drow;
        if (GU) { const int half = col >= DFF ? 1 : 0, jj = col - half * DFF; drow = 256 * (jj >> 7) + 128 * half + (jj & 127); } else drow = col;
        *(u32x4*)(WT + (size_t)drow * K + k0 + 8 * c) = o; }
    asm volatile("s_waitcnt lgkmcnt(0)" ::: "memory");
}

__device__ __forceinline__ void phase_prologue(const Args& a, LAS unsigned char* lds, int tid, int lane, int wave) {
    unsigned char* ws = a.ws;
    LAS float* scr = (LAS float*)(lds + wave * 16384);
    int NGW = gridDim.x * NWAVES; asm volatile("" : "+s"(NGW));
    const int gw = blockIdx.x * NWAVES + wave;
    constexpr int I_IN = (DM / 64) * (NIN / 32), I_BR = (DM / 64) * (DM / 32), I_OUT = I_BR, I_GU = (DM / 64) * (NGU / 32), I_DN = (DFF / 64) * (DM / 32);
    constexpr int I_LAYER = I_IN + I_BR + I_OUT + I_GU + I_DN;
    for (int it = gw; it < 2 * I_LAYER; it += NGW) {
        const int l = it / I_LAYER; int r = it % I_LAYER;
        if (r < I_IN) { transpose_item<false>(a.w_in + (size_t)l * DM * NIN, a.g_mix + l * DM, DM, NIN, (bf16_t*)(ws + WS_WIN) + (size_t)l * NIN * DM, scr, r, lane); continue; } r -= I_IN;
        if (r < I_BR) { transpose_item<false>(a.w_branch + (size_t)l * DM * DM, nullptr, DM, DM, (bf16_t*)(ws + WS_WBR) + (size_t)l * DM * DM, scr, r, lane); continue; } r -= I_BR;
        if (r < I_OUT) { transpose_item<false>(a.w_out + (size_t)l * DM * DM, nullptr, DM, DM, (bf16_t*)(ws + WS_WOUT) + (size_t)l * DM * DM, scr, r, lane); continue; } r -= I_OUT;
        if (r < I_GU) { transpose_item<true>(a.w_gu + (size_t)l * DM * NGU, a.g_ffn + l * DM, DM, NGU, (bf16_t*)(ws + WS_WGU) + (size_t)l * NGU * DM, scr, r, lane); continue; } r -= I_GU;
        transpose_item<false>(a.w_down + (size_t)l * DFF * DM, nullptr, DFF, DM, (bf16_t*)(ws + WS_WDN) + (size_t)l * DM * DFF, scr, r, lane);
    }
    float* ss = (float*)(ws + WS_SS);
    for (int m = gw; m < M; m += NGW) {
        const f32x4* xr = (const f32x4*)(a.x + (size_t)m * DM) + lane; u32x2* o8 = (u32x2*)((bf16_t*)(ws + WS_XB) + (size_t)m * DM) + lane;
        float s = 0.f;
#pragma unroll
        for (int j = 0; j < 8; ++j) { const f32x4 v = xr[64 * j]; s += (v.x * v.x + v.y * v.y) + (v.z * v.z + v.w * v.w); u32x2 w; w.x = pk2(v.x, v.y); w.y = pk2(v.z, v.w); o8[64 * j] = w; }
        s = wave_sum(s);
        if (lane == 0) ss[m] = s;
    }
    int NGT = gridDim.x * NTHR; asm volatile("" : "+s"(NGT));
    const int gt = blockIdx.x * NTHR + tid;
    for (int i = gt; i < 3 * M; i += NGT) ss[M + i] = 0.f;
    if (gt < 1024) ((unsigned*)(ws + WS_CTR))[gt] = 0u;
    float* lut = (float*)(ws + WS_LUT);
    for (int i = gt; i < 12 * 4096; i += NGT) { const int hs = i >> 12, d = i & 4095; int bucket;
        if (d < 16) bucket = d; else { const float df = (float)d; int large = 16 + (int)(logf(df / 16.0f) / 4.852030263919617f * 16.0f); bucket = large < 31 ? large : 31; }
        lut[i] = a.rel_bias[bucket * 12 + hs] * 1.4426950408889634f; }
}

__device__ __forceinline__ void phase_qknorm(const Args& a, int l, LAS unsigned char* lds, int tid, int lane, int wave) {
    bf16_t* qkv = (bf16_t*)(a.ws + WS_QKV); float* kmean = (float*)(a.ws + WS_KM);
    LAS float* red = (LAS float*)lds;
    for (int it = blockIdx.x; it < 1536; it += gridDim.x) {
        const int kind = it / 768, rem = it % 768, b = rem / 192, hs = (rem % 192) / 16, blk = rem % 16;
        const float* gain = (kind ? a.k_gain : a.q_gain) + (size_t)l * 12 * 128 + hs * 128 + (lane & 15) * 8;
        float gn[8];
#pragma unroll
        for (int e = 0; e < 8; ++e) gn[e] = gain[e];
        bf16_t* base = qkv + (size_t)(b * SEQ + blk * 256 + wave * 32) * QKVP + kind * 2048 + (4 + hs) * 128 + (lane & 15) * 8;
        float ks[8];
#pragma unroll
        for (int e = 0; e < 8; ++e) ks[e] = 0.f;
        u32x4 wv[8];
#pragma unroll
        for (int ii = 0; ii < 8; ++ii) wv[ii] = *(const u32x4*)(base + (size_t)(4 * ii + (lane >> 4)) * QKVP);
#pragma unroll
        for (int ii = 0; ii < 8; ++ii) { bf16_t* p = base + (size_t)(4 * ii + (lane >> 4)) * QKVP;
            const u32x4 w = wv[ii]; float v[8];
            v[0] = pg8::bf_lo(w.x); v[1] = pg8::bf_hi(w.x); v[2] = pg8::bf_lo(w.y); v[3] = pg8::bf_hi(w.y); v[4] = pg8::bf_lo(w.z); v[5] = pg8::bf_hi(w.z); v[6] = pg8::bf_lo(w.w); v[7] = pg8::bf_hi(w.w);
            float s = 0.f;
#pragma unroll
            for (int e = 0; e < 8; ++e) s += v[e] * v[e];
            s += __shfl_xor(s, 1); s += __shfl_xor(s, 2); s += __shfl_xor(s, 4); s += __shfl_xor(s, 8);
            const float rs = rsqrtf(s * (1.0f / 128.0f) + 1e-6f);
#pragma unroll
            for (int e = 0; e < 8; ++e) { v[e] = v[e] * rs * gn[e]; ks[e] += v[e]; }
            u32x4 o; o.x = pk2(v[0], v[1]); o.y = pk2(v[2], v[3]); o.z = pk2(v[4], v[5]); o.w = pk2(v[6], v[7]);
            *(u32x4*)p = o; }
        const bool km = (kind == 1) && (hs < 6);
        if (km) {
#pragma unroll
            for (int e = 0; e < 8; ++e) { ks[e] += __shfl_xor(ks[e], 16); ks[e] += __shfl_xor(ks[e], 32); }
            if (lane < 16) {
#pragma unroll
                for (int e = 0; e < 8; ++e) red[wave * 128 + lane * 8 + e] = ks[e]; }
        }
        __syncthreads();
        if (km && tid < 128) { float s = 0.f;
#pragma unroll
            for (int w = 0; w < 8; ++w) s += red[w * 128 + tid];
            kmean[((size_t)(b * 6 + hs) * 16 + blk) * 128 + tid] = s * (1.0f / 256.0f); }
        __syncthreads();
    }
}

namespace att {
constexpr float SCALE = 0.08838834764831845f, LOG2E = 1.4426950408889634f, NEG = -1e30f, C1 = SCALE * LOG2E;
__device__ __forceinline__ unsigned offa(unsigned row, unsigned ch) { return 2048u * (row >> 3) + 512u * (ch >> 2) + 64u * (row & 7u) + 16u * ((ch & 3u) ^ ((row >> 2) & 3u)); }
__device__ __forceinline__ int clamp_s(int s) { return s < 0 ? 0 : (s > SEQ - 1 ? SEQ - 1 : s); }
__device__ __forceinline__ void load_k(bf16x8 (&kf)[8], const bf16_t* Kb, int s0, int stride, int lane) {
    const int s = clamp_s(s0 + stride * (lane & 31));
    const GAS bf16x8* p = (const GAS bf16x8*)(Kb + (size_t)s * QKVP + 8 * (lane >> 5));
#pragma unroll
    for (int j = 0; j < 8; ++j) kf[j] = p[2 * j];
}
__device__ __forceinline__ void load_v(u32x4 (&vr)[8], const bf16_t* Vb, int s0, int stride, int lane) {
#pragma unroll
    for (int ii = 0; ii < 8; ++ii) { const int s = clamp_s(s0 + stride * ((lane >> 4) + 4 * ii)); vr[ii] = *(const GAS u32x4*)(Vb + (size_t)s * QKVP + (lane & 15) * 8); }
}
__device__ __forceinline__ void stage_v(LAS unsigned char* vl, const u32x4 (&vr)[8], int lane) {
    const unsigned ch = lane & 15, wl = 512u * (ch >> 2) + 64u * (unsigned)(lane >> 4);
#pragma unroll
    for (int ii = 0; ii < 8; ++ii) *(LAS u32x4*)(vl + wl + 16u * ((ch & 3u) ^ (unsigned)(ii & 3)) + 2048 * (ii >> 1) + 256 * (ii & 1)) = vr[ii];
}
__device__ __forceinline__ f32x16 qk(const bf16x8 (&kf)[8], const bf16x8 (&qf)[8]) {
    f32x16 acc = {0.f, 0.f, 0.f, 0.f, 0.f, 0.f, 0.f, 0.f, 0.f, 0.f, 0.f, 0.f, 0.f, 0.f, 0.f, 0.f};
#pragma unroll
    for (int j = 0; j < 8; ++j) acc = __builtin_amdgcn_mfma_f32_32x32x16_bf16(kf[j], qf[j], acc, 0, 0, 0);
    return acc;
}
typedef short v4i16_t __attribute__((ext_vector_type(4)));
__device__ __forceinline__ s16x4 vtr(LAS unsigned char* p) { return __builtin_bit_cast(s16x4, __builtin_amdgcn_ds_read_tr16_b64_v4i16((LAS v4i16_t*)p)); }
__device__ __forceinline__ void pv(f32x16 (&o)[4], LAS unsigned char* vl, bf16x8 P0, bf16x8 P1, int lane) {
    const unsigned h = lane >> 5, blk = (lane >> 4) & 1, q = (lane & 15) >> 2, p = lane & 3;
    const unsigned lb = 64u * (4u * h + q) + 16u * ((p >> 1) ^ h) + 8u * (p & 1u);
    LAS unsigned char* b0 = vl + lb + 32u * blk; LAS unsigned char* b1 = vl + lb + 32u * (blk ^ 1u) + 2048u;
#pragma unroll
    for (int hf = 0; hf < 2; ++hf) {
        s16x4 lo[2][2], hi[2][2];
#pragma unroll
        for (int cc = 0; cc < 2; ++cc)
#pragma unroll
            for (int s = 0; s < 2; ++s) { lo[cc][s] = vtr(b0 + 4096 * s + 512 * (2 * hf + cc)); hi[cc][s] = vtr(b1 + 4096 * s + 512 * (2 * hf + cc)); }
        asm volatile("s_waitcnt lgkmcnt(0)" ::: "memory");
        __builtin_amdgcn_sched_barrier(0);
#pragma unroll
        for (int cc = 0; cc < 2; ++cc)
#pragma unroll
            for (int s = 0; s < 2; ++s) {
                const bf16x8 A = {lo[cc][s][0], lo[cc][s][1], lo[cc][s][2], lo[cc][s][3], hi[cc][s][0], hi[cc][s][1], hi[cc][s][2], hi[cc][s][3]};
                o[2 * hf + cc] = __builtin_amdgcn_mfma_f32_32x32x16_bf16(A, s ? P1 : P0, o[2 * hf + cc], 0, 0, 0);
            }
        __builtin_amdgcn_sched_barrier(0);
    }
}
typedef float f32x2_t __attribute__((ext_vector_type(2))); typedef __bf16 bf16x2_t __attribute__((ext_vector_type(2)));
__device__ __forceinline__ unsigned cvtpk(float lo, float hi) { f32x2_t v = {lo, hi}; bf16x2_t b = __builtin_convertvector(v, bf16x2_t); return __builtin_bit_cast(unsigned, b); }
__device__ __forceinline__ void pack_p(const float (&p)[16], bf16x8& P0, bf16x8& P1) {
    u32x4 a, b; a.x = cvtpk(p[0], p[1]); a.y = cvtpk(p[2], p[3]); a.z = cvtpk(p[4], p[5]); a.w = cvtpk(p[6], p[7]);
    b.x = cvtpk(p[8], p[9]); b.y = cvtpk(p[10], p[11]); b.z = cvtpk(p[12], p[13]); b.w = cvtpk(p[14], p[15]);
    P0 = __builtin_bit_cast(bf16x8, a); P1 = __builtin_bit_cast(bf16x8, b);
}
__device__ __forceinline__ void softmax_step(float (&x)[16], float& m, float& l, f32x16 (&o)[4], bf16x8& P0, bf16x8& P1) {
    float mx = fmaxf(x[0], x[1]);
#pragma unroll
    for (int r = 2; r < 16; ++r) mx = fmaxf(mx, x[r]);
    mx = fmaxf(mx, __shfl_xor(mx, 32));
    const float mn = fmaxf(m, mx);
    const float alpha = __builtin_amdgcn_exp2f(m - mn);
    float ls = 0.f;
#pragma unroll
    for (int r = 0; r < 16; ++r) { const float p = __builtin_amdgcn_exp2f(x[r] - mn); ls += p; x[r] = p; }
    l = l * alpha + ls; m = mn;
    if (__any(alpha != 1.0f)) {
#pragma unroll
        for (int c = 0; c < 4; ++c) o[c] = o[c] * alpha;
    }
    pack_p(x, P0, P1);
}
__device__ __forceinline__ void softmax_fixed(float (&x)[16], float& l, bf16x8& P0, bf16x8& P1) {
    float ls = 0.f;
#pragma unroll
    for (int r = 0; r < 16; ++r) { const float p = __builtin_amdgcn_exp2f(x[r]); ls += p; x[r] = p; }
    l += ls;
    pack_p(x, P0, P1);
}
__device__ __forceinline__ float softmax_ref(const Args& a, int l, int hs, const bf16x8 (&qf)[8], int lane) {
    const float* kg = a.k_gain + (size_t)l * 12 * 128 + hs * 128;
    float gm = fmaxf(fabsf(kg[lane]), fabsf(kg[lane + 64]));
    float bm = a.rel_bias[(lane & 31) * 12 + hs];
#pragma unroll
    for (int o_ = 1; o_ < 64; o_ <<= 1) { gm = fmaxf(gm, __shfl_xor(gm, o_)); bm = fmaxf(bm, __shfl_xor(bm, o_)); }
    float qs = 0.f;
#pragma unroll
    for (int j = 0; j < 8; ++j) { const u32x4 qw = __builtin_bit_cast(u32x4, qf[j]);
        const float q0 = pg8::bf_lo(qw.x), q1 = pg8::bf_hi(qw.x), q2 = pg8::bf_lo(qw.y), q3 = pg8::bf_hi(qw.y), q4 = pg8::bf_lo(qw.z), q5 = pg8::bf_hi(qw.z), q6 = pg8::bf_lo(qw.w), q7 = pg8::bf_hi(qw.w);
        qs += (q0 * q0 + q1 * q1) + (q2 * q2 + q3 * q3) + (q4 * q4 + q5 * q5) + (q6 * q6 + q7 * q7); }
    qs += __shfl_xor(qs, 32);
    return C1 * sqrtf(qs) * (11.3137085f * 1.004f * gm) + bm * LOG2E + 1e-3f;
}
__device__ __forceinline__ void store_o(const f32x16 (&o)[4], float inv, bf16_t* orow, int lane) {
    const int h = lane >> 5;
#pragma unroll
    for (int c = 0; c < 4; ++c)
#pragma unroll
        for (int i = 0; i < 4; ++i) { u32x2 w; w.x = cvtpk(o[c][4 * i] * inv, o[c][4 * i + 1] * inv); w.y = cvtpk(o[c][4 * i + 2] * inv, o[c][4 * i + 3] * inv);
            *(GAS u32x2*)(orow + 32 * c + 8 * i + 4 * h) = w; }
}
__device__ __forceinline__ void load_q(bf16x8 (&qf)[8], const bf16_t* qrow, int lane) {
    const GAS bf16x8* p = (const GAS bf16x8*)(qrow + 8 * (lane >> 5));
#pragma unroll
    for (int j = 0; j < 8; ++j) qf[j] = p[2 * j];
}

__device__ __forceinline__ void unit_moba(const Args& a, int lyr, bf16_t* Ob, int OP, int b, int hm, int qb, LAS unsigned char* lds, int tid, int lane, int wave) {
    asm volatile("" : "+v"(lane));
    const bf16_t* qkv = (const bf16_t*)(a.ws + WS_QKV);
    LAS float* lutL = (LAS float*)(lds + ATT_LUT_OFF); LAS float* kmL = (LAS float*)(lds + ATT_KM_OFF);
    { const float* lutG = (const float*)(a.ws + WS_LUT) + hm * 4096;
#pragma unroll
      for (int k_ = 0; k_ < 8; ++k_) lutL[tid + k_ * NTHR] = lutG[tid + k_ * NTHR];
      const float* kmG = (const float*)(a.ws + WS_KM) + (size_t)(b * 6 + hm) * 16 * 128;
#pragma unroll
      for (int k_ = 0; k_ < 4; ++k_) kmL[tid + k_ * NTHR] = kmG[tid + k_ * NTHR]; }
    __syncthreads();
    const int h = lane >> 5, t0 = qb * 256, tw = t0 + 32 * wave, t = tw + (lane & 31), hg = 4 + hm;
    const bf16_t* Kb = qkv + (size_t)b * SEQ * QKVP + 2048 + hg * 128; const bf16_t* Vb = Kb + 2048;
    bf16x8 qf[8]; load_q(qf, qkv + (size_t)(b * SEQ + t) * QKVP + hg * 128, lane);
    unsigned selmask = 0u, anymask = 0u;
    if (qb > 0) {
        float v1 = -3e38f, v2 = -3e38f, v3 = -3e38f; int i1 = -1, i2 = -1, i3 = -1;
        for (int n = 0; n < qb; ++n) {
            float g = 0.f;
#pragma unroll
            for (int j = 0; j < 8; ++j) { const LAS f32x4* kp = (const LAS f32x4*)(kmL + n * 128 + 16 * j + 8 * h); const f32x4 k0 = kp[0], k1 = kp[1];
                const u32x4 qw = __builtin_bit_cast(u32x4, qf[j]);
                g += pg8::bf_lo(qw.x) * k0[0] + pg8::bf_hi(qw.x) * k0[1] + pg8::bf_lo(qw.y) * k0[2] + pg8::bf_hi(qw.y) * k0[3]
                   + pg8::bf_lo(qw.z) * k1[0] + pg8::bf_hi(qw.z) * k1[1] + pg8::bf_lo(qw.w) * k1[2] + pg8::bf_hi(qw.w) * k1[3]; }
            g += __shfl_xor(g, 32);
            if (g > v1) { v3 = v2; i3 = i2; v2 = v1; i2 = i1; v1 = g; i1 = n; } else if (g > v2) { v3 = v2; i3 = i2; v2 = g; i2 = n; } else if (g > v3) { v3 = g; i3 = n; }
        }
        if (i1 >= 0) selmask |= 1u << i1; if (i2 >= 0) selmask |= 1u << i2; if (i3 >= 0) selmask |= 1u << i3;
        for (int n = 0; n < qb; ++n) if (__ballot((selmask >> n) & 1u) != 0ull) anymask |= 1u << n;
    }
    volatile LAS unsigned* misc = (volatile LAS unsigned*)(lds + MISC_OFF);
    if (tid == 0) misc[4] = 0u;
    __syncthreads();
    if (lane == 0 && anymask != 0u) __hip_atomic_fetch_or((LAS unsigned*)(lds + MISC_OFF + 16), anymask, __ATOMIC_RELAXED, __HIP_MEMORY_SCOPE_WORKGROUP);
    __syncthreads();
    const unsigned anywg = misc[4];
    const float nref = -softmax_ref(a, lyr, hm, qf, lane);
    float l = 0.f; f32x16 o[4];
#pragma unroll
    for (int c = 0; c < 4; ++c) o[c] = (f32x16){0.f, 0.f, 0.f, 0.f, 0.f, 0.f, 0.f, 0.f, 0.f, 0.f, 0.f, 0.f, 0.f, 0.f, 0.f, 0.f};
    const int srow = 8 * (wave >> 1) + ((lane >> 2) & 7), sch = 4 * (2 * (wave & 1) + (lane >> 5)) + ((lane & 3) ^ ((srow >> 2) & 3));
    const bf16_t* kg = Kb + (size_t)srow * QKVP + sch * 8; const bf16_t* vg = Vb + (size_t)srow * QKVP + sch * 8;
    const int r31 = lane & 31; const unsigned x0 = (r31 >> 2) & 1, x1 = (r31 >> 3) & 1;
    const unsigned kb_l = 2048u * (r31 >> 3) + 64u * (r31 & 7) + 16u * ((unsigned)h ^ x0);
    const unsigned ke0 = kb_l + 32u * x1, ke1 = kb_l + 32u * (x1 ^ 1u);
#define MOBA_STAGE(buf, nblk, stp) do { const size_t ro_ = (size_t)(256 * (nblk) + 64 * (stp)) * QKVP; LAS unsigned char* d_ = lds + ATT_V_OFF + (buf) * 32768 + wave * 1024; \
        __builtin_amdgcn_global_load_lds((const unsigned*)(kg + ro_), (LAS unsigned*)(d_), 16, 0, 0); \
        __builtin_amdgcn_global_load_lds((const unsigned*)(kg + ro_ + 32 * QKVP), (LAS unsigned*)(d_ + 8192), 16, 0, 0); \
        __builtin_amdgcn_global_load_lds((const unsigned*)(vg + ro_), (LAS unsigned*)(d_ + 16384), 16, 0, 0); \
        __builtin_amdgcn_global_load_lds((const unsigned*)(vg + ro_ + 32 * QKVP), (LAS unsigned*)(d_ + 24576), 16, 0, 0); } while (0)
    int n = qb, st = 3;
    MOBA_STAGE(0, n, st);
    asm volatile("s_waitcnt vmcnt(0)" ::: "memory");
    __syncthreads();
    int cur = 0;
    for (;;) {
        int nn = n, nst = st; bool has_next = true;
        if (n == qb) { if (st > 0) nst = st - 1; else { if (anywg == 0u) has_next = false; else { nn = __builtin_ctz(anywg); nst = 0; } } }
        else { if (st < 3) nst = st + 1; else { const unsigned rest = anywg & ~((2u << n) - 1u); if (rest == 0u) has_next = false; else { nn = __builtin_ctz(rest); nst = 0; } } }
        if (has_next) MOBA_STAGE(cur ^ 1, nn, nst);
        const bool own = (n == qb);
        const bool active = own ? (2 * st <= wave) : (((anymask >> (n & 31)) & 1u) != 0u);
        if (active) {
            LAS unsigned char* kl = lds + ATT_V_OFF + cur * 32768;
            const int dbase = t - (256 * n + 64 * st);
            const float lanebias = own ? nref : (((selmask >> (n & 31)) & 1u) ? nref : NEG);
            bf16x8 PA0, PA1, PB0, PB1;
#pragma unroll
            for (int tt = 0; tt < 2; ++tt) {
                bf16x8 kc[8];
#pragma unroll
                for (int s = 0; s < 8; ++s) kc[s] = *(const LAS bf16x8*)(kl + 8192 * tt + ((s & 1) ? ke1 : ke0) + 512 * (s >> 1));
                asm volatile("s_waitcnt lgkmcnt(0)" ::: "memory"); __builtin_amdgcn_sched_barrier(0);
                const f32x16 sacc = qk(kc, qf);
                const int db = dbase - 32 * tt;
                float x[16];
                if (own) {
#pragma unroll
                    for (int r = 0; r < 16; ++r) { const int dist = db - (8 * (r >> 2) + 4 * h + (r & 3)); const float lvv = lutL[dist < 0 ? 0 : dist];
                        const float xx = __builtin_fmaf(sacc[r], C1, lvv) + nref; x[r] = (dist >= 0) ? xx : NEG; }
                } else {
                    const LAS float* lp = lutL + (db - 4 * h);
#pragma unroll
                    for (int r = 0; r < 16; ++r) x[r] = __builtin_fmaf(sacc[r], C1, lp[-(8 * (r >> 2) + (r & 3))]) + lanebias;
                }
                if (tt == 0) softmax_fixed(x, l, PA0, PA1); else softmax_fixed(x, l, PB0, PB1);
            }
            pv(o, kl + 16384, PA0, PA1, lane);
            pv(o, kl + 24576, PB0, PB1, lane);
        }
        if (!has_next) break;
        asm volatile("s_waitcnt vmcnt(0)" ::: "memory");
        __syncthreads();
        n = nn; st = nst; cur ^= 1;
    }
#undef MOBA_STAGE
    l += __shfl_xor(l, 32);
    store_o(o, 1.0f / l, Ob + (size_t)(b * SEQ + t) * OP + hg * 128, lane);
}

__device__ __forceinline__ void dil_desc(int idx, int tb, int c4, int i, int& s0, int& stride, int& delta0, int& pat, int& aa) {
    if (idx < 5) { const int kt = 4 - idx; stride = 4; s0 = tb + c4 + 4 * (-128 + 32 * kt); delta0 = i + 128 - 32 * kt; pat = 0; aa = 0; }
    else if (idx < 13) { const int kt = idx - 5; stride = 1; s0 = tb - 128 + 32 * kt; delta0 = c4 + 4 * i + 128 - 32 * kt; pat = 1; aa = 0; }
    else { aa = (idx - 13) / 5; const int kt = (idx - 13) % 5; stride = 16; s0 = tb + c4 + 4 * aa + 16 * (-128 + 32 * kt); delta0 = (i >> 2) + 128 - 32 * kt; pat = 2; }
}
__device__ __forceinline__ void unit_dilated(const Args& a, int lyr, bf16_t* Ob, int OP, int b, int hd, int qb, LAS unsigned char* lds, int tid, int lane, int wave) {
    asm volatile("" : "+v"(lane));
    const bf16_t* qkv = (const bf16_t*)(a.ws + WS_QKV);
    LAS float* lut3 = (LAS float*)(lds + ATT_LUT_OFF);
    { const float* lutG = (const float*)(a.ws + WS_LUT) + (6 + hd) * 4096;

#pragma unroll
      for (int k_ = 0; k_ < 3; ++k_) { const int e = tid + k_ * NTHR; if (e >= 3 * 384) break; const int p = e / 384, d = e % 384 - 128; const int st = p == 0 ? 4 : (p == 1 ? 1 : 16); lut3[e] = (d >= 0 && d <= 128) ? lutG[st * d] : 0.f; } }
    __syncthreads();
    LAS unsigned char* vl = lds + ATT_V_OFF + wave * 8192;
    const int h = lane >> 5, i = lane & 31, t0 = qb * 256, tb = t0 + 128 * (wave >> 2), c4 = wave & 3, t = tb + c4 + 4 * i, hg = 10 + hd;
    const bf16_t* Kb = qkv + (size_t)b * SEQ * QKVP + 2048 + hg * 128; const bf16_t* Vb = Kb + 2048;
    bf16x8 qf[8]; load_q(qf, qkv + (size_t)(b * SEQ + t) * QKVP + hg * 128, lane);
    const float nref = -softmax_ref(a, lyr, 6 + hd, qf, lane);
    const unsigned dmax4 = (unsigned)((t >> 2) < 128 ? (t >> 2) : 128), dmax1 = (unsigned)(t < 128 ? t : 128), dmax16 = (unsigned)((t >> 4) < 128 ? (t >> 4) : 128);
    float l = 0.f; f32x16 o[4];
#pragma unroll
    for (int c = 0; c < 4; ++c) o[c] = (f32x16){0.f, 0.f, 0.f, 0.f, 0.f, 0.f, 0.f, 0.f, 0.f, 0.f, 0.f, 0.f, 0.f, 0.f, 0.f, 0.f};
    LAS unsigned char* kl = lds + DIL_K_OFF + wave * 8192;
    const int kc_ = (lane >> 2) & 7, kd_ = lane & 3;
#define DIL_KDMA(s0v, strv) do { _Pragma("unroll") for (int i_ = 0; i_ < 8; ++i_) { const int row_ = 8 * (i_ >> 1) + kc_; const int ch_ = 4 * (2 * (i_ & 1) + (lane >> 5)) + (kd_ ^ ((row_ >> 2) & 3)); \
        const int s_ = clamp_s((s0v) + (strv) * row_); \
        __builtin_amdgcn_global_load_lds((const unsigned*)(Kb + (size_t)s_ * QKVP + ch_ * 8), (LAS unsigned*)(kl + 1024 * i_), 16, 0, 0); } } while (0)
    const int r31 = lane & 31; const unsigned kx0 = (r31 >> 2) & 1, kx1 = (r31 >> 3) & 1;
    const unsigned kb_l = 2048u * (r31 >> 3) + 64u * (r31 & 7) + 16u * ((unsigned)h ^ kx0);
    const unsigned ke0 = kb_l + 32u * kx1, ke1 = kb_l + 32u * (kx1 ^ 1u);
    u32x4 vr[8];
    int s0, stride, delta0, pat, aa;
    dil_desc(0, tb, c4, i, s0, stride, delta0, pat, aa);
    DIL_KDMA(s0, stride); load_v(vr, Vb, s0, stride, lane);
    for (int idx = 0; idx < 33;) {
        asm volatile("s_waitcnt vmcnt(0)" ::: "memory");
        bf16x8 kc[8];
#pragma unroll
        for (int s = 0; s < 8; ++s) kc[s] = *(const LAS bf16x8*)(kl + ((s & 1) ? ke1 : ke0) + 512 * (s >> 1));
        asm volatile("s_waitcnt lgkmcnt(0)" ::: "memory"); __builtin_amdgcn_sched_barrier(0);
        int s0n = 0, stn = 1, d0n = 0, patn = 0, aan = 0, nidx = idx + 1;
#pragma unroll 1
        for (; nidx < 33; ++nidx) {
            int last;
            if (nidx < 5) last = tb + c4 + 4 * (-128 + 32 * (4 - nidx) + 31);
            else if (nidx < 13) last = tb - 128 + 32 * (nidx - 5) + 31;
            else last = tb + c4 + 4 * ((nidx - 13) / 5) + 16 * (-128 + 32 * ((nidx - 13) % 5) + 31);
            if (last >= 0) break; }
        const bool more = nidx < 33;
        if (more) { dil_desc(nidx, tb, c4, i, s0n, stn, d0n, patn, aan); DIL_KDMA(s0n, stn); }
        const f32x16 sacc = qk(kc, qf);
        stage_v(vl, vr, lane);
        if (more) load_v(vr, Vb, s0n, stn, lane);
        const unsigned dmax = pat == 0 ? dmax4 : (pat == 1 ? dmax1 : dmax16);
        const float lb = (pat == 2 && (i & 3) != aa) ? NEG : nref;
        const int dk = delta0 - 4 * h;
        const LAS float* lp = lut3 + pat * 384 + 128 + dk;
        float x[16];
#pragma unroll
        for (int r = 0; r < 16; ++r) { const float lvv = lp[-(8 * (r >> 2) + (r & 3))]; const float xx = __builtin_fmaf(sacc[r], C1, lvv) + lb;
            const unsigned delta = (unsigned)(dk - (8 * (r >> 2) + (r & 3))); x[r] = (delta <= dmax) ? xx : NEG; }
        bf16x8 P0, P1; softmax_fixed(x, l, P0, P1);
        pv(o, vl, P0, P1, lane);
        s0 = s0n; stride = stn; delta0 = d0n; pat = patn; aa = aan; idx = nidx;
    }
#undef DIL_KDMA
    l += __shfl_xor(l, 32);
    store_o(o, 1.0f / l, Ob + (size_t)(b * SEQ + t) * OP + hg * 128, lane);
}

__device__ __forceinline__ void unit_sb(const Args& a, bf16_t* Ob, int OP, int b, int ha, int qb, LAS unsigned char* lds, int tid, int lane, int wave) {
    asm volatile("" : "+v"(lane));
    const bf16_t* qkv = (const bf16_t*)(a.ws + WS_QKV);
    LAS unsigned char* vl = lds + ATT_V_OFF + wave * 8192;
    const int h = lane >> 5, t0 = qb * 256, tw = t0 + 32 * wave, t = tw + (lane & 31);
    const bf16_t* Kb = qkv + (size_t)b * SEQ * QKVP + 2048 + ha * 128; const bf16_t* Vb = Kb + 2048;
    bf16x8 qf[8]; load_q(qf, qkv + (size_t)(b * SEQ + t) * QKVP + ha * 128, lane);
    f32x16 o[4];
#pragma unroll
    for (int c = 0; c < 4; ++c) o[c] = (f32x16){0.f, 0.f, 0.f, 0.f, 0.f, 0.f, 0.f, 0.f, 0.f, 0.f, 0.f, 0.f, 0.f, 0.f, 0.f, 0.f};
    float R = 0.f;
    bf16x8 kc[8];
    int kt = tw >> 5;
    load_k(kc, Kb, 32 * kt, 1, lane);
    for (;;) {
        u32x4 vr[8]; load_v(vr, Vb, 32 * kt, 1, lane);
        const f32x16 sacc = qk(kc, qf);
        const bool more = kt > 0;
        if (more) load_k(kc, Kb, 32 * (kt - 1), 1, lane);
        stage_v(vl, vr, lane);
        const int dbase = t - 32 * kt;
        float lb[16], g[4], gp[4];
#pragma unroll
        for (int i = 0; i < 4; ++i) { g[i] = 0.f;
#pragma unroll
            for (int j = 0; j < 4; ++j) { const int r = 4 * i + j; const int kap = 8 * i + 4 * h + j; const bool past = kap < dbase;
                const float z = sacc[r] * SCALE; const float sp = __logf(1.0f + __expf(-fabsf(z)));
                lb[r] = fminf(z, 0.f) - sp; g[i] += past ? (lb[r] - z) : 0.f; }
            gp[i] = __shfl_xor(g[i], 32); }
        float sg[4]; sg[3] = 0.f; sg[2] = g[3] + gp[3]; sg[1] = sg[2] + g[2] + gp[2]; sg[0] = sg[1] + g[1] + gp[1];
        const float tot = sg[0] + g[0] + gp[0];
#pragma unroll
        for (int i = 0; i < 4; ++i) { const float basei = sg[i] + R + (h == 0 ? gp[i] : 0.f);
            float suf = 0.f;
#pragma unroll
            for (int j = 3; j >= 0; --j) { const int r = 4 * i + j; const int kap = 8 * i + 4 * h + j; const bool past = kap < dbase;
                const float l1 = past ? (lb[r] - sacc[r] * SCALE) : 0.f;
                lb[r] = past ? __expf(lb[r] + suf + basei) : 0.f; suf += l1; } }
        R += tot;
        bf16x8 P0, P1; pack_p(lb, P0, P1);
        pv(o, vl, P0, P1, lane);
        if (!more || __all(R < -110.0f)) break;
        --kt;
    }
    store_o(o, 1.0f, Ob + (size_t)(b * SEQ + t) * OP + ha * 128, lane);
}

__device__ __forceinline__ void phase_attention(const Args& a, int l, int rep, LAS unsigned char* lds, int tid, int lane, int wave) {
    unsigned* ctr0 = (unsigned*)(a.ws + WS_CTR) + (l + 2 * rep) * 64;
    bf16_t* Ob = l == 0 ? (bf16_t*)a.out : (bf16_t*)(a.ws + WS_QKV); const int OP = l == 0 ? DM : QKVP;
    volatile LAS unsigned* misc = (volatile LAS unsigned*)(lds + MISC_OFF);
    int xq = (int)((unsigned)__builtin_amdgcn_s_getreg((3 << 11) | 20) & 7u), left = 8;
    for (;;) {
        __syncthreads();
        if (tid == 0) misc[0] = atomicAdd(ctr0 + xq * 8, 1u);
        __syncthreads();
        const int j = (int)misc[0];
        if (j >= 128) { if (--left == 0) break; xq = (xq + 1) & 7; continue; }
        if (j < 48) { const int qb = 15 - j / 3, bh = 3 * xq + j % 3; unit_moba(a, l, Ob, OP, bh / 6, bh % 6, qb, lds, tid, lane, wave); }
        else if (j < 96) { const int jj = j - 48, qb = jj % 16, bh = 3 * xq + jj / 16; unit_dilated(a, l, Ob, OP, bh / 6, bh % 6, qb, lds, tid, lane, wave); }
        else { const int jj = j - 96, qb = 15 - jj / 2, bh = 2 * xq + jj % 2; unit_sb(a, Ob, OP, bh / 4, bh % 4, qb, lds, tid, lane, wave); }
    }
}
}

__device__ __forceinline__ void grid_barrier(unsigned* bar, unsigned k) {
    asm volatile("s_waitcnt vmcnt(0) lgkmcnt(0)" ::: "memory");
    __syncthreads();
    if (threadIdx.x == 0) {
        const unsigned G = gridDim.x, g = blockIdx.x & 7u, nloc = (G - g + 7u) >> 3, ngrp = G < 8u ? G : 8u;
        __builtin_amdgcn_fence(__ATOMIC_RELEASE, "agent");
        asm volatile("s_waitcnt vmcnt(0)" ::: "memory");
        const unsigned old = __hip_atomic_fetch_add(bar + 64 * g, 1u, __ATOMIC_RELAXED, __HIP_MEMORY_SCOPE_AGENT);
        if (old + 1u == nloc * k) __hip_atomic_fetch_add(bar + 512, 1u, __ATOMIC_RELAXED, __HIP_MEMORY_SCOPE_AGENT);
        unsigned spins = 0;
        while (__hip_atomic_load(bar + 512, __ATOMIC_RELAXED, __HIP_MEMORY_SCOPE_AGENT) < ngrp * k) { __builtin_amdgcn_s_sleep(2); if (++spins > (1u << 24)) break; }
        __builtin_amdgcn_fence(__ATOMIC_ACQUIRE, "agent");
        asm volatile("s_waitcnt vmcnt(0)" ::: "memory");
    }
    __syncthreads();
}

__global__ void __launch_bounds__(NTHR, 2) hybrid_fwd(Args a_) {
    __shared__ __attribute__((aligned(16))) unsigned char lds_raw[LDS_BYTES];
    LAS unsigned char* lds = (LAS unsigned char*)lds_raw;
    const int ph_lo = a_.ph_lo, ph_hi = a_.ph_hi;
    int n_grid = 0;
    for (int ph = ph_lo; ph < ph_hi; ++ph) {
        {
        constexpr int rep = 0;
        int tid = threadIdx.x; asm volatile("" : "+v"(tid));
        const int lane = tid & 63, wave = __builtin_amdgcn_readfirstlane(tid >> 6);
        const __attribute__((address_space(4))) Args* ap = (const __attribute__((address_space(4))) Args*)__builtin_amdgcn_kernarg_segment_ptr(); asm volatile("" : "+s"(ap));
        Args a; a.x = ap->x; a.g_mix = ap->g_mix; a.w_in = ap->w_in; a.q_gain = ap->q_gain; a.k_gain = ap->k_gain; a.w_branch = ap->w_branch; a.w_out = ap->w_out;
        a.g_ffn = ap->g_ffn; a.w_gu = ap->w_gu; a.w_down = ap->w_down; a.rel_bias = ap->rel_bias; a.out = ap->out; a.ws = ap->ws; a.ph_lo = 0; a.ph_hi = 0;
        unsigned char* ws = a.ws;
        const int G = gridDim.x, cidx = blockIdx.x;
        float* ss = (float*)(ws + WS_SS);
        bf16_t* xb = (bf16_t*)(ws + WS_XB); bf16_t* qkv = (bf16_t*)(ws + WS_QKV); bf16_t* gates = (bf16_t*)(ws + WS_GATES);
        bf16_t* ob = qkv; bf16_t* merged = qkv + 2048; bf16_t* act = qkv;
        if (ph == 0) phase_prologue(a, lds, tid, lane, wave);
        else {
            const int l = (ph - 1) / 7, k = (ph - 1) % 7;
            if (k == 0) {
                pg8::Gemm g{xb, (const bf16_t*)(ws + WS_WIN) + (size_t)l * NIN * DM, DM, DM, M, NIN, DM}; pg8::StaticOrder S; S.init(M, NIN, G, cidx);
                pg8::EpiIn E{qkv, gates, ss + (size_t)(2 * l) * M, a.q_gain + (size_t)l * 12 * 128, a.k_gain + (size_t)l * 12 * 128, (float*)(ws + WS_KM), lds + 132096};
                pg8::gemm_phase<pg8::EpiIn, pg8::StaticOrder>(lds, g, S, E, tid);
            } else if (k == 1) {   }
            else if (k == 2) att::phase_attention(a, l, rep, lds, tid, lane, wave);
            else if (k == 3) {
                const bf16_t* wbt = (const bf16_t*)(ws + WS_WBR) + (size_t)l * DM * DM;
                for (int br = 0; br < 3; ++br) {
                    const int k0 = br == 0 ? 0 : (br == 1 ? 512 : 1280), kl = br == 0 ? 512 : 768;
                    pg8::Gemm g{(l == 0 ? (const bf16_t*)a.out : ob) + k0, wbt + k0, l == 0 ? DM : QKVP, DM, M, DM, kl}; pg8::StaticOrder S; S.init(M, DM, G, cidx);
                    pg8::EpiBranch E{merged, gates, br * 2048, br == 0 ? 1 : 0};
                    pg8::gemm_phase<pg8::EpiBranch, pg8::StaticOrder>(lds, g, S, E, tid);
                }
            } else if (k == 4 || k == 6) {
                const bool dn = (k == 6);
                pg8::Gemm g{dn ? act : merged, dn ? (const bf16_t*)(ws + WS_WDN) + (size_t)l * DM * DFF : (const bf16_t*)(ws + WS_WOUT) + (size_t)l * DM * DM,
                            dn ? DFF : QKVP, dn ? DFF : DM, M, DM, dn ? DFF : DM};
                pg8::StaticOrder S; S.init(M, DM, G, cidx);
                const float* base = (l == 0 && !dn) ? a.x : a.out;
                const bool lastp = dn && (l == 1);
                pg8::EpiResid E{base, a.out, lastp ? nullptr : xb, lastp ? nullptr : ss + (size_t)(2 * l + (dn ? 2 : 1)) * M};
                pg8::gemm_phase<pg8::EpiResid, pg8::StaticOrder>(lds, g, S, E, tid);
            } else {
                pg8::Gemm g{xb, (const bf16_t*)(ws + WS_WGU) + (size_t)l * NGU * DM, DM, DM, M, NGU, DM}; pg8::StaticOrder S; S.init(M, NGU, G, cidx);
                pg8::EpiGU E{act, ss + (size_t)(2 * l + 1) * M};
                pg8::gemm_phase<pg8::EpiGU, pg8::StaticOrder>(lds, g, S, E, tid);
            }
        }
        }
        if (ph + 1 < ph_hi) {
            if (ph == ph_lo) cg::this_grid().sync();
            else if ((ph - 1) % 7 != 0) { ++n_grid; grid_barrier((unsigned*)(a_.ws + WS_CTR) + 256, (unsigned)n_grid); }
        }
    }
}

__global__ void fill_const(float* o, int n, float v) { for (int i = blockIdx.x * blockDim.x + threadIdx.x; i < n; i += gridDim.x * blockDim.x) o[i] = v; }
extern "C" void kernel_launch(void* const* d_in, const int* in_sizes, int n_in, void* d_out, int out_size, void* d_ws, size_t ws_size, hipStream_t stream) {
    static int grid = 0;
    if (grid == 0) {
        if (n_in != 11 || in_sizes[0] != M * DM || out_size != M * DM || ws_size < WS_END) { fprintf(stderr, "kernel_launch: unexpected shapes / workspace (n_in %d, ws %zu); nothing launched\n", n_in, ws_size); grid = -1; return; }
        int dev = 0, cus = 0, per_cu = 0;
        if (hipGetDevice(&dev) != hipSuccess || hipDeviceGetAttribute(&cus, hipDeviceAttributeMultiprocessorCount, dev) != hipSuccess || cus < 1) cus = 256;
        if (hipOccupancyMaxActiveBlocksPerMultiprocessor(&per_cu, hybrid_fwd, NTHR, 0) != hipSuccess || per_cu < 1) per_cu = 1;
        (void)hipGetLastError();
        grid = cus * per_cu;
    }
    if (grid < 0) return;
    Args a{};
    a.x = (const float*)d_in[0]; a.g_mix = (const float*)d_in[1]; a.w_in = (const float*)d_in[2]; a.q_gain = (const float*)d_in[3]; a.k_gain = (const float*)d_in[4];
    a.w_branch = (const float*)d_in[5]; a.w_out = (const float*)d_in[6]; a.g_ffn = (const float*)d_in[7]; a.w_gu = (const float*)d_in[8]; a.w_down = (const float*)d_in[9];
    a.rel_bias = (const float*)d_in[10]; a.out = (float*)d_out; a.ws = (unsigned char*)d_ws;
#if MK_COOP
    a.ph_lo = 0; a.ph_hi = MK_PH_END;
    void* args[] = {&a};
    hipError_t e = hipLaunchCooperativeKernel((void*)hybrid_fwd, dim3(grid), dim3(NTHR), args, 0, stream);
    if (e != hipSuccess) fprintf(stderr, "kernel_launch: cooperative launch failed: %s (grid %d)\n", hipGetErrorString(e), grid);
#else
    for (int ph = 0; ph < MK_PH_END; ++ph) { a.ph_lo = ph; a.ph_hi = ph + 1; hipLaunchKernelGGL(hybrid_fwd, dim3(grid), dim3(NTHR), 0, stream, a); }
#endif
}
```

```cpp
#include <hip/hip_runtime.h>
#include <hip/hip_cooperative_groups.h>
#include <cstdio>
#include <cstdint>
namespace cg = cooperative_groups;

#ifndef MK_DUP_PRO
#define MK_DUP_PRO 1
#define MK_DUP_BIG 1
#define MK_DUP_BR 1
#define MK_DUP_ATT 1
#define MK_DUP_SYNC 1
#endif
#ifndef MK_PH_END
#define MK_PH_END 15
#endif
#ifndef MK_COOP
#define MK_COOP 1
#endif

namespace pg8 {
#define PG8_LAS __attribute__((address_space(3)))
typedef unsigned short bf16_t;
typedef short bf16x8 __attribute__((ext_vector_type(8)));
typedef float f32x4 __attribute__((ext_vector_type(4)));
typedef unsigned u32x4 __attribute__((ext_vector_type(4)));
typedef unsigned u32x2 __attribute__((ext_vector_type(2)));
constexpr int BM = 256, BK = 64, HALF = 128, HTB = HALF * BK * 2, STAGE_BYTES = 8 * HTB, NXCD = 8, WGM = 8;

__host__ __device__ __forceinline__ int lds_byte(int r, int c) { const int st = (r >> 4) * 2 + (c >> 5), rr = r & 15, cc = c & 31, ob = rr * 64 + cc * 2; return st * 1024 + (ob ^ (((ob >> 9) & 1) << 5)); }
__host__ __device__ __forceinline__ void stage_rc(int b, int& R, int& C) { const int st = b / 1024, sb = b % 1024, swz = sb ^ (((sb >> 9) & 1) << 5); R = (st >> 1) * 16 + swz / 64; C = (st & 1) * 32 + (swz % 64) / 2; }
__host__ __device__ __forceinline__ int perm32(int rho) { const int n = rho >> 4, i = rho & 15; return 8 * (i >> 2) + 4 * n + (i & 3); }

struct Unit { int pm, pn; };
struct Gemm { const bf16_t* A; const bf16_t* Bt; int lda, ldb, M, N, K; };

struct StaticOrder {
    int nM, nN, nwg, G, c;
    __host__ __device__ void init(int M, int N, int G_, int c_) { nM = M / BM; nN = N / BM; nwg = nM * nN; G = G_; c = c_; }
    __host__ __device__ bool next(int i, Unit& u) const {
        const int L = i * G + c; if (L >= nwg) return false;
        int wgid = L; { const int q = nwg / NXCD, r = nwg % NXCD, xcd = wgid % NXCD, off = wgid / NXCD; wgid = (xcd < r ? xcd * (q + 1) : r * (q + 1) + (xcd - r) * q) + off; }
        const int nig = WGM * nN, gid = wgid / nig, fm = gid * WGM, gsz = (nM - fm) < WGM ? (nM - fm) : WGM;
        u.pm = fm + ((wgid % nig) % gsz); u.pn = (wgid % nig) / gsz; return true;
    }
};

typedef float f32x2c_t __attribute__((ext_vector_type(2))); typedef __bf16 bf16x2c_t __attribute__((ext_vector_type(2)));
__device__ __forceinline__ unsigned cvt_pk_bf16(float lo, float hi) { f32x2c_t v = {lo, hi}; bf16x2c_t b = __builtin_convertvector(v, bf16x2c_t); return __builtin_bit_cast(unsigned, b); }
__device__ __forceinline__ float bf_lo(unsigned w) { return __uint_as_float(w << 16); }
__device__ __forceinline__ float bf_hi(unsigned w) { return __uint_as_float(w & 0xffff0000u); }
__device__ __forceinline__ float sigmoidf_(float v) { return __builtin_amdgcn_rcpf(1.0f + __builtin_amdgcn_exp2f(v * -1.4426950408889634f)); }


struct EpiIn {
    static constexpr bool PERM = true;
    bf16_t* qkv; bf16_t* gates; const float* ss; const float* qg; const float* kg; float* kmean; PG8_LAS unsigned char* xl;
    __device__ __forceinline__ void operator()(const f32x4 (&acc)[2][2][4][2], const Unit& u, int wr, int wc, int fr, int fq) const {
        const int row0 = u.pm * BM + wr * 64 + fr; const bool isg = u.pn >= 24;
        bf16_t* base = isg ? gates : qkv; const int col0 = (isg ? u.pn - 24 : u.pn) * BM + wc * 32 + 8 * fq;
        float rsv[2][4];
#pragma unroll
        for (int ai = 0; ai < 2; ++ai)
#pragma unroll
            for (int m = 0; m < 4; ++m) rsv[ai][m] = ss[row0 + ai * HALF + m * 16];
#pragma unroll
        for (int ai = 0; ai < 2; ++ai)
#pragma unroll
            for (int m = 0; m < 4; ++m) rsv[ai][m] = rsqrtf(rsv[ai][m] * (1.0f / 2048.0f) + 1e-6f);
        const int sec = u.pn >> 3, hp = u.pn & 7; const bool soft = (u.pn < 16) && (hp >= 2);
        if (!soft) {
#pragma unroll
            for (int ai = 0; ai < 2; ++ai)
#pragma unroll
                for (int m = 0; m < 4; ++m) { const int row = row0 + ai * HALF + m * 16; const float rs = rsv[ai][m];
                    bf16_t* rowp = base + (size_t)row * 6144 + col0;
#pragma unroll
                    for (int bj = 0; bj < 2; ++bj) { f32x4 v0 = acc[ai][bj][m][0] * rs, v1 = acc[ai][bj][m][1] * rs;
                        if (isg) { v0 = (f32x4){sigmoidf_(v0[0]), sigmoidf_(v0[1]), sigmoidf_(v0[2]), sigmoidf_(v0[3])}; v1 = (f32x4){sigmoidf_(v1[0]), sigmoidf_(v1[1]), sigmoidf_(v1[2]), sigmoidf_(v1[3])}; }
                        u32x4 w; w.x = cvt_pk_bf16(v0[0], v0[1]); w.y = cvt_pk_bf16(v0[2], v0[3]); w.z = cvt_pk_bf16(v1[0], v1[1]); w.w = cvt_pk_bf16(v1[2], v1[3]);
                        *(u32x4*)(rowp + bj * HALF) = w; } }
            return;
        }
        PG8_LAS float* part = (PG8_LAS float*)xl; PG8_LAS float* colsum = (PG8_LAS float*)(xl + 8192);
#pragma unroll
        for (int ai = 0; ai < 2; ++ai)
#pragma unroll
            for (int m = 0; m < 4; ++m)
#pragma unroll
                for (int bj = 0; bj < 2; ++bj) { const f32x4 a0 = acc[ai][bj][m][0] * rsv[ai][m], a1 = acc[ai][bj][m][1] * rsv[ai][m];
                    float s = (a0[0] * a0[0] + a0[1] * a0[1]) + (a0[2] * a0[2] + a0[3] * a0[3]) + (a1[0] * a1[0] + a1[1] * a1[1]) + (a1[2] * a1[2] + a1[3] * a1[3]);
                    s += __shfl_xor(s, 16); s += __shfl_xor(s, 32);
                    if (fq == 0) part[((ai * HALF + wr * 64 + m * 16 + fr) * 2 + bj) * 4 + wc] = s; }
        asm volatile("s_waitcnt lgkmcnt(0)" ::: "memory"); __builtin_amdgcn_s_barrier(); asm volatile("" ::: "memory");
        const bool km = (sec == 1) && (hp <= 4);
        const float* gbase = (sec ? kg : qg) + (2 * hp - 4) * 128 + wc * 32 + 8 * fq;
        float gn[2][8], cs[2][8];
#pragma unroll
        for (int bj = 0; bj < 2; ++bj)
#pragma unroll
            for (int e = 0; e < 8; ++e) { gn[bj][e] = gbase[bj * 128 + e]; cs[bj][e] = 0.f; }
#pragma unroll
        for (int ai = 0; ai < 2; ++ai)
#pragma unroll
            for (int m = 0; m < 4; ++m) { const int rl = ai * HALF + wr * 64 + m * 16 + fr; bf16_t* rowp = base + (size_t)(u.pm * BM + rl) * 6144 + col0;
#pragma unroll
                for (int bj = 0; bj < 2; ++bj) { const f32x4 p = *(const PG8_LAS f32x4*)(part + (rl * 2 + bj) * 4);
                    const float sc = rsv[ai][m] * rsqrtf(((p[0] + p[1]) + (p[2] + p[3])) * (1.0f / 128.0f) + 1e-6f);
                    float r[8];
#pragma unroll
                    for (int e = 0; e < 4; ++e) { r[e] = acc[ai][bj][m][0][e] * sc * gn[bj][e]; r[4 + e] = acc[ai][bj][m][1][e] * sc * gn[bj][4 + e]; }
#pragma unroll
                    for (int e = 0; e < 8; ++e) cs[bj][e] += r[e];
                    u32x4 w; w.x = cvt_pk_bf16(r[0], r[1]); w.y = cvt_pk_bf16(r[2], r[3]); w.z = cvt_pk_bf16(r[4], r[5]); w.w = cvt_pk_bf16(r[6], r[7]);
                    *(u32x4*)(rowp + bj * HALF) = w; } }
        if (km) {
#pragma unroll
            for (int bj = 0; bj < 2; ++bj)
#pragma unroll
                for (int e = 0; e < 8; ++e) { float c = cs[bj][e]; c += __shfl_xor(c, 1); c += __shfl_xor(c, 2); c += __shfl_xor(c, 4); c += __shfl_xor(c, 8);
                    if (fr == 0) colsum[wr * 256 + bj * 128 + wc * 32 + 8 * fq + e] = c; }
            asm volatile("s_waitcnt lgkmcnt(0)" ::: "memory"); __builtin_amdgcn_s_barrier(); asm volatile("" ::: "memory");
            if (wr == 0) { const int c = wc * 64 + fq * 16 + fr;
                const int hs = 2 * hp - 4 + (c >> 7);
                kmean[((size_t)((u.pm >> 4) * 6 + hs) * 16 + (u.pm & 15)) * 128 + (c & 127)] = (colsum[c] + colsum[256 + c]) * (1.0f / 256.0f); }
        }
    }
};
struct EpiGU {
    static constexpr bool PERM = true;
    bf16_t* act; const float* ss;
    __device__ __forceinline__ void operator()(const f32x4 (&acc)[2][2][4][2], const Unit& u, int wr, int wc, int fr, int fq) const {
        const int row0 = u.pm * BM + wr * 64 + fr; const int col0 = u.pn * HALF + wc * 32 + 8 * fq;
        float ssv[2][4];
#pragma unroll
        for (int ai = 0; ai < 2; ++ai)
#pragma unroll
            for (int m = 0; m < 4; ++m) ssv[ai][m] = ss[row0 + ai * HALF + m * 16];
#pragma unroll
        for (int ai = 0; ai < 2; ++ai)
#pragma unroll
            for (int m = 0; m < 4; ++m) { const int row = row0 + ai * HALF + m * 16; const float rs = rsqrtf(ssv[ai][m] * (1.0f / 2048.0f) + 1e-6f);
                float r[8];
#pragma unroll
                for (int n = 0; n < 2; ++n)
#pragma unroll
                    for (int e = 0; e < 4; ++e) { const float g = acc[ai][0][m][n][e] * rs, up = acc[ai][1][m][n][e] * rs; r[n * 4 + e] = g * sigmoidf_(g) * up; }
                u32x4 w; w.x = cvt_pk_bf16(r[0], r[1]); w.y = cvt_pk_bf16(r[2], r[3]); w.z = cvt_pk_bf16(r[4], r[5]); w.w = cvt_pk_bf16(r[6], r[7]);
                *(u32x4*)(act + (size_t)row * 5632 + col0) = w; }
    }
};
struct EpiBranch {
    static constexpr bool PERM = true;
    bf16_t* merged; const bf16_t* gates; int gcol; int first;
    __device__ __forceinline__ void operator()(const f32x4 (&acc)[2][2][4][2], const Unit& u, int wr, int wc, int fr, int fq) const {
        const int row0 = u.pm * BM + wr * 64 + fr; const int col0 = u.pn * BM + wc * 32 + 8 * fq;
#pragma unroll
        for (int aq = 0; aq < 4; ++aq) { const int ai = aq >> 1, m0 = 2 * (aq & 1);
            u32x4 gw[2][2], pw[2][2];
#pragma unroll
            for (int mm = 0; mm < 2; ++mm)
#pragma unroll
                for (int bj = 0; bj < 2; ++bj) { const int row = row0 + ai * HALF + (m0 + mm) * 16, col = col0 + bj * HALF;
                    gw[mm][bj] = *(const u32x4*)(gates + (size_t)row * 6144 + gcol + col);
                    pw[mm][bj] = first ? (u32x4){0u, 0u, 0u, 0u} : *(const u32x4*)(merged + (size_t)row * 6144 + col); }
#pragma unroll
            for (int mm = 0; mm < 2; ++mm)
#pragma unroll
                for (int bj = 0; bj < 2; ++bj) { const int m = m0 + mm; const int row = row0 + ai * HALF + m * 16, col = col0 + bj * HALF;
                    const u32x4 g_ = gw[mm][bj], p_ = pw[mm][bj]; float r[8];
                    r[0] = bf_lo(g_.x) * acc[ai][bj][m][0][0] + bf_lo(p_.x); r[1] = bf_hi(g_.x) * acc[ai][bj][m][0][1] + bf_hi(p_.x);
                    r[2] = bf_lo(g_.y) * acc[ai][bj][m][0][2] + bf_lo(p_.y); r[3] = bf_hi(g_.y) * acc[ai][bj][m][0][3] + bf_hi(p_.y);
                    r[4] = bf_lo(g_.z) * acc[ai][bj][m][1][0] + bf_lo(p_.z); r[5] = bf_hi(g_.z) * acc[ai][bj][m][1][1] + bf_hi(p_.z);
                    r[6] = bf_lo(g_.w) * acc[ai][bj][m][1][2] + bf_lo(p_.w); r[7] = bf_hi(g_.w) * acc[ai][bj][m][1][3] + bf_hi(p_.w);
                    u32x4 w; w.x = cvt_pk_bf16(r[0], r[1]); w.y = cvt_pk_bf16(r[2], r[3]); w.z = cvt_pk_bf16(r[4], r[5]); w.w = cvt_pk_bf16(r[6], r[7]);
                    *(u32x4*)(merged + (size_t)row * 6144 + col) = w; }
            asm volatile("" ::: "memory");
        }
    }
};
struct EpiResid {
    static constexpr bool PERM = true;
    const float* basef; const bf16_t* baseb; float* out; bf16_t* xb; float* ss;
    __device__ __forceinline__ void operator()(const f32x4 (&acc)[2][2][4][2], const Unit& u, int wr, int wc, int fr, int fq) const {
        const int row0 = u.pm * BM + wr * 64 + fr; const int col0 = u.pn * BM + wc * 32 + 8 * fq;
#pragma unroll
        for (int aq = 0; aq < 4; ++aq) { const int ai = aq >> 1, m0 = 2 * (aq & 1);
            f32x4 bv[2][2][2];
            if (basef) {
#pragma unroll
                for (int mm = 0; mm < 2; ++mm)
#pragma unroll
                    for (int bj = 0; bj < 2; ++bj) { const size_t off = (size_t)(row0 + ai * HALF + (m0 + mm) * 16) * 2048 + col0 + bj * HALF;
                        bv[mm][bj][0] = *(const f32x4*)(basef + off); bv[mm][bj][1] = *(const f32x4*)(basef + off + 4); }
            } else {
                u32x4 bw[2][2];
#pragma unroll
                for (int mm = 0; mm < 2; ++mm)
#pragma unroll
                    for (int bj = 0; bj < 2; ++bj) bw[mm][bj] = *(const u32x4*)(baseb + (size_t)(row0 + ai * HALF + (m0 + mm) * 16) * 2048 + col0 + bj * HALF);
#pragma unroll
                for (int mm = 0; mm < 2; ++mm)
#pragma unroll
                    for (int bj = 0; bj < 2; ++bj) { const u32x4 w_ = bw[mm][bj];
                        bv[mm][bj][0] = (f32x4){bf_lo(w_.x), bf_hi(w_.x), bf_lo(w_.y), bf_hi(w_.y)}; bv[mm][bj][1] = (f32x4){bf_lo(w_.z), bf_hi(w_.z), bf_lo(w_.w), bf_hi(w_.w)}; }
            }
#pragma unroll
            for (int mm = 0; mm < 2; ++mm) { const int m = m0 + mm; const int row = row0 + ai * HALF + m * 16; float sq = 0.f;
#pragma unroll
                for (int bj = 0; bj < 2; ++bj) { const size_t off = (size_t)row * 2048 + col0 + bj * HALF;
                    const f32x4 o0 = bv[mm][bj][0] + acc[ai][bj][m][0], o1 = bv[mm][bj][1] + acc[ai][bj][m][1];
                    if (out) { *(f32x4*)(out + off) = o0; *(f32x4*)(out + off + 4) = o1; }
                    sq += (o0[0] * o0[0] + o0[1] * o0[1]) + (o0[2] * o0[2] + o0[3] * o0[3]) + (o1[0] * o1[0] + o1[1] * o1[1]) + (o1[2] * o1[2] + o1[3] * o1[3]);
                    if (xb) { u32x4 w; w.x = cvt_pk_bf16(o0[0], o0[1]); w.y = cvt_pk_bf16(o0[2], o0[3]); w.z = cvt_pk_bf16(o1[0], o1[1]); w.w = cvt_pk_bf16(o1[2], o1[3]); *(u32x4*)(xb + off) = w; } }
                if (ss) { sq += __shfl_xor(sq, 16); sq += __shfl_xor(sq, 32); if (fq == 0) atomicAdd(ss + row, sq); } }
            asm volatile("" ::: "memory");
        }
    }
};

template <class Epi, class Sched>
__device__ __forceinline__ void gemm_phase(PG8_LAS unsigned char* lds, const Gemm g, const Sched& S, const Epi& E, const int tid) {
    const int wid = __builtin_amdgcn_readfirstlane(tid >> 6), lane = tid & 63, wr = wid >> 2, wc = wid & 3, fr = lane & 15, fq = lane >> 4;
    const int nt = g.K / BK;
    unsigned voffA[2], voffB[2];
#pragma unroll
    for (int i = 0; i < 2; ++i) { int R, C; stage_rc(tid * 16 + i * 8192, R, C); const int Rb = Epi::PERM ? ((R & ~31) + perm32(R & 31)) : R;
        voffA[i] = (unsigned)(R * g.lda + C) * 2u; voffB[i] = (unsigned)(Rb * g.ldb + C) * 2u; }
    const size_t kstep = (size_t)(BK * 2);
    const size_t hstepA = (size_t)HALF * g.lda * 2, hstepB = (size_t)HALF * g.ldb * 2;
    const size_t tstepA = 2 * hstepA, tstepB = 2 * hstepB;
    const unsigned ldsw = (unsigned)wid * 1024u;
    const int aoff = lds_byte(wr * 64 + fr, fq * 8), boff = lds_byte(wc * 32 + fr, fq * 8);
#define PG8_SA(b, h) (((b) * 2 + (h)) * HTB)
#define PG8_SB(b, h) ((4 + (b) * 2 + (h)) * HTB)
#define PG8_STAGE(bufoff, gbase, voff) do { _Pragma("unroll") for (int _i = 0; _i < 2; ++_i) \
        __builtin_amdgcn_global_load_lds((const unsigned*)((const char*)(gbase) + (voff)[_i]), (PG8_LAS unsigned*)(lds + (bufoff) + ldsw + _i * 8192), 16, 0, 0); } while (0)
#define PG8_LDA(dst, b, h) do { _Pragma("unroll") for (int m = 0; m < 4; ++m) _Pragma("unroll") for (int k = 0; k < 2; ++k) dst[m][k] = *(const PG8_LAS bf16x8*)(lds + PG8_SA(b, h) + aoff + m * 2048 + k * 1024); } while (0)
#define PG8_LDB(dst, b, h) do { _Pragma("unroll") for (int n = 0; n < 2; ++n) _Pragma("unroll") for (int k = 0; k < 2; ++k) dst[n][k] = *(const PG8_LAS bf16x8*)(lds + PG8_SB(b, h) + boff + n * 2048 + k * 1024); } while (0)
#define PG8_MMA(ai, bj, At, Bt) do { __builtin_amdgcn_s_setprio(1); _Pragma("unroll") for (int m = 0; m < 4; ++m) _Pragma("unroll") for (int n = 0; n < 2; ++n) _Pragma("unroll") for (int k = 0; k < 2; ++k) \
        acc[ai][bj][m][n] = __builtin_amdgcn_mfma_f32_16x16x32_bf16(Bt[n][k], At[m][k], acc[ai][bj][m][n], 0, 0, 0); __builtin_amdgcn_s_setprio(0); } while (0)
#define PG8_WAIT_V(n) asm volatile("s_waitcnt vmcnt(" #n ")" ::: "memory")
#define PG8_WAIT_L(n) asm volatile("s_waitcnt lgkmcnt(" #n ")" ::: "memory")
#define PG8_BAR __builtin_amdgcn_s_barrier()
#define PG8_SCHED __builtin_amdgcn_sched_barrier(0)
    Unit cur, nxt; int ui = 0;
    if (!S.next(0, cur)) return;
    f32x4 acc[2][2][4][2];
#pragma unroll
    for (int a = 0; a < 2; ++a)
#pragma unroll
        for (int b = 0; b < 2; ++b)
#pragma unroll
            for (int m = 0; m < 4; ++m)
#pragma unroll
                for (int n = 0; n < 2; ++n) acc[a][b][m][n] = (f32x4){0.f, 0.f, 0.f, 0.f};
    bf16x8 At[4][2], B0[2][2], B1[2][2];
    const char* cA = (const char*)g.A + (size_t)cur.pm * tstepA; const char* cB = (const char*)g.Bt + (size_t)cur.pn * tstepB;
    PG8_STAGE(PG8_SB(0, 0), cB, voffB); PG8_STAGE(PG8_SB(0, 1), cB + hstepB, voffB); PG8_STAGE(PG8_SA(0, 0), cA, voffA); PG8_STAGE(PG8_SA(0, 1), cA + hstepA, voffA);
    if (wr == 1) PG8_BAR;
    PG8_WAIT_V(2); PG8_BAR;
    PG8_STAGE(PG8_SB(1, 0), cB + kstep, voffB); PG8_STAGE(PG8_SA(1, 0), cA + kstep, voffA); PG8_STAGE(PG8_SB(1, 1), cB + hstepB + kstep, voffB);
    PG8_WAIT_V(6); PG8_BAR;
    for (;;) {
        const bool has_next = S.next(ui + 1, nxt);
        const char* nA = has_next ? (const char*)g.A + (size_t)nxt.pm * tstepA : cA; const char* nB = has_next ? (const char*)g.Bt + (size_t)nxt.pn * tstepB : cB;
        for (int t = 0; t < nt; t += 2) {
            const bool last = (t == nt - 2);
            const char* a1 = cA + (size_t)(t + 1) * kstep;
            const char* a2 = last ? nA : cA + (size_t)(t + 2) * kstep; const char* b2 = last ? nB : cB + (size_t)(t + 2) * kstep;
            const char* a3 = a2 + kstep; const char* b3 = b2 + kstep;
            PG8_LDB(B0, 0, 0); PG8_LDB(B1, 0, 1); PG8_SCHED; PG8_LDA(At, 0, 0); PG8_STAGE(PG8_SA(1, 1), a1 + hstepA, voffA);
            PG8_WAIT_V(8); PG8_WAIT_L(0); PG8_BAR; PG8_MMA(0, 0, At, B0); PG8_MMA(0, 1, At, B1); PG8_BAR; PG8_SCHED;
            PG8_LDA(At, 0, 1); PG8_STAGE(PG8_SB(0, 0), b2, voffB); PG8_STAGE(PG8_SB(0, 1), b2 + hstepB, voffB); PG8_STAGE(PG8_SA(0, 0), a2, voffA);
            PG8_WAIT_V(8); PG8_WAIT_L(0); PG8_BAR; PG8_MMA(1, 0, At, B0); PG8_MMA(1, 1, At, B1); PG8_BAR; PG8_SCHED;
            PG8_LDB(B0, 1, 0); PG8_LDB(B1, 1, 1); PG8_SCHED; PG8_LDA(At, 1, 0); PG8_STAGE(PG8_SA(0, 1), a2 + hstepA, voffA);
            PG8_WAIT_V(8); PG8_WAIT_L(0); PG8_BAR; PG8_MMA(0, 0, At, B0); PG8_MMA(0, 1, At, B1); PG8_BAR; PG8_SCHED;
            PG8_LDA(At, 1, 1); PG8_STAGE(PG8_SB(1, 0), b3, voffB); PG8_STAGE(PG8_SB(1, 1), b3 + hstepB, voffB); PG8_STAGE(PG8_SA(1, 0), a3, voffA);
            PG8_WAIT_V(8); PG8_WAIT_L(0); PG8_BAR; PG8_MMA(1, 0, At, B0); PG8_MMA(1, 1, At, B1); PG8_BAR; PG8_SCHED;
        }
        if (wr == 0) PG8_BAR;
        E(acc, cur, wr, wc, fr, fq);
        if (!has_next) break;
#pragma unroll
        for (int a = 0; a < 2; ++a)
#pragma unroll
            for (int b = 0; b < 2; ++b)
#pragma unroll
                for (int m = 0; m < 4; ++m)
#pragma unroll
                    for (int n = 0; n < 2; ++n) acc[a][b][m][n] = (f32x4){0.f, 0.f, 0.f, 0.f};
        cur = nxt; cA = nA; cB = nB; ++ui;
        if (wr == 1) PG8_BAR;
    }
    PG8_WAIT_V(0);
    PG8_BAR;
#undef PG8_SA
#undef PG8_SB
#undef PG8_STAGE
#undef PG8_LDA
#undef PG8_LDB
#undef PG8_MMA
#undef PG8_WAIT_V
#undef PG8_WAIT_L
#undef PG8_BAR
#undef PG8_SCHED
}
}

#define GAS __attribute__((address_space(1)))
#define LAS __attribute__((address_space(3)))
typedef unsigned short bf16_t;
typedef short bf16x8 __attribute__((ext_vector_type(8)));
typedef short s16x4 __attribute__((ext_vector_type(4)));
typedef float f32x4 __attribute__((ext_vector_type(4)));
typedef float f32x16 __attribute__((ext_vector_type(16)));
typedef unsigned u32x4 __attribute__((ext_vector_type(4)));
typedef unsigned u32x2 __attribute__((ext_vector_type(2)));

constexpr int DM = 2048, BATCH = 4, SEQ = 4096, M = BATCH * SEQ, DFF = 5632, NIN = 12288, NGU = 11264, QKVP = 6144;
constexpr int NWAVES = 8, NTHR = 512;
constexpr size_t MiB = 1u << 20;
constexpr size_t WS_CTR = 0, WS_SS = 64 * 1024, WS_LUT = 512 * 1024, WS_KM = 1 * MiB;
constexpr size_t WS_WIN = 4 * MiB, WS_WBR = 100 * MiB, WS_WOUT = 116 * MiB, WS_WGU = 132 * MiB, WS_WDN = 220 * MiB;
constexpr size_t WS_XB = 264 * MiB, WS_QKV = 328 * MiB, WS_GATES = 520 * MiB, WS_END = 712 * MiB;
constexpr int LDS_BYTES = 143360;
constexpr int ATT_V_OFF = 0, ATT_LUT_OFF = 65536, ATT_KM_OFF = 81920, DIL_K_OFF = 73728, MISC_OFF = 142336;

struct Args {
    const float* x; const float* g_mix; const float* w_in; const float* q_gain; const float* k_gain; const float* w_branch; const float* w_out;
    const float* g_ffn; const float* w_gu; const float* w_down; const float* rel_bias;
    float* out; unsigned char* ws; int ph_lo, ph_hi;
};

__device__ __forceinline__ unsigned f2bf(float f) { unsigned u = __builtin_bit_cast(unsigned, f); return (u + 0x7fffu + ((u >> 16) & 1u)) >> 16; }
__device__ __forceinline__ unsigned pk2(float lo, float hi) { return pg8::cvt_pk_bf16(lo, hi); }
__device__ __forceinline__ float wave_sum(float v) {
#pragma unroll
    for (int o = 1; o < 64; o <<= 1) v += __shfl_xor(v, o);
    return v;
}

template <bool GU>
__device__ __forceinline__ void transpose_item(const float* W, const float* gk, int K, int N, bf16_t* WT, LAS float* scr, int item, int lane) {
    const int nblk = N / 32, kb = item / nblk, nb = item % nblk, k0 = 64 * kb, n0 = 32 * nb;
    float v[32];
#pragma unroll
    for (int i = 0; i < 32; ++i) v[i] = W[(size_t)(k0 + 2 * i + (lane >> 5)) * N + n0 + (lane & 31)];
#pragma unroll
    for (int i = 0; i < 32; ++i) { const int kk = 2 * i + (lane >> 5); if (gk) v[i] *= gk[k0 + kk]; scr[kk * 33 + (lane & 31)] = v[i]; }
    asm volatile("s_waitcnt lgkmcnt(0)" ::: "memory");
    const int c = lane & 7;
#pragma unroll
    for (int j = 0; j < 4; ++j) { const int n = (lane >> 3) + 8 * j; const LAS float* s = scr + (8 * c) * 33 + n;
        u32x4 o; o.x = pk2(s[0 * 33], s[1 * 33]); o.y = pk2(s[2 * 33], s[3 * 33]); o.z = pk2(s[4 * 33], s[5 * 33]); o.w = pk2(s[6 * 33], s[7 * 33]);
        int col = n0 + n, drow;
        if (GU) { const int half = col >= DFF ? 1 : 0, jj = col - half * DFF; drow = 256 * (jj >> 7) + 128 * half + (jj & 127); } else drow = col;
        *(u32x4*)(WT + (size_t)drow * K + k0 + 8 * c) = o; }
    asm volatile("s_waitcnt lgkmcnt(0)" ::: "memory");
}

__device__ __forceinline__ void phase_prologue(const Args& a, LAS unsigned char* lds, int tid, int lane, int wave) {
    unsigned char* ws = a.ws;
    LAS float* scr = (LAS float*)(lds + wave * 16384);
    int NGW = gridDim.x * NWAVES; asm volatile("" : "+s"(NGW));
    const int gw = blockIdx.x * NWAVES + wave;
    constexpr int I_IN = (DM / 64) * (NIN / 32), I_BR = (DM / 64) * (DM / 32), I_OUT = I_BR, I_GU = (DM / 64) * (NGU / 32), I_DN = (DFF / 64) * (DM / 32);
    constexpr int I_LAYER = I_IN + I_BR + I_OUT + I_GU + I_DN;
    for (int it = gw; it < 2 * I_LAYER; it += NGW) {
        const int l = it / I_LAYER; int r = it % I_LAYER;
        if (r < I_IN) { transpose_item<false>(a.w_in + (size_t)l * DM * NIN, a.g_mix + l * DM, DM, NIN, (bf16_t*)(ws + WS_WIN) + (size_t)l * NIN * DM, scr, r, lane); continue; } r -= I_IN;
        if (r < I_BR) { transpose_item<false>(a.w_branch + (size_t)l * DM * DM, nullptr, DM, DM, (bf16_t*)(ws + WS_WBR) + (size_t)l * DM * DM, scr, r, lane); continue; } r -= I_BR;
        if (r < I_OUT) { transpose_item<false>(a.w_out + (size_t)l * DM * DM, nullptr, DM, DM, (bf16_t*)(ws + WS_WOUT) + (size_t)l * DM * DM, scr, r, lane); continue; } r -= I_OUT;
        if (r < I_GU) { transpose_item<true>(a.w_gu + (size_t)l * DM * NGU, a.g_ffn + l * DM, DM, NGU, (bf16_t*)(ws + WS_WGU) + (size_t)l * NGU * DM, scr, r, lane); continue; } r -= I_GU;
        transpose_item<false>(a.w_down + (size_t)l * DFF * DM, nullptr, DFF, DM, (bf16_t*)(ws + WS_WDN) + (size_t)l * DM * DFF, scr, r, lane);
    }
    float* ss = (float*)(ws + WS_SS);
    for (int m = gw; m < M; m += NGW) {
        const f32x4* xr = (const f32x4*)(a.x + (size_t)m * DM) + lane; u32x2* o8 = (u32x2*)((bf16_t*)(ws + WS_XB) + (size_t)m * DM) + lane;
        float s = 0.f;
#pragma unroll
        for (int j = 0; j < 8; ++j) { const f32x4 v = xr[64 * j]; s += (v.x * v.x + v.y * v.y) + (v.z * v.z + v.w * v.w); u32x2 w; w.x = pk2(v.x, v.y); w.y = pk2(v.z, v.w); o8[64 * j] = w; }
        s = wave_sum(s);
        if (lane == 0) ss[m] = s;
    }
    int NGT = gridDim.x * NTHR; asm volatile("" : "+s"(NGT));
    const int gt = blockIdx.x * NTHR + tid;
    for (int i = gt; i < 3 * M; i += NGT) ss[M + i] = 0.f;
    if (gt < 1024) ((unsigned*)(ws + WS_CTR))[gt] = 0u;
    float* lut = (float*)(ws + WS_LUT);
    for (int i = gt; i < 12 * 4096; i += NGT) { const int hs = i >> 12, d = i & 4095; int bucket;
        if (d < 16) bucket = d; else { const float df = (float)d; int large = 16 + (int)(logf(df / 16.0f) / 4.852030263919617f * 16.0f); bucket = large < 31 ? large : 31; }
        lut[i] = a.rel_bias[bucket * 12 + hs] * 1.4426950408889634f; }
}

__device__ __forceinline__ void phase_qknorm(const Args& a, int l, LAS unsigned char* lds, int tid, int lane, int wave) {
    bf16_t* qkv = (bf16_t*)(a.ws + WS_QKV); float* kmean = (float*)(a.ws + WS_KM);
    LAS float* red = (LAS float*)lds;
    for (int it = blockIdx.x; it < 1536; it += gridDim.x) {
        const int kind = it / 768, rem = it % 768, b = rem / 192, hs = (rem % 192) / 16, blk = rem % 16;
        const float* gain = (kind ? a.k_gain : a.q_gain) + (size_t)l * 12 * 128 + hs * 128 + (lane & 15) * 8;
        float gn[8];
#pragma unroll
        for (int e = 0; e < 8; ++e) gn[e] = gain[e];
        bf16_t* base = qkv + (size_t)(b * SEQ + blk * 256 + wave * 32) * QKVP + kind * 2048 + (4 + hs) * 128 + (lane & 15) * 8;
        float ks[8];
#pragma unroll
        for (int e = 0; e < 8; ++e) ks[e] = 0.f;
        u32x4 wv[8];
#pragma unroll
        for (int ii = 0; ii < 8; ++ii) wv[ii] = *(const u32x4*)(base + (size_t)(4 * ii + (lane >> 4)) * QKVP);
#pragma unroll
        for (int ii = 0; ii < 8; ++ii) { bf16_t* p = base + (size_t)(4 * ii + (lane >> 4)) * QKVP;
            const u32x4 w = wv[ii]; float v[8];
            v[0] = pg8::bf_lo(w.x); v[1] = pg8::bf_hi(w.x); v[2] = pg8::bf_lo(w.y); v[3] = pg8::bf_hi(w.y); v[4] = pg8::bf_lo(w.z); v[5] = pg8::bf_hi(w.z); v[6] = pg8::bf_lo(w.w); v[7] = pg8::bf_hi(w.w);
            float s = 0.f;
#pragma unroll
            for (int e = 0; e < 8; ++e) s += v[e] * v[e];
            s += __shfl_xor(s, 1); s += __shfl_xor(s, 2); s += __shfl_xor(s, 4); s += __shfl_xor(s, 8);
            const float rs = rsqrtf(s * (1.0f / 128.0f) + 1e-6f);
#pragma unroll
            for (int e = 0; e < 8; ++e) { v[e] = v[e] * rs * gn[e]; ks[e] += v[e]; }
            u32x4 o; o.x = pk2(v[0], v[1]); o.y = pk2(v[2], v[3]); o.z = pk2(v[4], v[5]); o.w = pk2(v[6], v[7]);
            *(u32x4*)p = o; }
        const bool km = (kind == 1) && (hs < 6);
        if (km) {
#pragma unroll
            for (int e = 0; e < 8; ++e) { ks[e] += __shfl_xor(ks[e], 16); ks[e] += __shfl_xor(ks[e], 32); }
            if (lane < 16) {
#pragma unroll
                for (int e = 0; e < 8; ++e) red[wave * 128 + lane * 8 + e] = ks[e]; }
        }
        __syncthreads();
        if (km && tid < 128) { float s = 0.f;
#pragma unroll
            for (int w = 0; w < 8; ++w) s += red[w * 128 + tid];
            kmean[((size_t)(b * 6 + hs) * 16 + blk) * 128 + tid] = s * (1.0f / 256.0f); }
        __syncthreads();
    }
}

namespace att {
constexpr float SCALE = 0.08838834764831845f, LOG2E = 1.4426950408889634f, NEG = -1e30f, C1 = SCALE * LOG2E;
__device__ __forceinline__ unsigned offa(unsigned row, unsigned ch) { return 2048u * (row >> 3) + 512u * (ch >> 2) + 64u * (row & 7u) + 16u * ((ch & 3u) ^ ((row >> 2) & 3u)); }
__device__ __forceinline__ int clamp_s(int s) { return s < 0 ? 0 : (s > SEQ - 1 ? SEQ - 1 : s); }
__device__ __forceinline__ void load_k(bf16x8 (&kf)[8], const bf16_t* Kb, int s0, int stride, int lane) {
    const int s = clamp_s(s0 + stride * (lane & 31));
    const GAS bf16x8* p = (const GAS bf16x8*)(Kb + (size_t)s * QKVP + 8 * (lane >> 5));
#pragma unroll
    for (int j = 0; j < 8; ++j) kf[j] = p[2 * j];
}
__device__ __forceinline__ void load_v(u32x4 (&vr)[8], const bf16_t* Vb, int s0, int stride, int lane) {
#pragma unroll
    for (int ii = 0; ii < 8; ++ii) { const int s = clamp_s(s0 + stride * ((lane >> 4) + 4 * ii)); vr[ii] = *(const GAS u32x4*)(Vb + (size_t)s * QKVP + (lane & 15) * 8); }
}
__device__ __forceinline__ void stage_v(LAS unsigned char* vl, const u32x4 (&vr)[8], int lane) {
    const unsigned ch = lane & 15, wl = 512u * (ch >> 2) + 64u * (unsigned)(lane >> 4);
#pragma unroll
    for (int ii = 0; ii < 8; ++ii) *(LAS u32x4*)(vl + wl + 16u * ((ch & 3u) ^ (unsigned)(ii & 3)) + 2048 * (ii >> 1) + 256 * (ii & 1)) = vr[ii];
}
__device__ __forceinline__ f32x16 qk(const bf16x8 (&kf)[8], const bf16x8 (&qf)[8]) {
    f32x16 acc = {0.f, 0.f, 0.f, 0.f, 0.f, 0.f, 0.f, 0.f, 0.f, 0.f, 0.f, 0.f, 0.f, 0.f, 0.f, 0.f};
#pragma unroll
    for (int j = 0; j < 8; ++j) acc = __builtin_amdgcn_mfma_f32_32x32x16_bf16(kf[j], qf[j], acc, 0, 0, 0);
    return acc;
}
typedef short v4i16_t __attribute__((ext_vector_type(4)));
__device__ __forceinline__ s16x4 vtr(LAS unsigned char* p) { return __builtin_bit_cast(s16x4, __builtin_amdgcn_ds_read_tr16_b64_v4i16((LAS v4i16_t*)p)); }
__device__ __forceinline__ void pv(f32x16 (&o)[4], LAS unsigned char* vl, bf16x8 P0, bf16x8 P1, int lane) {
    const unsigned h = lane >> 5, blk = (lane >> 4) & 1, q = (lane & 15) >> 2, p = lane & 3;
    const unsigned lb = 64u * (4u * h + q) + 16u * ((p >> 1) ^ h) + 8u * (p & 1u);
    LAS unsigned char* b0 = vl + lb + 32u * blk; LAS unsigned char* b1 = vl + lb + 32u * (blk ^ 1u) + 2048u;
#pragma unroll
    for (int hf = 0; hf < 2; ++hf) {
        s16x4 lo[2][2], hi[2][2];
#pragma unroll
        for (int cc = 0; cc < 2; ++cc)
#pragma unroll
            for (int s = 0; s < 2; ++s) { lo[cc][s] = vtr(b0 + 4096 * s + 512 * (2 * hf + cc)); hi[cc][s] = vtr(b1 + 4096 * s + 512 * (2 * hf + cc)); }
        asm volatile("s_waitcnt lgkmcnt(0)" ::: "memory");
        __builtin_amdgcn_sched_barrier(0);
#pragma unroll
        for (int cc = 0; cc < 2; ++cc)
#pragma unroll
            for (int s = 0; s < 2; ++s) {
                const bf16x8 A = {lo[cc][s][0], lo[cc][s][1], lo[cc][s][2], lo[cc][s][3], hi[cc][s][0], hi[cc][s][1], hi[cc][s][2], hi[cc][s][3]};
                o[2 * hf + cc] = __builtin_amdgcn_mfma_f32_32x32x16_bf16(A, s ? P1 : P0, o[2 * hf + cc], 0, 0, 0);
            }
        __builtin_amdgcn_sched_barrier(0);
    }
}
typedef float f32x2_t __attribute__((ext_vector_type(2))); typedef __bf16 bf16x2_t __attribute__((ext_vector_type(2)));
__device__ __forceinline__ unsigned cvtpk(float lo, float hi) { f32x2_t v = {lo, hi}; bf16x2_t b = __builtin_convertvector(v, bf16x2_t); return __builtin_bit_cast(unsigned, b); }
__device__ __forceinline__ void pack_p(const float (&p)[16], bf16x8& P0, bf16x8& P1) {
    u32x4 a, b; a.x = cvtpk(p[0], p[1]); a.y = cvtpk(p[2], p[3]); a.z = cvtpk(p[4], p[5]); a.w = cvtpk(p[6], p[7]);
    b.x = cvtpk(p[8], p[9]); b.y = cvtpk(p[10], p[11]); b.z = cvtpk(p[12], p[13]); b.w = cvtpk(p[14], p[15]);
    P0 = __builtin_bit_cast(bf16x8, a); P1 = __builtin_bit_cast(bf16x8, b);
}
__device__ __forceinline__ void softmax_step(float (&x)[16], float& m, float& l, f32x16 (&o)[4], bf16x8& P0, bf16x8& P1) {
    float mx = fmaxf(x[0], x[1]);
#pragma unroll
    for (int r = 2; r < 16; ++r) mx = fmaxf(mx, x[r]);
    mx = fmaxf(mx, __shfl_xor(mx, 32));
    const float mn = fmaxf(m, mx);
    const float alpha = __builtin_amdgcn_exp2f(m - mn);
    float ls = 0.f;
#pragma unroll
    for (int r = 0; r < 16; ++r) { const float p = __builtin_amdgcn_exp2f(x[r] - mn); ls += p; x[r] = p; }
    l = l * alpha + ls; m = mn;
    if (__any(alpha != 1.0f)) {
#pragma unroll
        for (int c = 0; c < 4; ++c) o[c] = o[c] * alpha;
    }
    pack_p(x, P0, P1);
}
__device__ __forceinline__ void softmax_fixed(float (&x)[16], float& l, bf16x8& P0, bf16x8& P1) {
    float ls = 0.f;
#pragma unroll
    for (int r = 0; r < 16; ++r) { const float p = __builtin_amdgcn_exp2f(x[r]); ls += p; x[r] = p; }
    l += ls;
    pack_p(x, P0, P1);
}
__device__ __forceinline__ float softmax_ref(const Args& a, int l, int hs, const bf16x8 (&qf)[8], int lane) {
    const float* kg = a.k_gain + (size_t)l * 12 * 128 + hs * 128;
    float gm = fmaxf(fabsf(kg[lane]), fabsf(kg[lane + 64]));
    float bm = a.rel_bias[(lane & 31) * 12 + hs];
#pragma unroll
    for (int o_ = 1; o_ < 64; o_ <<= 1) { gm = fmaxf(gm, __shfl_xor(gm, o_)); bm = fmaxf(bm, __shfl_xor(bm, o_)); }
    float qs = 0.f;
#pragma unroll
    for (int j = 0; j < 8; ++j) { const u32x4 qw = __builtin_bit_cast(u32x4, qf[j]);
        const float q0 = pg8::bf_lo(qw.x), q1 = pg8::bf_hi(qw.x), q2 = pg8::bf_lo(qw.y), q3 = pg8::bf_hi(qw.y), q4 = pg8::bf_lo(qw.z), q5 = pg8::bf_hi(qw.z), q6 = pg8::bf_lo(qw.w), q7 = pg8::bf_hi(qw.w);
        qs += (q0 * q0 + q1 * q1) + (q2 * q2 + q3 * q3) + (q4 * q4 + q5 * q5) + (q6 * q6 + q7 * q7); }
    qs += __shfl_xor(qs, 32);
    return C1 * sqrtf(qs) * (11.3137085f * 1.004f * gm) + bm * LOG2E + 1e-3f;
}
__device__ __forceinline__ void store_o(const f32x16 (&o)[4], float inv, bf16_t* orow, int lane) {
    const int h = lane >> 5;
#pragma unroll
    for (int c = 0; c < 4; ++c)
#pragma unroll
        for (int i = 0; i < 4; ++i) { u32x2 w; w.x = cvtpk(o[c][4 * i] * inv, o[c][4 * i + 1] * inv); w.y = cvtpk(o[c][4 * i + 2] * inv, o[c][4 * i + 3] * inv);
            *(GAS u32x2*)(orow + 32 * c + 8 * i + 4 * h) = w; }
}
__device__ __forceinline__ void load_q(bf16x8 (&qf)[8], const bf16_t* qrow, int lane) {
    const GAS bf16x8* p = (const GAS bf16x8*)(qrow + 8 * (lane >> 5));
#pragma unroll
    for (int j = 0; j < 8; ++j) qf[j] = p[2 * j];
}

__device__ __forceinline__ void unit_moba(const Args& a, int lyr, bf16_t* Ob, int OP, int b, int hm, int qb, LAS unsigned char* lds, int tid, int lane, int wave) {
    asm volatile("" : "+v"(lane));
    const bf16_t* qkv = (const bf16_t*)(a.ws + WS_QKV);
    LAS float* lutL = (LAS float*)(lds + ATT_LUT_OFF); LAS float* kmL = (LAS float*)(lds + ATT_KM_OFF);
    { const float* lutG = (const float*)(a.ws + WS_LUT) + hm * 4096;
#pragma unroll
      for (int k_ = 0; k_ < 8; ++k_) lutL[tid + k_ * NTHR] = lutG[tid + k_ * NTHR];
      const float* kmG = (const float*)(a.ws + WS_KM) + (size_t)(b * 6 + hm) * 16 * 128;
#pragma unroll
      for (int k_ = 0; k_ < 4; ++k_) kmL[tid + k_ * NTHR] = kmG[tid + k_ * NTHR]; }
    __syncthreads();
    const int h = lane >> 5, t0 = qb * 256, tw = t0 + 32 * wave, t = tw + (lane & 31), hg = 4 + hm;
    const bf16_t* Kb = qkv + (size_t)b * SEQ * QKVP + 2048 + hg * 128; const bf16_t* Vb = Kb + 2048;
    bf16x8 qf[8]; load_q(qf, qkv + (size_t)(b * SEQ + t) * QKVP + hg * 128, lane);
    unsigned selmask = 0u, anymask = 0u;
    if (qb > 0) {
        float v1 = -3e38f, v2 = -3e38f, v3 = -3e38f; int i1 = -1, i2 = -1, i3 = -1;
        for (int n = 0; n < qb; ++n) {
            float g = 0.f;
#pragma unroll
            for (int j = 0; j < 8; ++j) { const LAS f32x4* kp = (const LAS f32x4*)(kmL + n * 128 + 16 * j + 8 * h); const f32x4 k0 = kp[0], k1 = kp[1];
                const u32x4 qw = __builtin_bit_cast(u32x4, qf[j]);
                g += pg8::bf_lo(qw.x) * k0[0] + pg8::bf_hi(qw.x) * k0[1] + pg8::bf_lo(qw.y) * k0[2] + pg8::bf_hi(qw.y) * k0[3]
                   + pg8::bf_lo(qw.z) * k1[0] + pg8::bf_hi(qw.z) * k1[1] + pg8::bf_lo(qw.w) * k1[2] + pg8::bf_hi(qw.w) * k1[3]; }
            g += __shfl_xor(g, 32);
            if (g > v1) { v3 = v2; i3 = i2; v2 = v1; i2 = i1; v1 = g; i1 = n; } else if (g > v2) { v3 = v2; i3 = i2; v2 = g; i2 = n; } else if (g > v3) { v3 = g; i3 = n; }
        }
        if (i1 >= 0) selmask |= 1u << i1; if (i2 >= 0) selmask |= 1u << i2; if (i3 >= 0) selmask |= 1u << i3;
        for (int n = 0; n < qb; ++n) if (__ballot((selmask >> n) & 1u) != 0ull) anymask |= 1u << n;
    }
    volatile LAS unsigned* misc = (volatile LAS unsigned*)(lds + MISC_OFF);
    if (tid == 0) misc[4] = 0u;
    __syncthreads();
    if (lane == 0 && anymask != 0u) __hip_atomic_fetch_or((LAS unsigned*)(lds + MISC_OFF + 16), anymask, __ATOMIC_RELAXED, __HIP_MEMORY_SCOPE_WORKGROUP);
    __syncthreads();
    const unsigned anywg = misc[4];
    const float nref = -softmax_ref(a, lyr, hm, qf, lane);
    float l = 0.f; f32x16 o[4];
#pragma unroll
    for (int c = 0; c < 4; ++c) o[c] = (f32x16){0.f, 0.f, 0.f, 0.f, 0.f, 0.f, 0.f, 0.f, 0.f, 0.f, 0.f, 0.f, 0.f, 0.f, 0.f, 0.f};
    const int srow = 8 * (wave >> 1) + ((lane >> 2) & 7), sch = 4 * (2 * (wave & 1) + (lane >> 5)) + ((lane & 3) ^ ((srow >> 2) & 3));
    const bf16_t* kg = Kb + (size_t)srow * QKVP + sch * 8; const bf16_t* vg = Vb + (size_t)srow * QKVP + sch * 8;
    const int r31 = lane & 31; const unsigned x0 = (r31 >> 2) & 1, x1 = (r31 >> 3) & 1;
    const unsigned kb_l = 2048u * (r31 >> 3) + 64u * (r31 & 7) + 16u * ((unsigned)h ^ x0);
    const unsigned ke0 = kb_l + 32u * x1, ke1 = kb_l + 32u * (x1 ^ 1u);
#define MOBA_STAGE(buf, nblk, stp) do { const size_t ro_ = (size_t)(256 * (nblk) + 64 * (stp)) * QKVP; LAS unsigned char* d_ = lds + ATT_V_OFF + (buf) * 32768 + wave * 1024; \
        __builtin_amdgcn_global_load_lds((const unsigned*)(kg + ro_), (LAS unsigned*)(d_), 16, 0, 0); \
        __builtin_amdgcn_global_load_lds((const unsigned*)(kg + ro_ + 32 * QKVP), (LAS unsigned*)(d_ + 8192), 16, 0, 0); \
        __builtin_amdgcn_global_load_lds((const unsigned*)(vg + ro_), (LAS unsigned*)(d_ + 16384), 16, 0, 0); \
        __builtin_amdgcn_global_load_lds((const unsigned*)(vg + ro_ + 32 * QKVP), (LAS unsigned*)(d_ + 24576), 16, 0, 0); } while (0)
    int n = qb, st = 3;
    MOBA_STAGE(0, n, st);
    asm volatile("s_waitcnt vmcnt(0)" ::: "memory");
    __syncthreads();
    int cur = 0;
    for (;;) {
        int nn = n, nst = st; bool has_next = true;
        if (n == qb) { if (st > 0) nst = st - 1; else { if (anywg == 0u) has_next = false; else { nn = __builtin_ctz(anywg); nst = 0; } } }
        else { if (st < 3) nst = st + 1; else { const unsigned rest = anywg & ~((2u << n) - 1u); if (rest == 0u) has_next = false; else { nn = __builtin_ctz(rest); nst = 0; } } }
        if (has_next) MOBA_STAGE(cur ^ 1, nn, nst);
        const bool own = (n == qb);
        const bool active = own ? (2 * st <= wave) : (((anymask >> (n & 31)) & 1u) != 0u);
        if (active) {
            LAS unsigned char* kl = lds + ATT_V_OFF + cur * 32768;
            const int dbase = t - (256 * n + 64 * st);
            const float lanebias = own ? nref : (((selmask >> (n & 31)) & 1u) ? nref : NEG);
            bf16x8 PA0, PA1, PB0, PB1;
#pragma unroll
            for (int tt = 0; tt < 2; ++tt) {
                bf16x8 kc[8];
#pragma unroll
                for (int s = 0; s < 8; ++s) kc[s] = *(const LAS bf16x8*)(kl + 8192 * tt + ((s & 1) ? ke1 : ke0) + 512 * (s >> 1));
                asm volatile("s_waitcnt lgkmcnt(0)" ::: "memory"); __builtin_amdgcn_sched_barrier(0);
                const f32x16 sacc = qk(kc, qf);
                const int db = dbase - 32 * tt;
                float x[16];
                if (own) {
#pragma unroll
                    for (int r = 0; r < 16; ++r) { const int dist = db - (8 * (r >> 2) + 4 * h + (r & 3)); const float lvv = lutL[dist < 0 ? 0 : dist];
                        const float xx = __builtin_fmaf(sacc[r], C1, lvv) + nref; x[r] = (dist >= 0) ? xx : NEG; }
                } else {
                    const LAS float* lp = lutL + (db - 4 * h);
#pragma unroll
                    for (int r = 0; r < 16; ++r) x[r] = __builtin_fmaf(sacc[r], C1, lp[-(8 * (r >> 2) + (r & 3))]) + lanebias;
                }
                if (tt == 0) softmax_fixed(x, l, PA0, PA1); else softmax_fixed(x, l, PB0, PB1);
            }
            pv(o, kl + 16384, PA0, PA1, lane);
            pv(o, kl + 24576, PB0, PB1, lane);
        }
        if (!has_next) break;
        asm volatile("s_waitcnt vmcnt(0)" ::: "memory");
        __syncthreads();
        n = nn; st = nst; cur ^= 1;
    }
#undef MOBA_STAGE
    l += __shfl_xor(l, 32);
    store_o(o, 1.0f / l, Ob + (size_t)(b * SEQ + t) * OP + hg * 128, lane);
}

__device__ __forceinline__ void dil_desc(int idx, int tb, int c4, int i, int& s0, int& stride, int& delta0, int& pat, int& aa) {
    if (idx < 5) { const int kt = 4 - idx; stride = 4; s0 = tb + c4 + 4 * (-128 + 32 * kt); delta0 = i + 128 - 32 * kt; pat = 0; aa = 0; }
    else if (idx < 13) { const int kt = idx - 5; stride = 1; s0 = tb - 128 + 32 * kt; delta0 = c4 + 4 * i + 128 - 32 * kt; pat = 1; aa = 0; }
    else { aa = (idx - 13) / 5; const int kt = (idx - 13) % 5; stride = 16; s0 = tb + c4 + 4 * aa + 16 * (-128 + 32 * kt); delta0 = (i >> 2) + 128 - 32 * kt; pat = 2; }
}
__device__ __forceinline__ void unit_dilated(const Args& a, int lyr, bf16_t* Ob, int OP, int b, int hd, int qb, LAS unsigned char* lds, int tid, int lane, int wave) {
    asm volatile("" : "+v"(lane));
    const bf16_t* qkv = (const bf16_t*)(a.ws + WS_QKV);
    LAS float* lut3 = (LAS float*)(lds + ATT_LUT_OFF);
    { const float* lutG = (const float*)(a.ws + WS_LUT) + (6 + hd) * 4096;

#pragma unroll
      for (int k_ = 0; k_ < 3; ++k_) { const int e = tid + k_ * NTHR; if (e >= 3 * 384) break; const int p = e / 384, d = e % 384 - 128; const int st = p == 0 ? 4 : (p == 1 ? 1 : 16); lut3[e] = (d >= 0 && d <= 128) ? lutG[st * d] : 0.f; } }
    __syncthreads();
    LAS unsigned char* vl = lds + ATT_V_OFF + wave * 8192;
    const int h = lane >> 5, i = lane & 31, t0 = qb * 256, tb = t0 + 128 * (wave >> 2), c4 = wave & 3, t = tb + c4 + 4 * i, hg = 10 + hd;
    const bf16_t* Kb = qkv + (size_t)b * SEQ * QKVP + 2048 + hg * 128; const bf16_t* Vb = Kb + 2048;
    bf16x8 qf[8]; load_q(qf, qkv + (size_t)(b * SEQ + t) * QKVP + hg * 128, lane);
    const float nref = -softmax_ref(a, lyr, 6 + hd, qf, lane);
    const unsigned dmax4 = (unsigned)((t >> 2) < 128 ? (t >> 2) : 128), dmax1 = (unsigned)(t < 128 ? t : 128), dmax16 = (unsigned)((t >> 4) < 128 ? (t >> 4) : 128);
    float l = 0.f; f32x16 o[4];
#pragma unroll
    for (int c = 0; c < 4; ++c) o[c] = (f32x16){0.f, 0.f, 0.f, 0.f, 0.f, 0.f, 0.f, 0.f, 0.f, 0.f, 0.f, 0.f, 0.f, 0.f, 0.f, 0.f};
    LAS unsigned char* kl = lds + DIL_K_OFF + wave * 8192;
    const int kc_ = (lane >> 2) & 7, kd_ = lane & 3;
#define DIL_KDMA(s0v, strv) do { _Pragma("unroll") for (int i_ = 0; i_ < 8; ++i_) { const int row_ = 8 * (i_ >> 1) + kc_; const int ch_ = 4 * (2 * (i_ & 1) + (lane >> 5)) + (kd_ ^ ((row_ >> 2) & 3)); \
        const int s_ = clamp_s((s0v) + (strv) * row_); \
        __builtin_amdgcn_global_load_lds((const unsigned*)(Kb + (size_t)s_ * QKVP + ch_ * 8), (LAS unsigned*)(kl + 1024 * i_), 16, 0, 0); } } while (0)
    const int r31 = lane & 31; const unsigned kx0 = (r31 >> 2) & 1, kx1 = (r31 >> 3) & 1;
    const unsigned kb_l = 2048u * (r31 >> 3) + 64u * (r31 & 7) + 16u * ((unsigned)h ^ kx0);
    const unsigned ke0 = kb_l + 32u * kx1, ke1 = kb_l + 32u * (kx1 ^ 1u);
    u32x4 vr[8];
    int s0, stride, delta0, pat, aa;
    dil_desc(0, tb, c4, i, s0, stride, delta0, pat, aa);
    DIL_KDMA(s0, stride); load_v(vr, Vb, s0, stride, lane);
    for (int idx = 0; idx < 33;) {
        asm volatile("s_waitcnt vmcnt(0)" ::: "memory");
        bf16x8 kc[8];
#pragma unroll
        for (int s = 0; s < 8; ++s) kc[s] = *(const LAS bf16x8*)(kl + ((s & 1) ? ke1 : ke0) + 512 * (s >> 1));
        asm volatile("s_waitcnt lgkmcnt(0)" ::: "memory"); __builtin_amdgcn_sched_barrier(0);
        int s0n = 0, stn = 1, d0n = 0, patn = 0, aan = 0, nidx = idx + 1;
#pragma unroll 1
        for (; nidx < 33; ++nidx) {
            int last;
            if (nidx < 5) last = tb + c4 + 4 * (-128 + 32 * (4 - nidx) + 31);
            else if (nidx < 13) last = tb - 128 + 32 * (nidx - 5) + 31;
            else last = tb + c4 + 4 * ((nidx - 13) / 5) + 16 * (-128 + 32 * ((nidx - 13) % 5) + 31);
            if (last >= 0) break; }
        const bool more = nidx < 33;
        if (more) { dil_desc(nidx, tb, c4, i, s0n, stn, d0n, patn, aan); DIL_KDMA(s0n, stn); }
        const f32x16 sacc = qk(kc, qf);
        stage_v(vl, vr, lane);
        if (more) load_v(vr, Vb, s0n, stn, lane);
        const unsigned dmax = pat == 0 ? dmax4 : (pat == 1 ? dmax1 : dmax16);
        const float lb = (pat == 2 && (i & 3) != aa) ? NEG : nref;
        const int dk = delta0 - 4 * h;
        const LAS float* lp = lut3 + pat * 384 + 128 + dk;
        float x[16];
#pragma unroll
        for (int r = 0; r < 16; ++r) { const float lvv = lp[-(8 * (r >> 2) + (r & 3))]; const float xx = __builtin_fmaf(sacc[r], C1, lvv) + lb;
            const unsigned delta = (unsigned)(dk - (8 * (r >> 2) + (r & 3))); x[r] = (delta <= dmax) ? xx : NEG; }
        bf16x8 P0, P1; softmax_fixed(x, l, P0, P1);
        pv(o, vl, P0, P1, lane);
        s0 = s0n; stride = stn; delta0 = d0n; pat = patn; aa = aan; idx = nidx;
    }
#undef DIL_KDMA
    l += __shfl_xor(l, 32);
    store_o(o, 1.0f / l, Ob + (size_t)(b * SEQ + t) * OP + hg * 128, lane);
}

__device__ __forceinline__ void unit_sb(const Args& a, bf16_t* Ob, int OP, int b, int ha, int qb, LAS unsigned char* lds, int tid, int lane, int wave) {
    asm volatile("" : "+v"(lane));
    const bf16_t* qkv = (const bf16_t*)(a.ws + WS_QKV);
    LAS unsigned char* vl = lds + ATT_V_OFF + wave * 8192;
    const int h = lane >> 5, t0 = qb * 256, tw = t0 + 32 * wave, t = tw + (lane & 31);
    const bf16_t* Kb = qkv + (size_t)b * SEQ * QKVP + 2048 + ha * 128; const bf16_t* Vb = Kb + 2048;
    bf16x8 qf[8]; load_q(qf, qkv + (size_t)(b * SEQ + t) * QKVP + ha * 128, lane);
    f32x16 o[4];
#pragma unroll
    for (int c = 0; c < 4; ++c) o[c] = (f32x16){0.f, 0.f, 0.f, 0.f, 0.f, 0.f, 0.f, 0.f, 0.f, 0.f, 0.f, 0.f, 0.f, 0.f, 0.f, 0.f};
    float R = 0.f;
    bf16x8 kc[8];
    int kt = tw >> 5;
    load_k(kc, Kb, 32 * kt, 1, lane);
    for (;;) {
        u32x4 vr[8]; load_v(vr, Vb, 32 * kt, 1, lane);
        const f32x16 sacc = qk(kc, qf);
        const bool more = kt > 0;
        if (more) load_k(kc, Kb, 32 * (kt - 1), 1, lane);
        stage_v(vl, vr, lane);
        const int dbase = t - 32 * kt;
        float lb[16], g[4], gp[4];
#pragma unroll
        for (int i = 0; i < 4; ++i) { g[i] = 0.f;
#pragma unroll
            for (int j = 0; j < 4; ++j) { const int r = 4 * i + j; const int kap = 8 * i + 4 * h + j; const bool past = kap < dbase;
                const float z = sacc[r] * SCALE; const float sp = __logf(1.0f + __expf(-fabsf(z)));
                lb[r] = fminf(z, 0.f) - sp; g[i] += past ? (lb[r] - z) : 0.f; }
            gp[i] = __shfl_xor(g[i], 32); }
        float sg[4]; sg[3] = 0.f; sg[2] = g[3] + gp[3]; sg[1] = sg[2] + g[2] + gp[2]; sg[0] = sg[1] + g[1] + gp[1];
        const float tot = sg[0] + g[0] + gp[0];
#pragma unroll
        for (int i = 0; i < 4; ++i) { const float basei = sg[i] + R + (h == 0 ? gp[i] : 0.f);
            float suf = 0.f;
#pragma unroll
            for (int j = 3; j >= 0; --j) { const int r = 4 * i + j; const int kap = 8 * i + 4 * h + j; const bool past = kap < dbase;
                const float l1 = past ? (lb[r] - sacc[r] * SCALE) : 0.f;
                lb[r] = past ? __expf(lb[r] + suf + basei) : 0.f; suf += l1; } }
        R += tot;
        bf16x8 P0, P1; pack_p(lb, P0, P1);
        pv(o, vl, P0, P1, lane);
        if (!more || __all(R < -110.0f)) break;
        --kt;
    }
    store_o(o, 1.0f, Ob + (size_t)(b * SEQ + t) * OP + ha * 128, lane);
}

__device__ __forceinline__ void phase_attention(const Args& a, int l, int rep, LAS unsigned char* lds, int tid, int lane, int wave) {
    unsigned* ctr0 = (unsigned*)(a.ws + WS_CTR) + (l + 2 * rep) * 64;
    bf16_t* Ob = l == 0 ? (bf16_t*)a.out : (bf16_t*)(a.ws + WS_QKV); const int OP = l == 0 ? DM : QKVP;
    volatile LAS unsigned* misc = (volatile LAS unsigned*)(lds + MISC_OFF);
    int xq = (int)((unsigned)__builtin_amdgcn_s_getreg((3 << 11) | 20) & 7u), left = 8;
    for (;;) {
        __syncthreads();
        if (tid == 0) misc[0] = atomicAdd(ctr0 + xq * 8, 1u);
        __syncthreads();
        const int j = (int)misc[0];
        if (j >= 128) { if (--left == 0) break; xq = (xq + 1) & 7; continue; }
        if (j < 48) { const int qb = 15 - j / 3, bh = 3 * xq + j % 3; unit_moba(a, l, Ob, OP, bh / 6, bh % 6, qb, lds, tid, lane, wave); }
        else if (j < 96) { const int jj = j - 48, qb = jj % 16, bh = 3 * xq + jj / 16; unit_dilated(a, l, Ob, OP, bh / 6, bh % 6, qb, lds, tid, lane, wave); }
        else { const int jj = j - 96, qb = 15 - jj / 2, bh = 2 * xq + jj % 2; unit_sb(a, Ob, OP, bh / 4, bh % 4, qb, lds, tid, lane, wave); }
    }
}
}

__device__ __forceinline__ void grid_barrier(unsigned* bar, unsigned k) {
    asm volatile("s_waitcnt vmcnt(0) lgkmcnt(0)" ::: "memory");
    __syncthreads();
    if (threadIdx.x == 0) {
        const unsigned G = gridDim.x, g = blockIdx.x & 7u, nloc = (G - g + 7u) >> 3, ngrp = G < 8u ? G : 8u;
        __builtin_amdgcn_fence(__ATOMIC_RELEASE, "agent");
        asm volatile("s_waitcnt vmcnt(0)" ::: "memory");
        const unsigned old = __hip_atomic_fetch_add(bar + 64 * g, 1u, __ATOMIC_RELAXED, __HIP_MEMORY_SCOPE_AGENT);
        if (old + 1u == nloc * k) __hip_atomic_fetch_add(bar + 512, 1u, __ATOMIC_RELAXED, __HIP_MEMORY_SCOPE_AGENT);
        unsigned spins = 0;
        while (__hip_atomic_load(bar + 512, __ATOMIC_RELAXED, __HIP_MEMORY_SCOPE_AGENT) < ngrp * k) { __builtin_amdgcn_s_sleep(2); if (++spins > (1u << 24)) break; }
        __builtin_amdgcn_fence(__ATOMIC_ACQUIRE, "agent");
        asm volatile("s_waitcnt vmcnt(0)" ::: "memory");
    }
    __syncthreads();
}

__global__ void __launch_bounds__(NTHR, 2) hybrid_fwd(Args a_) {
    __shared__ __attribute__((aligned(16))) unsigned char lds_raw[LDS_BYTES];
    LAS unsigned char* lds = (LAS unsigned char*)lds_raw;
    const int ph_lo = a_.ph_lo, ph_hi = a_.ph_hi;
    int n_grid = 0;
    for (int ph = ph_lo; ph < ph_hi; ++ph) {
        {
        constexpr int rep = 0;
        int tid = threadIdx.x; asm volatile("" : "+v"(tid));
        const int lane = tid & 63, wave = __builtin_amdgcn_readfirstlane(tid >> 6);
        const __attribute__((address_space(4))) Args* ap = (const __attribute__((address_space(4))) Args*)__builtin_amdgcn_kernarg_segment_ptr(); asm volatile("" : "+s"(ap));
        Args a; a.x = ap->x; a.g_mix = ap->g_mix; a.w_in = ap->w_in; a.q_gain = ap->q_gain; a.k_gain = ap->k_gain; a.w_branch = ap->w_branch; a.w_out = ap->w_out;
        a.g_ffn = ap->g_ffn; a.w_gu = ap->w_gu; a.w_down = ap->w_down; a.rel_bias = ap->rel_bias; a.out = ap->out; a.ws = ap->ws; a.ph_lo = 0; a.ph_hi = 0;
        unsigned char* ws = a.ws;
        const int G = gridDim.x, cidx = blockIdx.x;
        float* ss = (float*)(ws + WS_SS);
        bf16_t* xb = (bf16_t*)(ws + WS_XB); bf16_t* qkv = (bf16_t*)(ws + WS_QKV); bf16_t* gates = (bf16_t*)(ws + WS_GATES);
        bf16_t* ob = qkv; bf16_t* merged = qkv + 2048; bf16_t* act = qkv;
        if (ph == 0) phase_prologue(a, lds, tid, lane, wave);
        else {
            const int l = (ph - 1) / 7, k = (ph - 1) % 7;
            if (k == 0) {
                pg8::Gemm g{xb, (const bf16_t*)(ws + WS_WIN) + (size_t)l * NIN * DM, DM, DM, M, NIN, DM}; pg8::StaticOrder S; S.init(M, NIN, G, cidx);
                pg8::EpiIn E{qkv, gates, ss + (size_t)(2 * l) * M, a.q_gain + (size_t)l * 12 * 128, a.k_gain + (size_t)l * 12 * 128, (float*)(ws + WS_KM), lds + 132096};
                pg8::gemm_phase<pg8::EpiIn, pg8::StaticOrder>(lds, g, S, E, tid);
            } else if (k == 1) {   }
            else if (k == 2) att::phase_attention(a, l, rep, lds, tid, lane, wave);
            else if (k == 3) {
                const bf16_t* wbt = (const bf16_t*)(ws + WS_WBR) + (size_t)l * DM * DM;
                for (int br = 0; br < 3; ++br) {
                    const int k0 = br == 0 ? 0 : (br == 1 ? 512 : 1280), kl = br == 0 ? 512 : 768;
                    pg8::Gemm g{(l == 0 ? (const bf16_t*)a.out : ob) + k0, wbt + k0, l == 0 ? DM : QKVP, DM, M, DM, kl}; pg8::StaticOrder S; S.init(M, DM, G, cidx);
                    pg8::EpiBranch E{merged, gates, br * 2048, br == 0 ? 1 : 0};
                    pg8::gemm_phase<pg8::EpiBranch, pg8::StaticOrder>(lds, g, S, E, tid);
                }
            } else if (k == 4 || k == 6) {
                const bool dn = (k == 6);
                pg8::Gemm g{dn ? act : merged, dn ? (const bf16_t*)(ws + WS_WDN) + (size_t)l * DM * DFF : (const bf16_t*)(ws + WS_WOUT) + (size_t)l * DM * DM,
                            dn ? DFF : QKVP, dn ? DFF : DM, M, DM, dn ? DFF : DM};
                pg8::StaticOrder S; S.init(M, DM, G, cidx);
                const bool first = (l == 0 && !dn), lastp = dn && (l == 1);
                pg8::EpiResid E{first ? a.x : nullptr, first ? nullptr : xb, lastp ? a.out : nullptr, lastp ? nullptr : xb, lastp ? nullptr : ss + (size_t)(2 * l + (dn ? 2 : 1)) * M};
                pg8::gemm_phase<pg8::EpiResid, pg8::StaticOrder>(lds, g, S, E, tid);
            } else {
                pg8::Gemm g{xb, (const bf16_t*)(ws + WS_WGU) + (size_t)l * NGU * DM, DM, DM, M, NGU, DM}; pg8::StaticOrder S; S.init(M, NGU, G, cidx);
                pg8::EpiGU E{act, ss + (size_t)(2 * l + 1) * M};
                pg8::gemm_phase<pg8::EpiGU, pg8::StaticOrder>(lds, g, S, E, tid);
            }
        }
        }
        if (ph + 1 < ph_hi) {
            if (ph == ph_lo) cg::this_grid().sync();
            else if ((ph - 1) % 7 != 0) { ++n_grid; grid_barrier((unsigned*)(a_.ws + WS_CTR) + 256, (unsigned)n_grid); }
        }
    }
}

__global__ void fill_const(float* o, int n, float v) { for (int i = blockIdx.x * blockDim.x + threadIdx.x; i < n; i += gridDim.x * blockDim.x) o[i] = v; }
extern "C" void kernel_launch(void* const* d_in, const int* in_sizes, int n_in, void* d_out, int out_size, void* d_ws, size_t ws_size, hipStream_t stream) {
    static int grid = 0;
    if (grid == 0) {
        if (n_in != 11 || in_sizes[0] != M * DM || out_size != M * DM || ws_size < WS_END) { fprintf(stderr, "kernel_launch: unexpected shapes / workspace (n_in %d, ws %zu); nothing launched\n", n_in, ws_size); grid = -1; return; }
        int dev = 0, cus = 0, per_cu = 0;
        if (hipGetDevice(&dev) != hipSuccess || hipDeviceGetAttribute(&cus, hipDeviceAttributeMultiprocessorCount, dev) != hipSuccess || cus < 1) cus = 256;
        if (hipOccupancyMaxActiveBlocksPerMultiprocessor(&per_cu, hybrid_fwd, NTHR, 0) != hipSuccess || per_cu < 1) per_cu = 1;
        (void)hipGetLastError();
        grid = cus * per_cu;
    }
    if (grid < 0) return;
    Args a{};
    a.x = (const float*)d_in[0]; a.g_mix = (const float*)d_in[1]; a.w_in = (const float*)d_in[2]; a.q_gain = (const float*)d_in[3]; a.k_gain = (const float*)d_in[4];
    a.w_branch = (const float*)d_in[5]; a.w_out = (const float*)d_in[6]; a.g_ffn = (const float*)d_in[7]; a.w_gu = (const float*)d_in[8]; a.w_down = (const float*)d_in[9];
    a.rel_bias = (const float*)d_in[10]; a.out = (float*)d_out; a.ws = (unsigned char*)d_ws;
#if MK_COOP
    a.ph_lo = 0; a.ph_hi = MK_PH_END;
    void* args[] = {&a};
    hipError_t e = hipLaunchCooperativeKernel((void*)hybrid_fwd, dim3(grid), dim3(NTHR), args, 0, stream);
    if (e != hipSuccess) fprintf(stderr, "kernel_launch: cooperative launch failed: %s (grid %d)\n", hipGetErrorString(e), grid);
#else
    for (int ph = 0; ph < MK_PH_END; ++ph) { a.ph_lo = ph; a.ph_hi = ph + 1; hipLaunchKernelGGL(hybrid_fwd, dim3(grid), dim3(NTHR), 0, stream, a); }
#endif
}
```

```cpp
#include <hip/hip_runtime.h>
#include <hip/hip_cooperative_groups.h>
#include <cstdio>
#include <cstdint>
namespace cg = cooperative_groups;

#ifndef MK_DUP_PRO
#define MK_DUP_PRO 1
#define MK_DUP_BIG 1
#define MK_DUP_BR 1
#define MK_DUP_ATT 1
#define MK_DUP_SYNC 1
#endif
#ifndef MK_PH_END
#define MK_PH_END 15
#endif
#ifndef MK_COOP
#define MK_COOP 1
#endif

namespace pg8 {
#define PG8_LAS __attribute__((address_space(3)))
typedef unsigned short bf16_t;
typedef short bf16x8 __attribute__((ext_vector_type(8)));
typedef float f32x4 __attribute__((ext_vector_type(4)));
typedef unsigned u32x4 __attribute__((ext_vector_type(4)));
typedef unsigned u32x2 __attribute__((ext_vector_type(2)));
constexpr int BM = 256, BK = 64, HALF = 128, HTB = HALF * BK * 2, STAGE_BYTES = 8 * HTB, NXCD = 8, WGM = 8;

__host__ __device__ __forceinline__ int lds_byte(int r, int c) { const int st = (r >> 4) * 2 + (c >> 5), rr = r & 15, cc = c & 31, ob = rr * 64 + cc * 2; return st * 1024 + (ob ^ (((ob >> 9) & 1) << 5)); }
__host__ __device__ __forceinline__ void stage_rc(int b, int& R, int& C) { const int st = b / 1024, sb = b % 1024, swz = sb ^ (((sb >> 9) & 1) << 5); R = (st >> 1) * 16 + swz / 64; C = (st & 1) * 32 + (swz % 64) / 2; }
__host__ __device__ __forceinline__ int perm32(int rho) { const int n = rho >> 4, i = rho & 15; return 8 * (i >> 2) + 4 * n + (i & 3); }

struct Unit { int pm, pn, seg; };
struct Gemm { const bf16_t* A; const bf16_t* Bt; int lda, ldb, M, N, K; };

struct StaticOrder {
    int nM, nN, nwg, G, c;
    __host__ __device__ void init(int M, int N, int G_, int c_) { nM = M / BM; nN = N / BM; nwg = nM * nN; G = G_; c = c_; }
    __host__ __device__ bool next(int i, Unit& u) const {
        const int L = i * G + c; if (L >= nwg) return false;
        int wgid = L; { const int q = nwg / NXCD, r = nwg % NXCD, xcd = wgid % NXCD, off = wgid / NXCD; wgid = (xcd < r ? xcd * (q + 1) : r * (q + 1) + (xcd - r) * q) + off; }
        const int nig = WGM * nN, gid = wgid / nig, fm = gid * WGM, gsz = (nM - fm) < WGM ? (nM - fm) : WGM;
        u.pm = fm + ((wgid % nig) % gsz); u.pn = (wgid % nig) / gsz; u.seg = 0; return true;
    }
    __device__ __forceinline__ int koff(const Unit&) const { return 0; }
    __device__ __forceinline__ int nt(const Unit&, int K) const { return K / BK; }
    __device__ __forceinline__ bool keep_acc(const Unit&) const { return false; }
};
struct BranchOrder {
    StaticOrder so;
    __device__ __forceinline__ bool next(int i, Unit& u) const { if (!so.next(i / 3, u)) return false; u.seg = i % 3; return true; }
    __device__ __forceinline__ int koff(const Unit& u) const { return u.seg == 0 ? 0 : (u.seg == 1 ? 512 : 1280); }
    __device__ __forceinline__ int nt(const Unit& u, int) const { return u.seg == 0 ? 8 : 12; }
    __device__ __forceinline__ bool keep_acc(const Unit& u) const { return u.seg < 2; }
};

typedef float f32x2c_t __attribute__((ext_vector_type(2))); typedef __bf16 bf16x2c_t __attribute__((ext_vector_type(2)));
__device__ __forceinline__ unsigned cvt_pk_bf16(float lo, float hi) { f32x2c_t v = {lo, hi}; bf16x2c_t b = __builtin_convertvector(v, bf16x2c_t); return __builtin_bit_cast(unsigned, b); }
__device__ __forceinline__ float bf_lo(unsigned w) { return __uint_as_float(w << 16); }
__device__ __forceinline__ float bf_hi(unsigned w) { return __uint_as_float(w & 0xffff0000u); }
__device__ __forceinline__ float sigmoidf_(float v) { return __builtin_amdgcn_rcpf(1.0f + __builtin_amdgcn_exp2f(v * -1.4426950408889634f)); }


struct EpiIn {
    static constexpr bool PERM = true;
    bf16_t* qkv; bf16_t* gates; const float* ss; const float* qg; const float* kg; float* kmean; PG8_LAS unsigned char* xl;
    __device__ __forceinline__ void operator()(const f32x4 (&acc)[2][2][4][2], const Unit& u, int wr, int wc, int fr, int fq) const {
        const int row0 = u.pm * BM + wr * 64 + fr; const bool isg = u.pn >= 24;
        bf16_t* base = isg ? gates : qkv; const int col0 = (isg ? u.pn - 24 : u.pn) * BM + wc * 32 + 8 * fq;
        float rsv[2][4];
#pragma unroll
        for (int ai = 0; ai < 2; ++ai)
#pragma unroll
            for (int m = 0; m < 4; ++m) rsv[ai][m] = ss[row0 + ai * HALF + m * 16];
#pragma unroll
        for (int ai = 0; ai < 2; ++ai)
#pragma unroll
            for (int m = 0; m < 4; ++m) rsv[ai][m] = rsqrtf(rsv[ai][m] * (1.0f / 2048.0f) + 1e-6f);
        const int sec = u.pn >> 3, hp = u.pn & 7; const bool soft = (u.pn < 16) && (hp >= 2);
        if (!soft) {
#pragma unroll
            for (int ai = 0; ai < 2; ++ai)
#pragma unroll
                for (int m = 0; m < 4; ++m) { const int row = row0 + ai * HALF + m * 16; const float rs = rsv[ai][m];
                    bf16_t* rowp = base + (size_t)row * 6144 + col0;
#pragma unroll
                    for (int bj = 0; bj < 2; ++bj) { f32x4 v0 = acc[ai][bj][m][0] * rs, v1 = acc[ai][bj][m][1] * rs;
                        if (isg) { v0 = (f32x4){sigmoidf_(v0[0]), sigmoidf_(v0[1]), sigmoidf_(v0[2]), sigmoidf_(v0[3])}; v1 = (f32x4){sigmoidf_(v1[0]), sigmoidf_(v1[1]), sigmoidf_(v1[2]), sigmoidf_(v1[3])}; }
                        u32x4 w; w.x = cvt_pk_bf16(v0[0], v0[1]); w.y = cvt_pk_bf16(v0[2], v0[3]); w.z = cvt_pk_bf16(v1[0], v1[1]); w.w = cvt_pk_bf16(v1[2], v1[3]);
                        *(u32x4*)(rowp + bj * HALF) = w; } }
            return;
        }
        PG8_LAS float* part = (PG8_LAS float*)xl; PG8_LAS float* colsum = (PG8_LAS float*)(xl + 8192);
#pragma unroll
        for (int ai = 0; ai < 2; ++ai)
#pragma unroll
            for (int m = 0; m < 4; ++m)
#pragma unroll
                for (int bj = 0; bj < 2; ++bj) { const f32x4 a0 = acc[ai][bj][m][0] * rsv[ai][m], a1 = acc[ai][bj][m][1] * rsv[ai][m];
                    float s = (a0[0] * a0[0] + a0[1] * a0[1]) + (a0[2] * a0[2] + a0[3] * a0[3]) + (a1[0] * a1[0] + a1[1] * a1[1]) + (a1[2] * a1[2] + a1[3] * a1[3]);
                    s += __shfl_xor(s, 16); s += __shfl_xor(s, 32);
                    if (fq == 0) part[((ai * HALF + wr * 64 + m * 16 + fr) * 2 + bj) * 4 + wc] = s; }
        asm volatile("s_waitcnt lgkmcnt(0)" ::: "memory"); __builtin_amdgcn_s_barrier(); asm volatile("" ::: "memory");
        const bool km = (sec == 1) && (hp <= 4);
        const float* gbase = (sec ? kg : qg) + (2 * hp - 4) * 128 + wc * 32 + 8 * fq;
        float gn[2][8], cs[2][8];
#pragma unroll
        for (int bj = 0; bj < 2; ++bj)
#pragma unroll
            for (int e = 0; e < 8; ++e) { gn[bj][e] = gbase[bj * 128 + e]; cs[bj][e] = 0.f; }
#pragma unroll
        for (int ai = 0; ai < 2; ++ai)
#pragma unroll
            for (int m = 0; m < 4; ++m) { const int rl = ai * HALF + wr * 64 + m * 16 + fr; bf16_t* rowp = base + (size_t)(u.pm * BM + rl) * 6144 + col0;
#pragma unroll
                for (int bj = 0; bj < 2; ++bj) { const f32x4 p = *(const PG8_LAS f32x4*)(part + (rl * 2 + bj) * 4);
                    const float sc = rsv[ai][m] * rsqrtf(((p[0] + p[1]) + (p[2] + p[3])) * (1.0f / 128.0f) + 1e-6f);
                    float r[8];
#pragma unroll
                    for (int e = 0; e < 4; ++e) { r[e] = acc[ai][bj][m][0][e] * sc * gn[bj][e]; r[4 + e] = acc[ai][bj][m][1][e] * sc * gn[bj][4 + e]; }
#pragma unroll
                    for (int e = 0; e < 8; ++e) cs[bj][e] += r[e];
                    u32x4 w; w.x = cvt_pk_bf16(r[0], r[1]); w.y = cvt_pk_bf16(r[2], r[3]); w.z = cvt_pk_bf16(r[4], r[5]); w.w = cvt_pk_bf16(r[6], r[7]);
                    *(u32x4*)(rowp + bj * HALF) = w; } }
        if (km) {
#pragma unroll
            for (int bj = 0; bj < 2; ++bj)
#pragma unroll
                for (int e = 0; e < 8; ++e) { float c = cs[bj][e]; c += __shfl_xor(c, 1); c += __shfl_xor(c, 2); c += __shfl_xor(c, 4); c += __shfl_xor(c, 8);
                    if (fr == 0) colsum[wr * 256 + bj * 128 + wc * 32 + 8 * fq + e] = c; }
            asm volatile("s_waitcnt lgkmcnt(0)" ::: "memory"); __builtin_amdgcn_s_barrier(); asm volatile("" ::: "memory");
            if (wr == 0) { const int c = wc * 64 + fq * 16 + fr;
                const int hs = 2 * hp - 4 + (c >> 7);
                kmean[((size_t)((u.pm >> 4) * 6 + hs) * 16 + (u.pm & 15)) * 128 + (c & 127)] = (colsum[c] + colsum[256 + c]) * (1.0f / 256.0f); }
        }
    }
};
struct EpiGU {
    static constexpr bool PERM = true;
    bf16_t* act; const float* ss;
    __device__ __forceinline__ void operator()(const f32x4 (&acc)[2][2][4][2], const Unit& u, int wr, int wc, int fr, int fq) const {
        const int row0 = u.pm * BM + wr * 64 + fr; const int col0 = u.pn * HALF + wc * 32 + 8 * fq;
        float ssv[2][4];
#pragma unroll
        for (int ai = 0; ai < 2; ++ai)
#pragma unroll
            for (int m = 0; m < 4; ++m) ssv[ai][m] = ss[row0 + ai * HALF + m * 16];
#pragma unroll
        for (int ai = 0; ai < 2; ++ai)
#pragma unroll
            for (int m = 0; m < 4; ++m) { const int row = row0 + ai * HALF + m * 16; const float rs = rsqrtf(ssv[ai][m] * (1.0f / 2048.0f) + 1e-6f);
                float r[8];
#pragma unroll
                for (int n = 0; n < 2; ++n)
#pragma unroll
                    for (int e = 0; e < 4; ++e) { const float g = acc[ai][0][m][n][e] * rs, up = acc[ai][1][m][n][e] * rs; r[n * 4 + e] = g * sigmoidf_(g) * up; }
                u32x4 w; w.x = cvt_pk_bf16(r[0], r[1]); w.y = cvt_pk_bf16(r[2], r[3]); w.z = cvt_pk_bf16(r[4], r[5]); w.w = cvt_pk_bf16(r[6], r[7]);
                *(u32x4*)(act + (size_t)row * 5632 + col0) = w; }
    }
};
struct EpiBranch {
    static constexpr bool PERM = true;
    bf16_t* merged; const bf16_t* gates;
    __device__ __forceinline__ void rescale(f32x4 (&acc)[2][2][4][2], const Unit& u, int wr, int wc, int fr, int fq, int from) const {
        int row0 = u.pm * BM + wr * 64 + fr; asm volatile("" : "+v"(row0));
        const int col0 = u.pn * BM + wc * 32 + 8 * fq + from * 2048; const float nlo = from ? 1e-30f : 0.f;
#pragma unroll
        for (int ai = 0; ai < 2; ++ai)
#pragma unroll
            for (int m = 0; m < 4; ++m) {
#pragma unroll
                for (int bj = 0; bj < 2; ++bj) { const unsigned off_ = (unsigned)((row0 + ai * HALF + m * 16) * 6144 + col0 + bj * HALF) * 2u;
                    const u32x4 a_ = *(const u32x4*)((const char*)gates + off_), b_ = *(const u32x4*)((const char*)gates + off_ + 4096u);
                    f32x4 r0, r1;
                    r0[0] = fmaxf(bf_lo(a_.x), nlo) * __builtin_amdgcn_rcpf(fmaxf(bf_lo(b_.x), 1e-30f)); r0[1] = fmaxf(bf_hi(a_.x), nlo) * __builtin_amdgcn_rcpf(fmaxf(bf_hi(b_.x), 1e-30f));
                    r0[2] = fmaxf(bf_lo(a_.y), nlo) * __builtin_amdgcn_rcpf(fmaxf(bf_lo(b_.y), 1e-30f)); r0[3] = fmaxf(bf_hi(a_.y), nlo) * __builtin_amdgcn_rcpf(fmaxf(bf_hi(b_.y), 1e-30f));
                    r1[0] = fmaxf(bf_lo(a_.z), nlo) * __builtin_amdgcn_rcpf(fmaxf(bf_lo(b_.z), 1e-30f)); r1[1] = fmaxf(bf_hi(a_.z), nlo) * __builtin_amdgcn_rcpf(fmaxf(bf_hi(b_.z), 1e-30f));
                    r1[2] = fmaxf(bf_lo(a_.w), nlo) * __builtin_amdgcn_rcpf(fmaxf(bf_lo(b_.w), 1e-30f)); r1[3] = fmaxf(bf_hi(a_.w), nlo) * __builtin_amdgcn_rcpf(fmaxf(bf_hi(b_.w), 1e-30f));
                    acc[ai][bj][m][0] = acc[ai][bj][m][0] * r0; acc[ai][bj][m][1] = acc[ai][bj][m][1] * r1; }
                asm volatile("" ::: "memory");
            }
    }
    __device__ __forceinline__ void operator()(f32x4 (&acc)[2][2][4][2], const Unit& u, int wr, int wc, int fr, int fq) const {
        if (u.seg < 2) { rescale(acc, u, wr, wc, fr, fq, u.seg); return; }
        const int row0 = u.pm * BM + wr * 64 + fr; const int col0 = u.pn * BM + wc * 32 + 8 * fq;
#pragma unroll
        for (int aq = 0; aq < 4; ++aq) { const int ai = aq >> 1, m0 = 2 * (aq & 1);
            u32x4 gw[2][2];
#pragma unroll
            for (int mm = 0; mm < 2; ++mm)
#pragma unroll
                for (int bj = 0; bj < 2; ++bj) gw[mm][bj] = *(const u32x4*)(gates + (size_t)(row0 + ai * HALF + (m0 + mm) * 16) * 6144 + 4096 + col0 + bj * HALF);
#pragma unroll
            for (int mm = 0; mm < 2; ++mm)
#pragma unroll
                for (int bj = 0; bj < 2; ++bj) { const int m = m0 + mm; const int row = row0 + ai * HALF + m * 16, col = col0 + bj * HALF; const u32x4 g_ = gw[mm][bj];
                    const float c0 = fmaxf(bf_lo(g_.x), 1e-30f), c1 = fmaxf(bf_hi(g_.x), 1e-30f), c2 = fmaxf(bf_lo(g_.y), 1e-30f), c3 = fmaxf(bf_hi(g_.y), 1e-30f);
                    const float c4 = fmaxf(bf_lo(g_.z), 1e-30f), c5 = fmaxf(bf_hi(g_.z), 1e-30f), c6 = fmaxf(bf_lo(g_.w), 1e-30f), c7 = fmaxf(bf_hi(g_.w), 1e-30f);
                    u32x4 w; w.x = cvt_pk_bf16(acc[ai][bj][m][0][0] * c0, acc[ai][bj][m][0][1] * c1); w.y = cvt_pk_bf16(acc[ai][bj][m][0][2] * c2, acc[ai][bj][m][0][3] * c3);
                    w.z = cvt_pk_bf16(acc[ai][bj][m][1][0] * c4, acc[ai][bj][m][1][1] * c5); w.w = cvt_pk_bf16(acc[ai][bj][m][1][2] * c6, acc[ai][bj][m][1][3] * c7);
                    *(u32x4*)(merged + (size_t)row * 6144 + col) = w; }
            asm volatile("" ::: "memory");
        }
    }
};
struct EpiResid {
    static constexpr bool PERM = true;
    const float* basef; const bf16_t* baseb; float* out; bf16_t* xb; float* ss;
    __device__ __forceinline__ void operator()(const f32x4 (&acc)[2][2][4][2], const Unit& u, int wr, int wc, int fr, int fq) const {
        const int row0 = u.pm * BM + wr * 64 + fr; const int col0 = u.pn * BM + wc * 32 + 8 * fq;
#pragma unroll
        for (int aq = 0; aq < 4; ++aq) { const int ai = aq >> 1, m0 = 2 * (aq & 1);
            f32x4 bv[2][2][2];
            if (basef) {
#pragma unroll
                for (int mm = 0; mm < 2; ++mm)
#pragma unroll
                    for (int bj = 0; bj < 2; ++bj) { const size_t off = (size_t)(row0 + ai * HALF + (m0 + mm) * 16) * 2048 + col0 + bj * HALF;
                        bv[mm][bj][0] = *(const f32x4*)(basef + off); bv[mm][bj][1] = *(const f32x4*)(basef + off + 4); }
            } else {
                u32x4 bw[2][2];
#pragma unroll
                for (int mm = 0; mm < 2; ++mm)
#pragma unroll
                    for (int bj = 0; bj < 2; ++bj) bw[mm][bj] = *(const u32x4*)(baseb + (size_t)(row0 + ai * HALF + (m0 + mm) * 16) * 2048 + col0 + bj * HALF);
#pragma unroll
                for (int mm = 0; mm < 2; ++mm)
#pragma unroll
                    for (int bj = 0; bj < 2; ++bj) { const u32x4 w_ = bw[mm][bj];
                        bv[mm][bj][0] = (f32x4){bf_lo(w_.x), bf_hi(w_.x), bf_lo(w_.y), bf_hi(w_.y)}; bv[mm][bj][1] = (f32x4){bf_lo(w_.z), bf_hi(w_.z), bf_lo(w_.w), bf_hi(w_.w)}; }
            }
#pragma unroll
            for (int mm = 0; mm < 2; ++mm) { const int m = m0 + mm; const int row = row0 + ai * HALF + m * 16; float sq = 0.f;
#pragma unroll
                for (int bj = 0; bj < 2; ++bj) { const size_t off = (size_t)row * 2048 + col0 + bj * HALF;
                    const f32x4 o0 = bv[mm][bj][0] + acc[ai][bj][m][0], o1 = bv[mm][bj][1] + acc[ai][bj][m][1];
                    if (out) { *(f32x4*)(out + off) = o0; *(f32x4*)(out + off + 4) = o1; }
                    sq += (o0[0] * o0[0] + o0[1] * o0[1]) + (o0[2] * o0[2] + o0[3] * o0[3]) + (o1[0] * o1[0] + o1[1] * o1[1]) + (o1[2] * o1[2] + o1[3] * o1[3]);
                    if (xb) { u32x4 w; w.x = cvt_pk_bf16(o0[0], o0[1]); w.y = cvt_pk_bf16(o0[2], o0[3]); w.z = cvt_pk_bf16(o1[0], o1[1]); w.w = cvt_pk_bf16(o1[2], o1[3]); *(u32x4*)(xb + off) = w; } }
                if (ss) { sq += __shfl_xor(sq, 16); sq += __shfl_xor(sq, 32); if (fq == 0) atomicAdd(ss + row, sq); } }
            asm volatile("" ::: "memory");
        }
    }
};

template <class Epi, class Sched>
__device__ __forceinline__ void gemm_phase(PG8_LAS unsigned char* lds, const Gemm g, const Sched& S, const Epi& E, const int tid) {
    const int wid = __builtin_amdgcn_readfirstlane(tid >> 6), lane = tid & 63, wr = wid >> 2, wc = wid & 3, fr = lane & 15, fq = lane >> 4;
    unsigned voffA[2], voffB[2];
#pragma unroll
    for (int i = 0; i < 2; ++i) { int R, C; stage_rc(tid * 16 + i * 8192, R, C); const int Rb = Epi::PERM ? ((R & ~31) + perm32(R & 31)) : R;
        voffA[i] = (unsigned)(R * g.lda + C) * 2u; voffB[i] = (unsigned)(Rb * g.ldb + C) * 2u; }
    const size_t kstep = (size_t)(BK * 2);
    const size_t hstepA = (size_t)HALF * g.lda * 2, hstepB = (size_t)HALF * g.ldb * 2;
    const size_t tstepA = 2 * hstepA, tstepB = 2 * hstepB;
    const unsigned ldsw = (unsigned)wid * 1024u;
    const int aoff = lds_byte(wr * 64 + fr, fq * 8), boff = lds_byte(wc * 32 + fr, fq * 8);
#define PG8_SA(b, h) (((b) * 2 + (h)) * HTB)
#define PG8_SB(b, h) ((4 + (b) * 2 + (h)) * HTB)
#define PG8_STAGE(bufoff, gbase, voff) do { _Pragma("unroll") for (int _i = 0; _i < 2; ++_i) \
        __builtin_amdgcn_global_load_lds((const unsigned*)((const char*)(gbase) + (voff)[_i]), (PG8_LAS unsigned*)(lds + (bufoff) + ldsw + _i * 8192), 16, 0, 0); } while (0)
#define PG8_LDA(dst, b, h) do { _Pragma("unroll") for (int m = 0; m < 4; ++m) _Pragma("unroll") for (int k = 0; k < 2; ++k) dst[m][k] = *(const PG8_LAS bf16x8*)(lds + PG8_SA(b, h) + aoff + m * 2048 + k * 1024); } while (0)
#define PG8_LDB(dst, b, h) do { _Pragma("unroll") for (int n = 0; n < 2; ++n) _Pragma("unroll") for (int k = 0; k < 2; ++k) dst[n][k] = *(const PG8_LAS bf16x8*)(lds + PG8_SB(b, h) + boff + n * 2048 + k * 1024); } while (0)
#define PG8_MMA(ai, bj, At, Bt) do { __builtin_amdgcn_s_setprio(1); _Pragma("unroll") for (int m = 0; m < 4; ++m) _Pragma("unroll") for (int n = 0; n < 2; ++n) _Pragma("unroll") for (int k = 0; k < 2; ++k) \
        acc[ai][bj][m][n] = __builtin_amdgcn_mfma_f32_16x16x32_bf16(Bt[n][k], At[m][k], acc[ai][bj][m][n], 0, 0, 0); __builtin_amdgcn_s_setprio(0); } while (0)
#define PG8_WAIT_V(n) asm volatile("s_waitcnt vmcnt(" #n ")" ::: "memory")
#define PG8_WAIT_L(n) asm volatile("s_waitcnt lgkmcnt(" #n ")" ::: "memory")
#define PG8_BAR __builtin_amdgcn_s_barrier()
#define PG8_SCHED __builtin_amdgcn_sched_barrier(0)
    Unit cur, nxt; int ui = 0;
    if (!S.next(0, cur)) return;
    f32x4 acc[2][2][4][2];
#pragma unroll
    for (int a = 0; a < 2; ++a)
#pragma unroll
        for (int b = 0; b < 2; ++b)
#pragma unroll
            for (int m = 0; m < 4; ++m)
#pragma unroll
                for (int n = 0; n < 2; ++n) acc[a][b][m][n] = (f32x4){0.f, 0.f, 0.f, 0.f};
    bf16x8 At[4][2], B0[2][2], B1[2][2];
    const char* cA = (const char*)g.A + (size_t)cur.pm * tstepA + 2 * S.koff(cur); const char* cB = (const char*)g.Bt + (size_t)cur.pn * tstepB + 2 * S.koff(cur);
    PG8_STAGE(PG8_SB(0, 0), cB, voffB); PG8_STAGE(PG8_SB(0, 1), cB + hstepB, voffB); PG8_STAGE(PG8_SA(0, 0), cA, voffA); PG8_STAGE(PG8_SA(0, 1), cA + hstepA, voffA);
    if (wr == 1) PG8_BAR;
    PG8_WAIT_V(2); PG8_BAR;
    PG8_STAGE(PG8_SB(1, 0), cB + kstep, voffB); PG8_STAGE(PG8_SA(1, 0), cA + kstep, voffA); PG8_STAGE(PG8_SB(1, 1), cB + hstepB + kstep, voffB);
    PG8_WAIT_V(6); PG8_BAR;
    for (;;) {
        const bool has_next = S.next(ui + 1, nxt);
        const char* nA = has_next ? (const char*)g.A + (size_t)nxt.pm * tstepA + 2 * S.koff(nxt) : cA; const char* nB = has_next ? (const char*)g.Bt + (size_t)nxt.pn * tstepB + 2 * S.koff(nxt) : cB;
        const int nt = S.nt(cur, g.K);
        for (int t = 0; t < nt; t += 2) {
            const bool last = (t == nt - 2);
            const char* a1 = cA + (size_t)(t + 1) * kstep;
            const char* a2 = last ? nA : cA + (size_t)(t + 2) * kstep; const char* b2 = last ? nB : cB + (size_t)(t + 2) * kstep;
            const char* a3 = a2 + kstep; const char* b3 = b2 + kstep;
            PG8_LDB(B0, 0, 0); PG8_LDB(B1, 0, 1); PG8_SCHED; PG8_LDA(At, 0, 0); PG8_STAGE(PG8_SA(1, 1), a1 + hstepA, voffA);
            PG8_WAIT_V(8); PG8_WAIT_L(0); PG8_BAR; PG8_MMA(0, 0, At, B0); PG8_MMA(0, 1, At, B1); PG8_BAR; PG8_SCHED;
            PG8_LDA(At, 0, 1); PG8_STAGE(PG8_SB(0, 0), b2, voffB); PG8_STAGE(PG8_SB(0, 1), b2 + hstepB, voffB); PG8_STAGE(PG8_SA(0, 0), a2, voffA);
            PG8_WAIT_V(8); PG8_WAIT_L(0); PG8_BAR; PG8_MMA(1, 0, At, B0); PG8_MMA(1, 1, At, B1); PG8_BAR; PG8_SCHED;
            PG8_LDB(B0, 1, 0); PG8_LDB(B1, 1, 1); PG8_SCHED; PG8_LDA(At, 1, 0); PG8_STAGE(PG8_SA(0, 1), a2 + hstepA, voffA);
            PG8_WAIT_V(8); PG8_WAIT_L(0); PG8_BAR; PG8_MMA(0, 0, At, B0); PG8_MMA(0, 1, At, B1); PG8_BAR; PG8_SCHED;
            PG8_LDA(At, 1, 1); PG8_STAGE(PG8_SB(1, 0), b3, voffB); PG8_STAGE(PG8_SB(1, 1), b3 + hstepB, voffB); PG8_STAGE(PG8_SA(1, 0), a3, voffA);
            PG8_WAIT_V(8); PG8_WAIT_L(0); PG8_BAR; PG8_MMA(1, 0, At, B0); PG8_MMA(1, 1, At, B1); PG8_BAR; PG8_SCHED;
        }
        if (wr == 0) PG8_BAR;
        E(acc, cur, wr, wc, fr, fq);
        if (!has_next) break;
        if (!S.keep_acc(cur))
#pragma unroll
        for (int a = 0; a < 2; ++a)
#pragma unroll
            for (int b = 0; b < 2; ++b)
#pragma unroll
                for (int m = 0; m < 4; ++m)
#pragma unroll
                    for (int n = 0; n < 2; ++n) acc[a][b][m][n] = (f32x4){0.f, 0.f, 0.f, 0.f};
        cur = nxt; cA = nA; cB = nB; ++ui;
        if (wr == 1) PG8_BAR;
    }
    PG8_WAIT_V(0);
    PG8_BAR;
#undef PG8_SA
#undef PG8_SB
#undef PG8_STAGE
#undef PG8_LDA
#undef PG8_LDB
#undef PG8_MMA
#undef PG8_WAIT_V
#undef PG8_WAIT_L
#undef PG8_BAR
#undef PG8_SCHED
}
}

#define GAS __attribute__((address_space(1)))
#define LAS __attribute__((address_space(3)))
typedef unsigned short bf16_t;
typedef short bf16x8 __attribute__((ext_vector_type(8)));
typedef short s16x4 __attribute__((ext_vector_type(4)));
typedef float f32x4 __attribute__((ext_vector_type(4)));
typedef float f32x16 __attribute__((ext_vector_type(16)));
typedef unsigned u32x4 __attribute__((ext_vector_type(4)));
typedef unsigned u32x2 __attribute__((ext_vector_type(2)));

constexpr int DM = 2048, BATCH = 4, SEQ = 4096, M = BATCH * SEQ, DFF = 5632, NIN = 12288, NGU = 11264, QKVP = 6144;
constexpr int NWAVES = 8, NTHR = 512;
constexpr size_t MiB = 1u << 20;
constexpr size_t WS_CTR = 0, WS_SS = 64 * 1024, WS_LUT = 512 * 1024, WS_KM = 1 * MiB;
constexpr size_t WS_WIN = 4 * MiB, WS_WBR = 100 * MiB, WS_WOUT = 116 * MiB, WS_WGU = 132 * MiB, WS_WDN = 220 * MiB;
constexpr size_t WS_XB = 264 * MiB, WS_QKV = 328 * MiB, WS_GATES = 520 * MiB, WS_END = 712 * MiB;
constexpr int LDS_BYTES = 143360;
constexpr int ATT_V_OFF = 0, ATT_LUT_OFF = 65536, ATT_KM_OFF = 81920, DIL_K_OFF = 73728, MISC_OFF = 142336;

struct Args {
    const float* x; const float* g_mix; const float* w_in; const float* q_gain; const float* k_gain; const float* w_branch; const float* w_out;
    const float* g_ffn; const float* w_gu; const float* w_down; const float* rel_bias;
    float* out; unsigned char* ws; int ph_lo, ph_hi;
};

__device__ __forceinline__ unsigned f2bf(float f) { unsigned u = __builtin_bit_cast(unsigned, f); return (u + 0x7fffu + ((u >> 16) & 1u)) >> 16; }
__device__ __forceinline__ unsigned pk2(float lo, float hi) { return pg8::cvt_pk_bf16(lo, hi); }
__device__ __forceinline__ float wave_sum(float v) {
#pragma unroll
    for (int o = 1; o < 64; o <<= 1) v += __shfl_xor(v, o);
    return v;
}

template <bool GU>
__device__ __forceinline__ void transpose_item(const float* W, const float* gk, int K, int N, bf16_t* WT, LAS float* scr, int item, int lane) {
    const int nblk = N / 32, kb = item / nblk, nb = item % nblk, k0 = 64 * kb, n0 = 32 * nb;
    float v[32];
#pragma unroll
    for (int i = 0; i < 32; ++i) v[i] = W[(size_t)(k0 + 2 * i + (lane >> 5)) * N + n0 + (lane & 31)];
#pragma unroll
    for (int i = 0; i < 32; ++i) { const int kk = 2 * i + (lane >> 5); if (gk) v[i] *= gk[k0 + kk]; scr[kk * 33 + (lane & 31)] = v[i]; }
    asm volatile("s_waitcnt lgkmcnt(0)" ::: "memory");
    const int c = lane & 7;
#pragma unroll
    for (int j = 0; j < 4; ++j) { const int n = (lane >> 3) + 8 * j; const LAS float* s = scr + (8 * c) * 33 + n;
        u32x4 o; o.x = pk2(s[0 * 33], s[1 * 33]); o.y = pk2(s[2 * 33], s[3 * 33]); o.z = pk2(s[4 * 33], s[5 * 33]); o.w = pk2(s[6 * 33], s[7 * 33]);
        int col = n0 + n, drow;
        if (GU) { const int half = col >= DFF ? 1 : 0, jj = col - half * DFF; drow = 256 * (jj >> 7) + 128 * half + (jj & 127); } else drow = col;
        *(u32x4*)(WT + (size_t)drow * K + k0 + 8 * c) = o; }
    asm volatile("s_waitcnt lgkmcnt(0)" ::: "memory");
}

__device__ __forceinline__ void phase_prologue(const Args& a, LAS unsigned char* lds, int tid, int lane, int wave) {
    unsigned char* ws = a.ws;
    LAS float* scr = (LAS float*)(lds + wave * 16384);
    int NGW = gridDim.x * NWAVES; asm volatile("" : "+s"(NGW));
    const int gw = blockIdx.x * NWAVES + wave;
    constexpr int I_IN = (DM / 64) * (NIN / 32), I_BR = (DM / 64) * (DM / 32), I_OUT = I_BR, I_GU = (DM / 64) * (NGU / 32), I_DN = (DFF / 64) * (DM / 32);
    constexpr int I_LAYER = I_IN + I_BR + I_OUT + I_GU + I_DN;
    for (int it = gw; it < 2 * I_LAYER; it += NGW) {
        const int l = it / I_LAYER; int r = it % I_LAYER;
        if (r < I_IN) { transpose_item<false>(a.w_in + (size_t)l * DM * NIN, a.g_mix + l * DM, DM, NIN, (bf16_t*)(ws + WS_WIN) + (size_t)l * NIN * DM, scr, r, lane); continue; } r -= I_IN;
        if (r < I_BR) { transpose_item<false>(a.w_branch + (size_t)l * DM * DM, nullptr, DM, DM, (bf16_t*)(ws + WS_WBR) + (size_t)l * DM * DM, scr, r, lane); continue; } r -= I_BR;
        if (r < I_OUT) { transpose_item<false>(a.w_out + (size_t)l * DM * DM, nullptr, DM, DM, (bf16_t*)(ws + WS_WOUT) + (size_t)l * DM * DM, scr, r, lane); continue; } r -= I_OUT;
        if (r < I_GU) { transpose_item<true>(a.w_gu + (size_t)l * DM * NGU, a.g_ffn + l * DM, DM, NGU, (bf16_t*)(ws + WS_WGU) + (size_t)l * NGU * DM, scr, r, lane); continue; } r -= I_GU;
        transpose_item<false>(a.w_down + (size_t)l * DFF * DM, nullptr, DFF, DM, (bf16_t*)(ws + WS_WDN) + (size_t)l * DM * DFF, scr, r, lane);
    }
    float* ss = (float*)(ws + WS_SS);
    for (int m = gw; m < M; m += NGW) {
        const f32x4* xr = (const f32x4*)(a.x + (size_t)m * DM) + lane; u32x2* o8 = (u32x2*)((bf16_t*)(ws + WS_XB) + (size_t)m * DM) + lane;
        float s = 0.f;
#pragma unroll
        for (int j = 0; j < 8; ++j) { const f32x4 v = xr[64 * j]; s += (v.x * v.x + v.y * v.y) + (v.z * v.z + v.w * v.w); u32x2 w; w.x = pk2(v.x, v.y); w.y = pk2(v.z, v.w); o8[64 * j] = w; }
        s = wave_sum(s);
        if (lane == 0) ss[m] = s;
    }
    int NGT = gridDim.x * NTHR; asm volatile("" : "+s"(NGT));
    const int gt = blockIdx.x * NTHR + tid;
    for (int i = gt; i < 3 * M; i += NGT) ss[M + i] = 0.f;
    if (gt < 1024) ((unsigned*)(ws + WS_CTR))[gt] = 0u;
    float* lut = (float*)(ws + WS_LUT);
    for (int i = gt; i < 12 * 4096; i += NGT) { const int hs = i >> 12, d = i & 4095; int bucket;
        if (d < 16) bucket = d; else { const float df = (float)d; int large = 16 + (int)(logf(df / 16.0f) / 4.852030263919617f * 16.0f); bucket = large < 31 ? large : 31; }
        lut[i] = a.rel_bias[bucket * 12 + hs] * 1.4426950408889634f; }
}

__device__ __forceinline__ void phase_qknorm(const Args& a, int l, LAS unsigned char* lds, int tid, int lane, int wave) {
    bf16_t* qkv = (bf16_t*)(a.ws + WS_QKV); float* kmean = (float*)(a.ws + WS_KM);
    LAS float* red = (LAS float*)lds;
    for (int it = blockIdx.x; it < 1536; it += gridDim.x) {
        const int kind = it / 768, rem = it % 768, b = rem / 192, hs = (rem % 192) / 16, blk = rem % 16;
        const float* gain = (kind ? a.k_gain : a.q_gain) + (size_t)l * 12 * 128 + hs * 128 + (lane & 15) * 8;
        float gn[8];
#pragma unroll
        for (int e = 0; e < 8; ++e) gn[e] = gain[e];
        bf16_t* base = qkv + (size_t)(b * SEQ + blk * 256 + wave * 32) * QKVP + kind * 2048 + (4 + hs) * 128 + (lane & 15) * 8;
        float ks[8];
#pragma unroll
        for (int e = 0; e < 8; ++e) ks[e] = 0.f;
        u32x4 wv[8];
#pragma unroll
        for (int ii = 0; ii < 8; ++ii) wv[ii] = *(const u32x4*)(base + (size_t)(4 * ii + (lane >> 4)) * QKVP);
#pragma unroll
        for (int ii = 0; ii < 8; ++ii) { bf16_t* p = base + (size_t)(4 * ii + (lane >> 4)) * QKVP;
            const u32x4 w = wv[ii]; float v[8];
            v[0] = pg8::bf_lo(w.x); v[1] = pg8::bf_hi(w.x); v[2] = pg8::bf_lo(w.y); v[3] = pg8::bf_hi(w.y); v[4] = pg8::bf_lo(w.z); v[5] = pg8::bf_hi(w.z); v[6] = pg8::bf_lo(w.w); v[7] = pg8::bf_hi(w.w);
            float s = 0.f;
#pragma unroll
            for (int e = 0; e < 8; ++e) s += v[e] * v[e];
            s += __shfl_xor(s, 1); s += __shfl_xor(s, 2); s += __shfl_xor(s, 4); s += __shfl_xor(s, 8);
            const float rs = rsqrtf(s * (1.0f / 128.0f) + 1e-6f);
#pragma unroll
            for (int e = 0; e < 8; ++e) { v[e] = v[e] * rs * gn[e]; ks[e] += v[e]; }
            u32x4 o; o.x = pk2(v[0], v[1]); o.y = pk2(v[2], v[3]); o.z = pk2(v[4], v[5]); o.w = pk2(v[6], v[7]);
            *(u32x4*)p = o; }
        const bool km = (kind == 1) && (hs < 6);
        if (km) {
#pragma unroll
            for (int e = 0; e < 8; ++e) { ks[e] += __shfl_xor(ks[e], 16); ks[e] += __shfl_xor(ks[e], 32); }
            if (lane < 16) {
#pragma unroll
                for (int e = 0; e < 8; ++e) red[wave * 128 + lane * 8 + e] = ks[e]; }
        }
        __syncthreads();
        if (km && tid < 128) { float s = 0.f;
#pragma unroll
            for (int w = 0; w < 8; ++w) s += red[w * 128 + tid];
            kmean[((size_t)(b * 6 + hs) * 16 + blk) * 128 + tid] = s * (1.0f / 256.0f); }
        __syncthreads();
    }
}

namespace att {
constexpr float SCALE = 0.08838834764831845f, LOG2E = 1.4426950408889634f, NEG = -1e30f, C1 = SCALE * LOG2E;
__device__ __forceinline__ unsigned offa(unsigned row, unsigned ch) { return 2048u * (row >> 3) + 512u * (ch >> 2) + 64u * (row & 7u) + 16u * ((ch & 3u) ^ ((row >> 2) & 3u)); }
__device__ __forceinline__ int clamp_s(int s) { return s < 0 ? 0 : (s > SEQ - 1 ? SEQ - 1 : s); }
__device__ __forceinline__ void load_k(bf16x8 (&kf)[8], const bf16_t* Kb, int s0, int stride, int lane) {
    const int s = clamp_s(s0 + stride * (lane & 31));
    const GAS bf16x8* p = (const GAS bf16x8*)(Kb + (size_t)s * QKVP + 8 * (lane >> 5));
#pragma unroll
    for (int j = 0; j < 8; ++j) kf[j] = p[2 * j];
}
__device__ __forceinline__ void load_v(u32x4 (&vr)[8], const bf16_t* Vb, int s0, int stride, int lane) {
#pragma unroll
    for (int ii = 0; ii < 8; ++ii) { const int s = clamp_s(s0 + stride * ((lane >> 4) + 4 * ii)); vr[ii] = *(const GAS u32x4*)(Vb + (size_t)s * QKVP + (lane & 15) * 8); }
}
__device__ __forceinline__ void stage_v(LAS unsigned char* vl, const u32x4 (&vr)[8], int lane) {
    const unsigned ch = lane & 15, wl = 512u * (ch >> 2) + 64u * (unsigned)(lane >> 4);
#pragma unroll
    for (int ii = 0; ii < 8; ++ii) *(LAS u32x4*)(vl + wl + 16u * ((ch & 3u) ^ (unsigned)(ii & 3)) + 2048 * (ii >> 1) + 256 * (ii & 1)) = vr[ii];
}
__device__ __forceinline__ f32x16 qk(const bf16x8 (&kf)[8], const bf16x8 (&qf)[8]) {
    f32x16 acc = {0.f, 0.f, 0.f, 0.f, 0.f, 0.f, 0.f, 0.f, 0.f, 0.f, 0.f, 0.f, 0.f, 0.f, 0.f, 0.f};
#pragma unroll
    for (int j = 0; j < 8; ++j) acc = __builtin_amdgcn_mfma_f32_32x32x16_bf16(kf[j], qf[j], acc, 0, 0, 0);
    return acc;
}
typedef short v4i16_t __attribute__((ext_vector_type(4)));
__device__ __forceinline__ s16x4 vtr(LAS unsigned char* p) { return __builtin_bit_cast(s16x4, __builtin_amdgcn_ds_read_tr16_b64_v4i16((LAS v4i16_t*)p)); }
__device__ __forceinline__ void pv(f32x16 (&o)[4], LAS unsigned char* vl, bf16x8 P0, bf16x8 P1, int lane) {
    const unsigned h = lane >> 5, blk = (lane >> 4) & 1, q = (lane & 15) >> 2, p = lane & 3;
    const unsigned lb = 64u * (4u * h + q) + 16u * ((p >> 1) ^ h) + 8u * (p & 1u);
    LAS unsigned char* b0 = vl + lb + 32u * blk; LAS unsigned char* b1 = vl + lb + 32u * (blk ^ 1u) + 2048u;
#pragma unroll
    for (int hf = 0; hf < 2; ++hf) {
        s16x4 lo[2][2], hi[2][2];
#pragma unroll
        for (int cc = 0; cc < 2; ++cc)
#pragma unroll
            for (int s = 0; s < 2; ++s) { lo[cc][s] = vtr(b0 + 4096 * s + 512 * (2 * hf + cc)); hi[cc][s] = vtr(b1 + 4096 * s + 512 * (2 * hf + cc)); }
        asm volatile("s_waitcnt lgkmcnt(0)" ::: "memory");
        __builtin_amdgcn_sched_barrier(0);
#pragma unroll
        for (int cc = 0; cc < 2; ++cc)
#pragma unroll
            for (int s = 0; s < 2; ++s) {
                const bf16x8 A = {lo[cc][s][0], lo[cc][s][1], lo[cc][s][2], lo[cc][s][3], hi[cc][s][0], hi[cc][s][1], hi[cc][s][2], hi[cc][s][3]};
                o[2 * hf + cc] = __builtin_amdgcn_mfma_f32_32x32x16_bf16(A, s ? P1 : P0, o[2 * hf + cc], 0, 0, 0);
            }
        __builtin_amdgcn_sched_barrier(0);
    }
}
typedef float f32x2_t __attribute__((ext_vector_type(2))); typedef __bf16 bf16x2_t __attribute__((ext_vector_type(2)));
__device__ __forceinline__ unsigned cvtpk(float lo, float hi) { f32x2_t v = {lo, hi}; bf16x2_t b = __builtin_convertvector(v, bf16x2_t); return __builtin_bit_cast(unsigned, b); }
__device__ __forceinline__ void pack_p(const float (&p)[16], bf16x8& P0, bf16x8& P1) {
    u32x4 a, b; a.x = cvtpk(p[0], p[1]); a.y = cvtpk(p[2], p[3]); a.z = cvtpk(p[4], p[5]); a.w = cvtpk(p[6], p[7]);
    b.x = cvtpk(p[8], p[9]); b.y = cvtpk(p[10], p[11]); b.z = cvtpk(p[12], p[13]); b.w = cvtpk(p[14], p[15]);
    P0 = __builtin_bit_cast(bf16x8, a); P1 = __builtin_bit_cast(bf16x8, b);
}
__device__ __forceinline__ void softmax_step(float (&x)[16], float& m, float& l, f32x16 (&o)[4], bf16x8& P0, bf16x8& P1) {
    float mx = fmaxf(x[0], x[1]);
#pragma unroll
    for (int r = 2; r < 16; ++r) mx = fmaxf(mx, x[r]);
    mx = fmaxf(mx, __shfl_xor(mx, 32));
    const float mn = fmaxf(m, mx);
    const float alpha = __builtin_amdgcn_exp2f(m - mn);
    float ls = 0.f;
#pragma unroll
    for (int r = 0; r < 16; ++r) { const float p = __builtin_amdgcn_exp2f(x[r] - mn); ls += p; x[r] = p; }
    l = l * alpha + ls; m = mn;
    if (__any(alpha != 1.0f)) {
#pragma unroll
        for (int c = 0; c < 4; ++c) o[c] = o[c] * alpha;
    }
    pack_p(x, P0, P1);
}
__device__ __forceinline__ void softmax_fixed(float (&x)[16], float& l, bf16x8& P0, bf16x8& P1) {
    float ls = 0.f;
#pragma unroll
    for (int r = 0; r < 16; ++r) { const float p = __builtin_amdgcn_exp2f(x[r]); ls += p; x[r] = p; }
    l += ls;
    pack_p(x, P0, P1);
}
__device__ __forceinline__ float softmax_ref(const Args& a, int l, int hs, const bf16x8 (&qf)[8], int lane) {
    const float* kg = a.k_gain + (size_t)l * 12 * 128 + hs * 128;
    float gm = fmaxf(fabsf(kg[lane]), fabsf(kg[lane + 64]));
    float bm = a.rel_bias[(lane & 31) * 12 + hs];
#pragma unroll
    for (int o_ = 1; o_ < 64; o_ <<= 1) { gm = fmaxf(gm, __shfl_xor(gm, o_)); bm = fmaxf(bm, __shfl_xor(bm, o_)); }
    float qs = 0.f;
#pragma unroll
    for (int j = 0; j < 8; ++j) { const u32x4 qw = __builtin_bit_cast(u32x4, qf[j]);
        const float q0 = pg8::bf_lo(qw.x), q1 = pg8::bf_hi(qw.x), q2 = pg8::bf_lo(qw.y), q3 = pg8::bf_hi(qw.y), q4 = pg8::bf_lo(qw.z), q5 = pg8::bf_hi(qw.z), q6 = pg8::bf_lo(qw.w), q7 = pg8::bf_hi(qw.w);
        qs += (q0 * q0 + q1 * q1) + (q2 * q2 + q3 * q3) + (q4 * q4 + q5 * q5) + (q6 * q6 + q7 * q7); }
    qs += __shfl_xor(qs, 32);
    return C1 * sqrtf(qs) * (11.3137085f * 1.004f * gm) + bm * LOG2E + 1e-3f;
}
__device__ __forceinline__ void store_o(const f32x16 (&o)[4], float inv, bf16_t* orow, int lane) {
    const int h = lane >> 5;
#pragma unroll
    for (int c = 0; c < 4; ++c)
#pragma unroll
        for (int i = 0; i < 4; ++i) { u32x2 w; w.x = cvtpk(o[c][4 * i] * inv, o[c][4 * i + 1] * inv); w.y = cvtpk(o[c][4 * i + 2] * inv, o[c][4 * i + 3] * inv);
            *(GAS u32x2*)(orow + 32 * c + 8 * i + 4 * h) = w; }
}
__device__ __forceinline__ void load_q(bf16x8 (&qf)[8], const bf16_t* qrow, int lane) {
    const GAS bf16x8* p = (const GAS bf16x8*)(qrow + 8 * (lane >> 5));
#pragma unroll
    for (int j = 0; j < 8; ++j) qf[j] = p[2 * j];
}

__device__ __forceinline__ void unit_moba(const Args& a, int lyr, bf16_t* Ob, int OP, int b, int hm, int qb, LAS unsigned char* lds, int tid, int lane, int wave) {
    asm volatile("" : "+v"(lane));
    const bf16_t* qkv = (const bf16_t*)(a.ws + WS_QKV);
    LAS float* lutL = (LAS float*)(lds + ATT_LUT_OFF); LAS float* kmL = (LAS float*)(lds + ATT_KM_OFF);
    { const float* lutG = (const float*)(a.ws + WS_LUT) + hm * 4096;
#pragma unroll
      for (int k_ = 0; k_ < 8; ++k_) lutL[tid + k_ * NTHR] = lutG[tid + k_ * NTHR];
      const float* kmG = (const float*)(a.ws + WS_KM) + (size_t)(b * 6 + hm) * 16 * 128;
#pragma unroll
      for (int k_ = 0; k_ < 4; ++k_) kmL[tid + k_ * NTHR] = kmG[tid + k_ * NTHR]; }
    __syncthreads();
    const int h = lane >> 5, t0 = qb * 256, tw = t0 + 32 * wave, t = tw + (lane & 31), hg = 4 + hm;
    const bf16_t* Kb = qkv + (size_t)b * SEQ * QKVP + 2048 + hg * 128; const bf16_t* Vb = Kb + 2048;
    bf16x8 qf[8]; load_q(qf, qkv + (size_t)(b * SEQ + t) * QKVP + hg * 128, lane);
    unsigned selmask = 0u, anymask = 0u;
    if (qb > 0) {
        float v1 = -3e38f, v2 = -3e38f, v3 = -3e38f; int i1 = -1, i2 = -1, i3 = -1;
        for (int n = 0; n < qb; ++n) {
            float g = 0.f;
#pragma unroll
            for (int j = 0; j < 8; ++j) { const LAS f32x4* kp = (const LAS f32x4*)(kmL + n * 128 + 16 * j + 8 * h); const f32x4 k0 = kp[0], k1 = kp[1];
                const u32x4 qw = __builtin_bit_cast(u32x4, qf[j]);
                g += pg8::bf_lo(qw.x) * k0[0] + pg8::bf_hi(qw.x) * k0[1] + pg8::bf_lo(qw.y) * k0[2] + pg8::bf_hi(qw.y) * k0[3]
                   + pg8::bf_lo(qw.z) * k1[0] + pg8::bf_hi(qw.z) * k1[1] + pg8::bf_lo(qw.w) * k1[2] + pg8::bf_hi(qw.w) * k1[3]; }
            g += __shfl_xor(g, 32);
            if (g > v1) { v3 = v2; i3 = i2; v2 = v1; i2 = i1; v1 = g; i1 = n; } else if (g > v2) { v3 = v2; i3 = i2; v2 = g; i2 = n; } else if (g > v3) { v3 = g; i3 = n; }
        }
        if (i1 >= 0) selmask |= 1u << i1; if (i2 >= 0) selmask |= 1u << i2; if (i3 >= 0) selmask |= 1u << i3;
        for (int n = 0; n < qb; ++n) if (__ballot((selmask >> n) & 1u) != 0ull) anymask |= 1u << n;
    }
    volatile LAS unsigned* misc = (volatile LAS unsigned*)(lds + MISC_OFF);
    if (tid == 0) misc[4] = 0u;
    __syncthreads();
    if (lane == 0 && anymask != 0u) __hip_atomic_fetch_or((LAS unsigned*)(lds + MISC_OFF + 16), anymask, __ATOMIC_RELAXED, __HIP_MEMORY_SCOPE_WORKGROUP);
    __syncthreads();
    const unsigned anywg = misc[4];
    const float nref = -softmax_ref(a, lyr, hm, qf, lane);
    float l = 0.f; f32x16 o[4];
#pragma unroll
    for (int c = 0; c < 4; ++c) o[c] = (f32x16){0.f, 0.f, 0.f, 0.f, 0.f, 0.f, 0.f, 0.f, 0.f, 0.f, 0.f, 0.f, 0.f, 0.f, 0.f, 0.f};
    const int srow = 8 * (wave >> 1) + ((lane >> 2) & 7), sch = 4 * (2 * (wave & 1) + (lane >> 5)) + ((lane & 3) ^ ((srow >> 2) & 3));
    const bf16_t* kg = Kb + (size_t)srow * QKVP + sch * 8; const bf16_t* vg = Vb + (size_t)srow * QKVP + sch * 8;
    const int r31 = lane & 31; const unsigned x0 = (r31 >> 2) & 1, x1 = (r31 >> 3) & 1;
    const unsigned kb_l = 2048u * (r31 >> 3) + 64u * (r31 & 7) + 16u * ((unsigned)h ^ x0);
    const unsigned ke0 = kb_l + 32u * x1, ke1 = kb_l + 32u * (x1 ^ 1u);
#define MOBA_STAGE(buf, nblk, stp) do { const size_t ro_ = (size_t)(256 * (nblk) + 64 * (stp)) * QKVP; LAS unsigned char* d_ = lds + ATT_V_OFF + (buf) * 32768 + wave * 1024; \
        __builtin_amdgcn_global_load_lds((const unsigned*)(kg + ro_), (LAS unsigned*)(d_), 16, 0, 0); \
        __builtin_amdgcn_global_load_lds((const unsigned*)(kg + ro_ + 32 * QKVP), (LAS unsigned*)(d_ + 8192), 16, 0, 0); \
        __builtin_amdgcn_global_load_lds((const unsigned*)(vg + ro_), (LAS unsigned*)(d_ + 16384), 16, 0, 0); \
        __builtin_amdgcn_global_load_lds((const unsigned*)(vg + ro_ + 32 * QKVP), (LAS unsigned*)(d_ + 24576), 16, 0, 0); } while (0)
    int n = qb, st = 3;
    MOBA_STAGE(0, n, st);
    asm volatile("s_waitcnt vmcnt(0)" ::: "memory");
    __syncthreads();
    int cur = 0;
    for (;;) {
        int nn = n, nst = st; bool has_next = true;
        if (n == qb) { if (st > 0) nst = st - 1; else { if (anywg == 0u) has_next = false; else { nn = __builtin_ctz(anywg); nst = 0; } } }
        else { if (st < 3) nst = st + 1; else { const unsigned rest = anywg & ~((2u << n) - 1u); if (rest == 0u) has_next = false; else { nn = __builtin_ctz(rest); nst = 0; } } }
        if (has_next) MOBA_STAGE(cur ^ 1, nn, nst);
        const bool own = (n == qb);
        const bool active = own ? (2 * st <= wave) : (((anymask >> (n & 31)) & 1u) != 0u);
        if (active) {
            LAS unsigned char* kl = lds + ATT_V_OFF + cur * 32768;
            const int dbase = t - (256 * n + 64 * st);
            const float lanebias = own ? nref : (((selmask >> (n & 31)) & 1u) ? nref : NEG);
            bf16x8 PA0, PA1, PB0, PB1;
#pragma unroll
            for (int tt = 0; tt < 2; ++tt) {
                bf16x8 kc[8];
#pragma unroll
                for (int s = 0; s < 8; ++s) kc[s] = *(const LAS bf16x8*)(kl + 8192 * tt + ((s & 1) ? ke1 : ke0) + 512 * (s >> 1));
                asm volatile("s_waitcnt lgkmcnt(0)" ::: "memory"); __builtin_amdgcn_sched_barrier(0);
                const f32x16 sacc = qk(kc, qf);
                const int db = dbase - 32 * tt;
                float x[16];
                if (own) {
#pragma unroll
                    for (int r = 0; r < 16; ++r) { const int dist = db - (8 * (r >> 2) + 4 * h + (r & 3)); const float lvv = lutL[dist < 0 ? 0 : dist];
                        const float xx = __builtin_fmaf(sacc[r], C1, lvv) + nref; x[r] = (dist >= 0) ? xx : NEG; }
                } else {
                    const LAS float* lp = lutL + (db - 4 * h);
#pragma unroll
                    for (int r = 0; r < 16; ++r) x[r] = __builtin_fmaf(sacc[r], C1, lp[-(8 * (r >> 2) + (r & 3))]) + lanebias;
                }
                if (tt == 0) softmax_fixed(x, l, PA0, PA1); else softmax_fixed(x, l, PB0, PB1);
            }
            pv(o, kl + 16384, PA0, PA1, lane);
            pv(o, kl + 24576, PB0, PB1, lane);
        }
        if (!has_next) break;
        asm volatile("s_waitcnt vmcnt(0)" ::: "memory");
        __syncthreads();
        n = nn; st = nst; cur ^= 1;
    }
#undef MOBA_STAGE
    l += __shfl_xor(l, 32);
    store_o(o, 1.0f / l, Ob + (size_t)(b * SEQ + t) * OP + hg * 128, lane);
}

__device__ __forceinline__ void dil_desc(int idx, int tb, int c4, int i, int& s0, int& stride, int& delta0, int& pat, int& aa) {
    if (idx < 5) { const int kt = 4 - idx; stride = 4; s0 = tb + c4 + 4 * (-128 + 32 * kt); delta0 = i + 128 - 32 * kt; pat = 0; aa = 0; }
    else if (idx < 13) { const int kt = idx - 5; stride = 1; s0 = tb - 128 + 32 * kt; delta0 = c4 + 4 * i + 128 - 32 * kt; pat = 1; aa = 0; }
    else { aa = (idx - 13) / 5; const int kt = (idx - 13) % 5; stride = 16; s0 = tb + c4 + 4 * aa + 16 * (-128 + 32 * kt); delta0 = (i >> 2) + 128 - 32 * kt; pat = 2; }
}
__device__ __forceinline__ void unit_dilated(const Args& a, int lyr, bf16_t* Ob, int OP, int b, int hd, int qb, LAS unsigned char* lds, int tid, int lane, int wave) {
    asm volatile("" : "+v"(lane));
    const bf16_t* qkv = (const bf16_t*)(a.ws + WS_QKV);
    LAS float* lut3 = (LAS float*)(lds + ATT_LUT_OFF);
    { const float* lutG = (const float*)(a.ws + WS_LUT) + (6 + hd) * 4096;

#pragma unroll
      for (int k_ = 0; k_ < 3; ++k_) { const int e = tid + k_ * NTHR; if (e >= 3 * 384) break; const int p = e / 384, d = e % 384 - 128; const int st = p == 0 ? 4 : (p == 1 ? 1 : 16); lut3[e] = (d >= 0 && d <= 128) ? lutG[st * d] : 0.f; } }
    __syncthreads();
    LAS unsigned char* vl = lds + ATT_V_OFF + wave * 8192;
    const int h = lane >> 5, i = lane & 31, t0 = qb * 256, tb = t0 + 128 * (wave >> 2), c4 = wave & 3, t = tb + c4 + 4 * i, hg = 10 + hd;
    const bf16_t* Kb = qkv + (size_t)b * SEQ * QKVP + 2048 + hg * 128; const bf16_t* Vb = Kb + 2048;
    bf16x8 qf[8]; load_q(qf, qkv + (size_t)(b * SEQ + t) * QKVP + hg * 128, lane);
    const float nref = -softmax_ref(a, lyr, 6 + hd, qf, lane);
    const unsigned dmax4 = (unsigned)((t >> 2) < 128 ? (t >> 2) : 128), dmax1 = (unsigned)(t < 128 ? t : 128), dmax16 = (unsigned)((t >> 4) < 128 ? (t >> 4) : 128);
    float l = 0.f; f32x16 o[4];
#pragma unroll
    for (int c = 0; c < 4; ++c) o[c] = (f32x16){0.f, 0.f, 0.f, 0.f, 0.f, 0.f, 0.f, 0.f, 0.f, 0.f, 0.f, 0.f, 0.f, 0.f, 0.f, 0.f};
    LAS unsigned char* kl = lds + DIL_K_OFF + wave * 8192;
    const int kc_ = (lane >> 2) & 7, kd_ = lane & 3;
#define DIL_KDMA(s0v, strv) do { _Pragma("unroll") for (int i_ = 0; i_ < 8; ++i_) { const int row_ = 8 * (i_ >> 1) + kc_; const int ch_ = 4 * (2 * (i_ & 1) + (lane >> 5)) + (kd_ ^ ((row_ >> 2) & 3)); \
        const int s_ = clamp_s((s0v) + (strv) * row_); \
        __builtin_amdgcn_global_load_lds((const unsigned*)(Kb + (size_t)s_ * QKVP + ch_ * 8), (LAS unsigned*)(kl + 1024 * i_), 16, 0, 0); } } while (0)
    const int r31 = lane & 31; const unsigned kx0 = (r31 >> 2) & 1, kx1 = (r31 >> 3) & 1;
    const unsigned kb_l = 2048u * (r31 >> 3) + 64u * (r31 & 7) + 16u * ((unsigned)h ^ kx0);
    const unsigned ke0 = kb_l + 32u * kx1, ke1 = kb_l + 32u * (kx1 ^ 1u);
    u32x4 vr[8];
    int s0, stride, delta0, pat, aa;
    dil_desc(0, tb, c4, i, s0, stride, delta0, pat, aa);
    DIL_KDMA(s0, stride); load_v(vr, Vb, s0, stride, lane);
    for (int idx = 0; idx < 33;) {
        asm volatile("s_waitcnt vmcnt(0)" ::: "memory");
        bf16x8 kc[8];
#pragma unroll
        for (int s = 0; s < 8; ++s) kc[s] = *(const LAS bf16x8*)(kl + ((s & 1) ? ke1 : ke0) + 512 * (s >> 1));
        asm volatile("s_waitcnt lgkmcnt(0)" ::: "memory"); __builtin_amdgcn_sched_barrier(0);
        int s0n = 0, stn = 1, d0n = 0, patn = 0, aan = 0, nidx = idx + 1;
#pragma unroll 1
        for (; nidx < 33; ++nidx) {
            int last;
            if (nidx < 5) last = tb + c4 + 4 * (-128 + 32 * (4 - nidx) + 31);
            else if (nidx < 13) last = tb - 128 + 32 * (nidx - 5) + 31;
            else last = tb + c4 + 4 * ((nidx - 13) / 5) + 16 * (-128 + 32 * ((nidx - 13) % 5) + 31);
            if (last >= 0) break; }
        const bool more = nidx < 33;
        if (more) { dil_desc(nidx, tb, c4, i, s0n, stn, d0n, patn, aan); DIL_KDMA(s0n, stn); }
        const f32x16 sacc = qk(kc, qf);
        stage_v(vl, vr, lane);
        if (more) load_v(vr, Vb, s0n, stn, lane);
        const unsigned dmax = pat == 0 ? dmax4 : (pat == 1 ? dmax1 : dmax16);
        const float lb = (pat == 2 && (i & 3) != aa) ? NEG : nref;
        const int dk = delta0 - 4 * h;
        const LAS float* lp = lut3 + pat * 384 + 128 + dk;
        float x[16];
#pragma unroll
        for (int r = 0; r < 16; ++r) { const float lvv = lp[-(8 * (r >> 2) + (r & 3))]; const float xx = __builtin_fmaf(sacc[r], C1, lvv) + lb;
            const unsigned delta = (unsigned)(dk - (8 * (r >> 2) + (r & 3))); x[r] = (delta <= dmax) ? xx : NEG; }
        bf16x8 P0, P1; softmax_fixed(x, l, P0, P1);
        pv(o, vl, P0, P1, lane);
        s0 = s0n; stride = stn; delta0 = d0n; pat = patn; aa = aan; idx = nidx;
    }
#undef DIL_KDMA
    l += __shfl_xor(l, 32);
    store_o(o, 1.0f / l, Ob + (size_t)(b * SEQ + t) * OP + hg * 128, lane);
}

__device__ __forceinline__ void unit_sb(const Args& a, bf16_t* Ob, int OP, int b, int ha, int qb, LAS unsigned char* lds, int tid, int lane, int wave) {
    asm volatile("" : "+v"(lane));
    const bf16_t* qkv = (const bf16_t*)(a.ws + WS_QKV);
    LAS unsigned char* vl = lds + ATT_V_OFF + wave * 8192;
    const int h = lane >> 5, t0 = qb * 256, tw = t0 + 32 * wave, t = tw + (lane & 31);
    const bf16_t* Kb = qkv + (size_t)b * SEQ * QKVP + 2048 + ha * 128; const bf16_t* Vb = Kb + 2048;
    bf16x8 qf[8]; load_q(qf, qkv + (size_t)(b * SEQ + t) * QKVP + ha * 128, lane);
    f32x16 o[4];
#pragma unroll
    for (int c = 0; c < 4; ++c) o[c] = (f32x16){0.f, 0.f, 0.f, 0.f, 0.f, 0.f, 0.f, 0.f, 0.f, 0.f, 0.f, 0.f, 0.f, 0.f, 0.f, 0.f};
    float R = 0.f;
    bf16x8 kc[8];
    int kt = tw >> 5;
    load_k(kc, Kb, 32 * kt, 1, lane);
    for (;;) {
        u32x4 vr[8]; load_v(vr, Vb, 32 * kt, 1, lane);
        const f32x16 sacc = qk(kc, qf);
        const bool more = kt > 0;
        if (more) load_k(kc, Kb, 32 * (kt - 1), 1, lane);
        stage_v(vl, vr, lane);
        const int dbase = t - 32 * kt;
        float lb[16], g[4], gp[4];
#pragma unroll
        for (int i = 0; i < 4; ++i) { g[i] = 0.f;
#pragma unroll
            for (int j = 0; j < 4; ++j) { const int r = 4 * i + j; const int kap = 8 * i + 4 * h + j; const bool past = kap < dbase;
                const float z = sacc[r] * SCALE; const float sp = __logf(1.0f + __expf(-fabsf(z)));
                lb[r] = fminf(z, 0.f) - sp; g[i] += past ? (lb[r] - z) : 0.f; }
            gp[i] = __shfl_xor(g[i], 32); }
        float sg[4]; sg[3] = 0.f; sg[2] = g[3] + gp[3]; sg[1] = sg[2] + g[2] + gp[2]; sg[0] = sg[1] + g[1] + gp[1];
        const float tot = sg[0] + g[0] + gp[0];
#pragma unroll
        for (int i = 0; i < 4; ++i) { const float basei = sg[i] + R + (h == 0 ? gp[i] : 0.f);
            float suf = 0.f;
#pragma unroll
            for (int j = 3; j >= 0; --j) { const int r = 4 * i + j; const int kap = 8 * i + 4 * h + j; const bool past = kap < dbase;
                const float l1 = past ? (lb[r] - sacc[r] * SCALE) : 0.f;
                lb[r] = past ? __expf(lb[r] + suf + basei) : 0.f; suf += l1; } }
        R += tot;
        bf16x8 P0, P1; pack_p(lb, P0, P1);
        pv(o, vl, P0, P1, lane);
        if (!more || __all(R < -110.0f)) break;
        --kt;
    }
    store_o(o, 1.0f, Ob + (size_t)(b * SEQ + t) * OP + ha * 128, lane);
}

__device__ __forceinline__ void phase_attention(const Args& a, int l, int rep, LAS unsigned char* lds, int tid, int lane, int wave) {
    unsigned* ctr0 = (unsigned*)(a.ws + WS_CTR) + (l + 2 * rep) * 64;
    bf16_t* Ob = l == 0 ? (bf16_t*)a.out : (bf16_t*)(a.ws + WS_QKV); const int OP = l == 0 ? DM : QKVP;
    volatile LAS unsigned* misc = (volatile LAS unsigned*)(lds + MISC_OFF);
    int xq = (int)((unsigned)__builtin_amdgcn_s_getreg((3 << 11) | 20) & 7u), left = 8;
    for (;;) {
        __syncthreads();
        if (tid == 0) misc[0] = atomicAdd(ctr0 + xq * 8, 1u);
        __syncthreads();
        const int j = (int)misc[0];
        if (j >= 128) { if (--left == 0) break; xq = (xq + 1) & 7; continue; }
        if (j < 48) { const int qb = 15 - j / 3, bh = 3 * xq + j % 3; unit_moba(a, l, Ob, OP, bh / 6, bh % 6, qb, lds, tid, lane, wave); }
        else if (j < 96) { const int jj = j - 48, qb = jj % 16, bh = 3 * xq + jj / 16; unit_dilated(a, l, Ob, OP, bh / 6, bh % 6, qb, lds, tid, lane, wave); }
        else { const int jj = j - 96, qb = 15 - jj / 2, bh = 2 * xq + jj % 2; unit_sb(a, Ob, OP, bh / 4, bh % 4, qb, lds, tid, lane, wave); }
    }
}
}

__device__ __forceinline__ void grid_barrier(unsigned* bar, unsigned k) {
    asm volatile("s_waitcnt vmcnt(0) lgkmcnt(0)" ::: "memory");
    __syncthreads();
    if (threadIdx.x == 0) {
        const unsigned G = gridDim.x, g = blockIdx.x & 7u, nloc = (G - g + 7u) >> 3, ngrp = G < 8u ? G : 8u;
        __builtin_amdgcn_fence(__ATOMIC_RELEASE, "agent");
        asm volatile("s_waitcnt vmcnt(0)" ::: "memory");
        const unsigned old = __hip_atomic_fetch_add(bar + 64 * g, 1u, __ATOMIC_RELAXED, __HIP_MEMORY_SCOPE_AGENT);
        if (old + 1u == nloc * k) __hip_atomic_fetch_add(bar + 512, 1u, __ATOMIC_RELAXED, __HIP_MEMORY_SCOPE_AGENT);
        unsigned spins = 0;
        while (__hip_atomic_load(bar + 512, __ATOMIC_RELAXED, __HIP_MEMORY_SCOPE_AGENT) < ngrp * k) { __builtin_amdgcn_s_sleep(2); if (++spins > (1u << 24)) break; }
        __builtin_amdgcn_fence(__ATOMIC_ACQUIRE, "agent");
        asm volatile("s_waitcnt vmcnt(0)" ::: "memory");
    }
    __syncthreads();
}

__global__ void __launch_bounds__(NTHR, 2) hybrid_fwd(Args a_) {
    __shared__ __attribute__((aligned(16))) unsigned char lds_raw[LDS_BYTES];
    LAS unsigned char* lds = (LAS unsigned char*)lds_raw;
    const int ph_lo = a_.ph_lo, ph_hi = a_.ph_hi;
    int n_grid = 0;
    for (int ph = ph_lo; ph < ph_hi; ++ph) {
        {
        constexpr int rep = 0;
        int tid = threadIdx.x; asm volatile("" : "+v"(tid));
        const int lane = tid & 63, wave = __builtin_amdgcn_readfirstlane(tid >> 6);
        const __attribute__((address_space(4))) Args* ap = (const __attribute__((address_space(4))) Args*)__builtin_amdgcn_kernarg_segment_ptr(); asm volatile("" : "+s"(ap));
        Args a; a.x = ap->x; a.g_mix = ap->g_mix; a.w_in = ap->w_in; a.q_gain = ap->q_gain; a.k_gain = ap->k_gain; a.w_branch = ap->w_branch; a.w_out = ap->w_out;
        a.g_ffn = ap->g_ffn; a.w_gu = ap->w_gu; a.w_down = ap->w_down; a.rel_bias = ap->rel_bias; a.out = ap->out; a.ws = ap->ws; a.ph_lo = 0; a.ph_hi = 0;
        unsigned char* ws = a.ws;
        const int G = gridDim.x, cidx = blockIdx.x;
        float* ss = (float*)(ws + WS_SS);
        bf16_t* xb = (bf16_t*)(ws + WS_XB); bf16_t* qkv = (bf16_t*)(ws + WS_QKV); bf16_t* gates = (bf16_t*)(ws + WS_GATES);
        bf16_t* ob = qkv; bf16_t* merged = qkv + 2048; bf16_t* act = qkv;
        if (ph == 0) phase_prologue(a, lds, tid, lane, wave);
        else {
            const int l = (ph - 1) / 7, k = (ph - 1) % 7;
            if (k == 0) {
                pg8::Gemm g{xb, (const bf16_t*)(ws + WS_WIN) + (size_t)l * NIN * DM, DM, DM, M, NIN, DM}; pg8::StaticOrder S; S.init(M, NIN, G, cidx);
                pg8::EpiIn E{qkv, gates, ss + (size_t)(2 * l) * M, a.q_gain + (size_t)l * 12 * 128, a.k_gain + (size_t)l * 12 * 128, (float*)(ws + WS_KM), lds + 132096};
                pg8::gemm_phase<pg8::EpiIn, pg8::StaticOrder>(lds, g, S, E, tid);
            } else if (k == 1) {   }
            else if (k == 2) att::phase_attention(a, l, rep, lds, tid, lane, wave);
            else if (k == 3) {
                const bf16_t* wbt = (const bf16_t*)(ws + WS_WBR) + (size_t)l * DM * DM;
                pg8::Gemm g{(l == 0 ? (const bf16_t*)a.out : ob), wbt, l == 0 ? DM : QKVP, DM, M, DM, DM}; pg8::BranchOrder S; S.so.init(M, DM, G, cidx);
                pg8::EpiBranch E{merged, gates};
                pg8::gemm_phase<pg8::EpiBranch, pg8::BranchOrder>(lds, g, S, E, tid);
            } else if (k == 4 || k == 6) {
                const bool dn = (k == 6);
                pg8::Gemm g{dn ? act : merged, dn ? (const bf16_t*)(ws + WS_WDN) + (size_t)l * DM * DFF : (const bf16_t*)(ws + WS_WOUT) + (size_t)l * DM * DM,
                            dn ? DFF : QKVP, dn ? DFF : DM, M, DM, dn ? DFF : DM};
                pg8::StaticOrder S; S.init(M, DM, G, cidx);
                const bool first = (l == 0 && !dn), lastp = dn && (l == 1);
                pg8::EpiResid E{first ? a.x : nullptr, first ? nullptr : xb, lastp ? a.out : nullptr, lastp ? nullptr : xb, lastp ? nullptr : ss + (size_t)(2 * l + (dn ? 2 : 1)) * M};
                pg8::gemm_phase<pg8::EpiResid, pg8::StaticOrder>(lds, g, S, E, tid);
            } else {
                pg8::Gemm g{xb, (const bf16_t*)(ws + WS_WGU) + (size_t)l * NGU * DM, DM, DM, M, NGU, DM}; pg8::StaticOrder S; S.init(M, NGU, G, cidx);
                pg8::EpiGU E{act, ss + (size_t)(2 * l + 1) * M};
                pg8::gemm_phase<pg8::EpiGU, pg8::StaticOrder>(lds, g, S, E, tid);
            }
        }
        }
        if (ph + 1 < ph_hi) {
            if (ph == ph_lo) cg::this_grid().sync();
            else if ((ph - 1) % 7 != 0) { ++n_grid; grid_barrier((unsigned*)(a_.ws + WS_CTR) + 256, (unsigned)n_grid); }
        }
    }
}

__global__ void fill_const(float* o, int n, float v) { for (int i = blockIdx.x * blockDim.x + threadIdx.x; i < n; i += gridDim.x * blockDim.x) o[i] = v; }
extern "C" void kernel_launch(void* const* d_in, const int* in_sizes, int n_in, void* d_out, int out_size, void* d_ws, size_t ws_size, hipStream_t stream) {
    static int grid = 0;
    if (grid == 0) {
        if (n_in != 11 || in_sizes[0] != M * DM || out_size != M * DM || ws_size < WS_END) { fprintf(stderr, "kernel_launch: unexpected shapes / workspace (n_in %d, ws %zu); nothing launched\n", n_in, ws_size); grid = -1; return; }
        int dev = 0, cus = 0, per_cu = 0;
        if (hipGetDevice(&dev) != hipSuccess || hipDeviceGetAttribute(&cus, hipDeviceAttributeMultiprocessorCount, dev) != hipSuccess || cus < 1) cus = 256;
        if (hipOccupancyMaxActiveBlocksPerMultiprocessor(&per_cu, hybrid_fwd, NTHR, 0) != hipSuccess || per_cu < 1) per_cu = 1;
        (void)hipGetLastError();
        grid = cus * per_cu;
    }
    if (grid < 0) return;
    Args a{};
    a.x = (const float*)d_in[0]; a.g_mix = (const float*)d_in[1]; a.w_in = (const float*)d_in[2]; a.q_gain = (const float*)d_in[3]; a.k_gain = (const float*)d_in[4];
    a.w_branch = (const float*)d_in[5]; a.w_out = (const float*)d_in[6]; a.g_ffn = (const float*)d_in[7]; a.w_gu = (const float*)d_in[8]; a.w_down = (const float*)d_in[9];
    a.rel_bias = (const float*)d_in[10]; a.out = (float*)d_out; a.ws = (unsigned char*)d_ws;
#if MK_COOP
    a.ph_lo = 0; a.ph_hi = MK_PH_END;
    void* args[] = {&a};
    hipError_t e = hipLaunchCooperativeKernel((void*)hybrid_fwd, dim3(grid), dim3(NTHR), args, 0, stream);
    if (e != hipSuccess) fprintf(stderr, "kernel_launch: cooperative launch failed: %s (grid %d)\n", hipGetErrorString(e), grid);
#else
    for (int ph = 0; ph < MK_PH_END; ++ph) { a.ph_lo = ph; a.ph_hi = ph + 1; hipLaunchKernelGGL(hybrid_fwd, dim3(grid), dim3(NTHR), 0, stream, a); }
#endif
}
```

```cpp
#include <hip/hip_runtime.h>
#include <hip/hip_cooperative_groups.h>
#include <cstdio>
#include <cstdint>
namespace cg = cooperative_groups;

#ifndef MK_DUP_PRO
#define MK_DUP_PRO 1
#define MK_DUP_BIG 1
#define MK_DUP_BR 1
#define MK_DUP_ATT 1
#define MK_DUP_SYNC 1
#endif
#ifndef MK_PH_END
#define MK_PH_END 15
#endif
#ifndef MK_COOP
#define MK_COOP 1
#endif

namespace pg8 {
#define PG8_LAS __attribute__((address_space(3)))
typedef unsigned short bf16_t;
typedef short bf16x8 __attribute__((ext_vector_type(8)));
typedef float f32x4 __attribute__((ext_vector_type(4)));
typedef unsigned u32x4 __attribute__((ext_vector_type(4)));
typedef unsigned u32x2 __attribute__((ext_vector_type(2)));
constexpr int BM = 256, BK = 64, HALF = 128, HTB = HALF * BK * 2, STAGE_BYTES = 8 * HTB, NXCD = 8, WGM = 8;

__host__ __device__ __forceinline__ int lds_byte(int r, int c) { const int st = (r >> 4) * 2 + (c >> 5), rr = r & 15, cc = c & 31, ob = rr * 64 + cc * 2; return st * 1024 + (ob ^ (((ob >> 9) & 1) << 5)); }
__host__ __device__ __forceinline__ void stage_rc(int b, int& R, int& C) { const int st = b / 1024, sb = b % 1024, swz = sb ^ (((sb >> 9) & 1) << 5); R = (st >> 1) * 16 + swz / 64; C = (st & 1) * 32 + (swz % 64) / 2; }
__host__ __device__ __forceinline__ int perm32(int rho) { const int n = rho >> 4, i = rho & 15; return 8 * (i >> 2) + 4 * n + (i & 3); }

struct Unit { int pm, pn, seg; };
struct Gemm { const bf16_t* A; const bf16_t* Bt; int lda, ldb, M, N, K; };

struct StaticOrder {
    int nM, nN, nwg, G, c;
    __host__ __device__ void init(int M, int N, int G_, int c_) { nM = M / BM; nN = N / BM; nwg = nM * nN; G = G_; c = c_; }
    __host__ __device__ bool next(int i, Unit& u) const {
        const int L = i * G + c; if (L >= nwg) return false;
        int wgid = L; { const int q = nwg / NXCD, r = nwg % NXCD, xcd = wgid % NXCD, off = wgid / NXCD; wgid = (xcd < r ? xcd * (q + 1) : r * (q + 1) + (xcd - r) * q) + off; }
        const int nig = WGM * nN, gid = wgid / nig, fm = gid * WGM, gsz = (nM - fm) < WGM ? (nM - fm) : WGM;
        u.pm = fm + ((wgid % nig) % gsz); u.pn = (wgid % nig) / gsz; u.seg = 0; return true;
    }
    __device__ __forceinline__ int koff(const Unit&) const { return 0; }
    __device__ __forceinline__ int nt(const Unit&, int K) const { return K / BK; }
    __device__ __forceinline__ bool keep_acc(const Unit&) const { return false; }
};
struct BranchOrder {
    StaticOrder so;
    __device__ __forceinline__ bool next(int i, Unit& u) const { if (!so.next(i / 3, u)) return false; u.seg = i % 3; return true; }
    __device__ __forceinline__ int koff(const Unit& u) const { return u.seg == 0 ? 0 : (u.seg == 1 ? 512 : 1280); }
    __device__ __forceinline__ int nt(const Unit& u, int) const { return u.seg == 0 ? 8 : 12; }
    __device__ __forceinline__ bool keep_acc(const Unit& u) const { return u.seg < 2; }
};

typedef float f32x2c_t __attribute__((ext_vector_type(2))); typedef __bf16 bf16x2c_t __attribute__((ext_vector_type(2)));
__device__ __forceinline__ unsigned cvt_pk_bf16(float lo, float hi) { f32x2c_t v = {lo, hi}; bf16x2c_t b = __builtin_convertvector(v, bf16x2c_t); return __builtin_bit_cast(unsigned, b); }
__device__ __forceinline__ float bf_lo(unsigned w) { return __uint_as_float(w << 16); }
__device__ __forceinline__ float bf_hi(unsigned w) { return __uint_as_float(w & 0xffff0000u); }
__device__ __forceinline__ float sigmoidf_(float v) { return __builtin_amdgcn_rcpf(1.0f + __builtin_amdgcn_exp2f(v * -1.4426950408889634f)); }


struct EpiIn {
    static constexpr bool PERM = true;
    bf16_t* qkv; bf16_t* gates; const float* ss; const float* qg; const float* kg; float* kmean; PG8_LAS unsigned char* xl;
    __device__ __forceinline__ void operator()(const f32x4 (&acc)[2][2][4][2], const Unit& u, int wr, int wc, int fr, int fq) const {
        const int row0 = u.pm * BM + wr * 64 + fr; const bool isg = u.pn >= 24;
        bf16_t* base = isg ? gates : qkv; const int col0 = (isg ? u.pn - 24 : u.pn) * BM + wc * 32 + 8 * fq;
        float rsv[2][4];
#pragma unroll
        for (int ai = 0; ai < 2; ++ai)
#pragma unroll
            for (int m = 0; m < 4; ++m) rsv[ai][m] = ss[row0 + ai * HALF + m * 16];
#pragma unroll
        for (int ai = 0; ai < 2; ++ai)
#pragma unroll
            for (int m = 0; m < 4; ++m) rsv[ai][m] = rsqrtf(rsv[ai][m] * (1.0f / 2048.0f) + 1e-6f);
        const int sec = u.pn >> 3, hp = u.pn & 7; const bool soft = (u.pn < 16) && (hp >= 2);
        if (!soft) {
#pragma unroll
            for (int ai = 0; ai < 2; ++ai)
#pragma unroll
                for (int m = 0; m < 4; ++m) { const int row = row0 + ai * HALF + m * 16; const float rs = rsv[ai][m];
                    bf16_t* rowp = base + (size_t)row * 6144 + col0;
#pragma unroll
                    for (int bj = 0; bj < 2; ++bj) { f32x4 v0 = acc[ai][bj][m][0] * rs, v1 = acc[ai][bj][m][1] * rs;
                        if (isg) { v0 = (f32x4){sigmoidf_(v0[0]), sigmoidf_(v0[1]), sigmoidf_(v0[2]), sigmoidf_(v0[3])}; v1 = (f32x4){sigmoidf_(v1[0]), sigmoidf_(v1[1]), sigmoidf_(v1[2]), sigmoidf_(v1[3])}; }
                        u32x4 w; w.x = cvt_pk_bf16(v0[0], v0[1]); w.y = cvt_pk_bf16(v0[2], v0[3]); w.z = cvt_pk_bf16(v1[0], v1[1]); w.w = cvt_pk_bf16(v1[2], v1[3]);
                        *(u32x4*)(rowp + bj * HALF) = w; } }
            return;
        }
        PG8_LAS float* part = (PG8_LAS float*)xl; PG8_LAS float* colsum = (PG8_LAS float*)(xl + 8192);
#pragma unroll
        for (int ai = 0; ai < 2; ++ai)
#pragma unroll
            for (int m = 0; m < 4; ++m)
#pragma unroll
                for (int bj = 0; bj < 2; ++bj) { const f32x4 a0 = acc[ai][bj][m][0] * rsv[ai][m], a1 = acc[ai][bj][m][1] * rsv[ai][m];
                    float s = (a0[0] * a0[0] + a0[1] * a0[1]) + (a0[2] * a0[2] + a0[3] * a0[3]) + (a1[0] * a1[0] + a1[1] * a1[1]) + (a1[2] * a1[2] + a1[3] * a1[3]);
                    s += __shfl_xor(s, 16); s += __shfl_xor(s, 32);
                    if (fq == 0) part[((ai * HALF + wr * 64 + m * 16 + fr) * 2 + bj) * 4 + wc] = s; }
        asm volatile("s_waitcnt lgkmcnt(0)" ::: "memory"); __builtin_amdgcn_s_barrier(); asm volatile("" ::: "memory");
        const bool km = (sec == 1) && (hp <= 4);
        const float* gbase = (sec ? kg : qg) + (2 * hp - 4) * 128 + wc * 32 + 8 * fq;
        float gn[2][8], cs[2][8];
#pragma unroll
        for (int bj = 0; bj < 2; ++bj)
#pragma unroll
            for (int e = 0; e < 8; ++e) { gn[bj][e] = gbase[bj * 128 + e]; cs[bj][e] = 0.f; }
#pragma unroll
        for (int ai = 0; ai < 2; ++ai)
#pragma unroll
            for (int m = 0; m < 4; ++m) { const int rl = ai * HALF + wr * 64 + m * 16 + fr; bf16_t* rowp = base + (size_t)(u.pm * BM + rl) * 6144 + col0;
#pragma unroll
                for (int bj = 0; bj < 2; ++bj) { const f32x4 p = *(const PG8_LAS f32x4*)(part + (rl * 2 + bj) * 4);
                    const float sc = rsv[ai][m] * rsqrtf(((p[0] + p[1]) + (p[2] + p[3])) * (1.0f / 128.0f) + 1e-6f);
                    float r[8];
#pragma unroll
                    for (int e = 0; e < 4; ++e) { r[e] = acc[ai][bj][m][0][e] * sc * gn[bj][e]; r[4 + e] = acc[ai][bj][m][1][e] * sc * gn[bj][4 + e]; }
#pragma unroll
                    for (int e = 0; e < 8; ++e) cs[bj][e] += r[e];
                    u32x4 w; w.x = cvt_pk_bf16(r[0], r[1]); w.y = cvt_pk_bf16(r[2], r[3]); w.z = cvt_pk_bf16(r[4], r[5]); w.w = cvt_pk_bf16(r[6], r[7]);
                    *(u32x4*)(rowp + bj * HALF) = w; } }
        if (km) {
#pragma unroll
            for (int bj = 0; bj < 2; ++bj)
#pragma unroll
                for (int e = 0; e < 8; ++e) { float c = cs[bj][e]; c += __shfl_xor(c, 1); c += __shfl_xor(c, 2); c += __shfl_xor(c, 4); c += __shfl_xor(c, 8);
                    if (fr == 0) colsum[wr * 256 + bj * 128 + wc * 32 + 8 * fq + e] = c; }
            asm volatile("s_waitcnt lgkmcnt(0)" ::: "memory"); __builtin_amdgcn_s_barrier(); asm volatile("" ::: "memory");
            if (wr == 0) { const int c = wc * 64 + fq * 16 + fr;
                const int hs = 2 * hp - 4 + (c >> 7);
                kmean[((size_t)((u.pm >> 4) * 6 + hs) * 16 + (u.pm & 15)) * 128 + (c & 127)] = (colsum[c] + colsum[256 + c]) * (1.0f / 256.0f); }
        }
    }
};
struct EpiGU {
    static constexpr bool PERM = true;
    bf16_t* act; const float* ss;
    __device__ __forceinline__ void operator()(const f32x4 (&acc)[2][2][4][2], const Unit& u, int wr, int wc, int fr, int fq) const {
        const int row0 = u.pm * BM + wr * 64 + fr; const int col0 = u.pn * HALF + wc * 32 + 8 * fq;
        float ssv[2][4];
#pragma unroll
        for (int ai = 0; ai < 2; ++ai)
#pragma unroll
            for (int m = 0; m < 4; ++m) ssv[ai][m] = ss[row0 + ai * HALF + m * 16];
#pragma unroll
        for (int ai = 0; ai < 2; ++ai)
#pragma unroll
            for (int m = 0; m < 4; ++m) { const int row = row0 + ai * HALF + m * 16; const float rs = rsqrtf(ssv[ai][m] * (1.0f / 2048.0f) + 1e-6f);
                float r[8];
#pragma unroll
                for (int n = 0; n < 2; ++n)
#pragma unroll
                    for (int e = 0; e < 4; ++e) { const float g = acc[ai][0][m][n][e] * rs, up = acc[ai][1][m][n][e] * rs; r[n * 4 + e] = g * sigmoidf_(g) * up; }
                u32x4 w; w.x = cvt_pk_bf16(r[0], r[1]); w.y = cvt_pk_bf16(r[2], r[3]); w.z = cvt_pk_bf16(r[4], r[5]); w.w = cvt_pk_bf16(r[6], r[7]);
                *(u32x4*)(act + (size_t)row * 5632 + col0) = w; }
    }
};
struct EpiBranch {
    static constexpr bool PERM = true;
    bf16_t* merged; const bf16_t* gates;
    __device__ __forceinline__ void rescale(f32x4 (&acc)[2][2][4][2], const Unit& u, int wr, int wc, int fr, int fq, int from) const {
        const int row0 = u.pm * BM + wr * 64 + fr;
        const int col0 = u.pn * BM + wc * 32 + 8 * fq + from * 2048; const float nlo = from ? 1e-30f : 0.f;
#pragma unroll
        for (int aq = 0; aq < 4; ++aq) { const int ai = aq >> 1, m0 = 2 * (aq & 1);
            u32x4 gf[2][2], gt[2][2];
#pragma unroll
            for (int mm = 0; mm < 2; ++mm)
#pragma unroll
                for (int bj = 0; bj < 2; ++bj) { const unsigned off_ = (unsigned)((row0 + ai * HALF + (m0 + mm) * 16) * 6144 + col0 + bj * HALF) * 2u;
                    gf[mm][bj] = *(const u32x4*)((const char*)gates + off_); gt[mm][bj] = *(const u32x4*)((const char*)gates + off_ + 4096u); }
#pragma unroll
            for (int mm = 0; mm < 2; ++mm)
#pragma unroll
                for (int bj = 0; bj < 2; ++bj) { const u32x4 a_ = gf[mm][bj], b_ = gt[mm][bj]; const int m = m0 + mm;
                    f32x4 r0, r1;
                    r0[0] = fmaxf(bf_lo(a_.x), nlo) * __builtin_amdgcn_rcpf(fmaxf(bf_lo(b_.x), 1e-30f)); r0[1] = fmaxf(bf_hi(a_.x), nlo) * __builtin_amdgcn_rcpf(fmaxf(bf_hi(b_.x), 1e-30f));
                    r0[2] = fmaxf(bf_lo(a_.y), nlo) * __builtin_amdgcn_rcpf(fmaxf(bf_lo(b_.y), 1e-30f)); r0[3] = fmaxf(bf_hi(a_.y), nlo) * __builtin_amdgcn_rcpf(fmaxf(bf_hi(b_.y), 1e-30f));
                    r1[0] = fmaxf(bf_lo(a_.z), nlo) * __builtin_amdgcn_rcpf(fmaxf(bf_lo(b_.z), 1e-30f)); r1[1] = fmaxf(bf_hi(a_.z), nlo) * __builtin_amdgcn_rcpf(fmaxf(bf_hi(b_.z), 1e-30f));
                    r1[2] = fmaxf(bf_lo(a_.w), nlo) * __builtin_amdgcn_rcpf(fmaxf(bf_lo(b_.w), 1e-30f)); r1[3] = fmaxf(bf_hi(a_.w), nlo) * __builtin_amdgcn_rcpf(fmaxf(bf_hi(b_.w), 1e-30f));
                    acc[ai][bj][m][0] = acc[ai][bj][m][0] * r0; acc[ai][bj][m][1] = acc[ai][bj][m][1] * r1; }
            asm volatile("" ::: "memory");
        }
    }
    __device__ __forceinline__ void operator()(f32x4 (&acc)[2][2][4][2], const Unit& u, int wr, int wc, int fr, int fq) const {
        if (u.seg < 2) { rescale(acc, u, wr, wc, fr, fq, u.seg); return; }
        const int row0 = u.pm * BM + wr * 64 + fr; const int col0 = u.pn * BM + wc * 32 + 8 * fq;
#pragma unroll
        for (int aq = 0; aq < 4; ++aq) { const int ai = aq >> 1, m0 = 2 * (aq & 1);
            u32x4 gw[2][2];
#pragma unroll
            for (int mm = 0; mm < 2; ++mm)
#pragma unroll
                for (int bj = 0; bj < 2; ++bj) gw[mm][bj] = *(const u32x4*)(gates + (size_t)(row0 + ai * HALF + (m0 + mm) * 16) * 6144 + 4096 + col0 + bj * HALF);
#pragma unroll
            for (int mm = 0; mm < 2; ++mm)
#pragma unroll
                for (int bj = 0; bj < 2; ++bj) { const int m = m0 + mm; const int row = row0 + ai * HALF + m * 16, col = col0 + bj * HALF; const u32x4 g_ = gw[mm][bj];
                    const float c0 = fmaxf(bf_lo(g_.x), 1e-30f), c1 = fmaxf(bf_hi(g_.x), 1e-30f), c2 = fmaxf(bf_lo(g_.y), 1e-30f), c3 = fmaxf(bf_hi(g_.y), 1e-30f);
                    const float c4 = fmaxf(bf_lo(g_.z), 1e-30f), c5 = fmaxf(bf_hi(g_.z), 1e-30f), c6 = fmaxf(bf_lo(g_.w), 1e-30f), c7 = fmaxf(bf_hi(g_.w), 1e-30f);
                    u32x4 w; w.x = cvt_pk_bf16(acc[ai][bj][m][0][0] * c0, acc[ai][bj][m][0][1] * c1); w.y = cvt_pk_bf16(acc[ai][bj][m][0][2] * c2, acc[ai][bj][m][0][3] * c3);
                    w.z = cvt_pk_bf16(acc[ai][bj][m][1][0] * c4, acc[ai][bj][m][1][1] * c5); w.w = cvt_pk_bf16(acc[ai][bj][m][1][2] * c6, acc[ai][bj][m][1][3] * c7);
                    *(u32x4*)(merged + (size_t)row * 6144 + col) = w; }
            asm volatile("" ::: "memory");
        }
    }
};
struct EpiResid {
    static constexpr bool PERM = true;
    const float* basef; const bf16_t* baseb; float* out; bf16_t* xb; float* ss;
    __device__ __forceinline__ void operator()(const f32x4 (&acc)[2][2][4][2], const Unit& u, int wr, int wc, int fr, int fq) const {
        const int row0 = u.pm * BM + wr * 64 + fr; const int col0 = u.pn * BM + wc * 32 + 8 * fq;
#pragma unroll
        for (int aq = 0; aq < 4; ++aq) { const int ai = aq >> 1, m0 = 2 * (aq & 1);
            f32x4 bv[2][2][2];
            if (basef) {
#pragma unroll
                for (int mm = 0; mm < 2; ++mm)
#pragma unroll
                    for (int bj = 0; bj < 2; ++bj) { const size_t off = (size_t)(row0 + ai * HALF + (m0 + mm) * 16) * 2048 + col0 + bj * HALF;
                        bv[mm][bj][0] = *(const f32x4*)(basef + off); bv[mm][bj][1] = *(const f32x4*)(basef + off + 4); }
            } else {
                u32x4 bw[2][2];
#pragma unroll
                for (int mm = 0; mm < 2; ++mm)
#pragma unroll
                    for (int bj = 0; bj < 2; ++bj) bw[mm][bj] = *(const u32x4*)(baseb + (size_t)(row0 + ai * HALF + (m0 + mm) * 16) * 2048 + col0 + bj * HALF);
#pragma unroll
                for (int mm = 0; mm < 2; ++mm)
#pragma unroll
                    for (int bj = 0; bj < 2; ++bj) { const u32x4 w_ = bw[mm][bj];
                        bv[mm][bj][0] = (f32x4){bf_lo(w_.x), bf_hi(w_.x), bf_lo(w_.y), bf_hi(w_.y)}; bv[mm][bj][1] = (f32x4){bf_lo(w_.z), bf_hi(w_.z), bf_lo(w_.w), bf_hi(w_.w)}; }
            }
#pragma unroll
            for (int mm = 0; mm < 2; ++mm) { const int m = m0 + mm; const int row = row0 + ai * HALF + m * 16; float sq = 0.f;
#pragma unroll
                for (int bj = 0; bj < 2; ++bj) { const size_t off = (size_t)row * 2048 + col0 + bj * HALF;
                    const f32x4 o0 = bv[mm][bj][0] + acc[ai][bj][m][0], o1 = bv[mm][bj][1] + acc[ai][bj][m][1];
                    if (out) { *(f32x4*)(out + off) = o0; *(f32x4*)(out + off + 4) = o1; }
                    sq += (o0[0] * o0[0] + o0[1] * o0[1]) + (o0[2] * o0[2] + o0[3] * o0[3]) + (o1[0] * o1[0] + o1[1] * o1[1]) + (o1[2] * o1[2] + o1[3] * o1[3]);
                    if (xb) { u32x4 w; w.x = cvt_pk_bf16(o0[0], o0[1]); w.y = cvt_pk_bf16(o0[2], o0[3]); w.z = cvt_pk_bf16(o1[0], o1[1]); w.w = cvt_pk_bf16(o1[2], o1[3]); *(u32x4*)(xb + off) = w; } }
                if (ss) { sq += __shfl_xor(sq, 16); sq += __shfl_xor(sq, 32); if (fq == 0) atomicAdd(ss + row, sq); } }
            asm volatile("" ::: "memory");
        }
    }
};

template <class Epi, class Sched>
__device__ __forceinline__ void gemm_phase(PG8_LAS unsigned char* lds, const Gemm g, const Sched& S, const Epi& E, const int tid) {
    const int wid = __builtin_amdgcn_readfirstlane(tid >> 6), lane = tid & 63, wr = wid >> 2, wc = wid & 3, fr = lane & 15, fq = lane >> 4;
    unsigned voffA[2], voffB[2];
#pragma unroll
    for (int i = 0; i < 2; ++i) { int R, C; stage_rc(tid * 16 + i * 8192, R, C); const int Rb = Epi::PERM ? ((R & ~31) + perm32(R & 31)) : R;
        voffA[i] = (unsigned)(R * g.lda + C) * 2u; voffB[i] = (unsigned)(Rb * g.ldb + C) * 2u; }
    const size_t kstep = (size_t)(BK * 2);
    const size_t hstepA = (size_t)HALF * g.lda * 2, hstepB = (size_t)HALF * g.ldb * 2;
    const size_t tstepA = 2 * hstepA, tstepB = 2 * hstepB;
    const unsigned ldsw = (unsigned)wid * 1024u;
    const int aoff = lds_byte(wr * 64 + fr, fq * 8), boff = lds_byte(wc * 32 + fr, fq * 8);
#define PG8_SA(b, h) (((b) * 2 + (h)) * HTB)
#define PG8_SB(b, h) ((4 + (b) * 2 + (h)) * HTB)
#define PG8_STAGE(bufoff, gbase, voff) do { _Pragma("unroll") for (int _i = 0; _i < 2; ++_i) \
        __builtin_amdgcn_global_load_lds((const unsigned*)((const char*)(gbase) + (voff)[_i]), (PG8_LAS unsigned*)(lds + (bufoff) + ldsw + _i * 8192), 16, 0, 0); } while (0)
#define PG8_LDA(dst, b, h) do { _Pragma("unroll") for (int m = 0; m < 4; ++m) _Pragma("unroll") for (int k = 0; k < 2; ++k) dst[m][k] = *(const PG8_LAS bf16x8*)(lds + PG8_SA(b, h) + aoff + m * 2048 + k * 1024); } while (0)
#define PG8_LDB(dst, b, h) do { _Pragma("unroll") for (int n = 0; n < 2; ++n) _Pragma("unroll") for (int k = 0; k < 2; ++k) dst[n][k] = *(const PG8_LAS bf16x8*)(lds + PG8_SB(b, h) + boff + n * 2048 + k * 1024); } while (0)
#define PG8_MMA(ai, bj, At, Bt) do { __builtin_amdgcn_s_setprio(1); _Pragma("unroll") for (int m = 0; m < 4; ++m) _Pragma("unroll") for (int n = 0; n < 2; ++n) _Pragma("unroll") for (int k = 0; k < 2; ++k) \
        acc[ai][bj][m][n] = __builtin_amdgcn_mfma_f32_16x16x32_bf16(Bt[n][k], At[m][k], acc[ai][bj][m][n], 0, 0, 0); __builtin_amdgcn_s_setprio(0); } while (0)
#define PG8_WAIT_V(n) asm volatile("s_waitcnt vmcnt(" #n ")" ::: "memory")
#define PG8_WAIT_L(n) asm volatile("s_waitcnt lgkmcnt(" #n ")" ::: "memory")
#define PG8_BAR __builtin_amdgcn_s_barrier()
#define PG8_SCHED __builtin_amdgcn_sched_barrier(0)
    Unit cur, nxt; int ui = 0;
    if (!S.next(0, cur)) return;
    f32x4 acc[2][2][4][2];
#pragma unroll
    for (int a = 0; a < 2; ++a)
#pragma unroll
        for (int b = 0; b < 2; ++b)
#pragma unroll
            for (int m = 0; m < 4; ++m)
#pragma unroll
                for (int n = 0; n < 2; ++n) acc[a][b][m][n] = (f32x4){0.f, 0.f, 0.f, 0.f};
    bf16x8 At[4][2], B0[2][2], B1[2][2];
    const char* cA = (const char*)g.A + (size_t)cur.pm * tstepA + 2 * S.koff(cur); const char* cB = (const char*)g.Bt + (size_t)cur.pn * tstepB + 2 * S.koff(cur);
    PG8_STAGE(PG8_SB(0, 0), cB, voffB); PG8_STAGE(PG8_SB(0, 1), cB + hstepB, voffB); PG8_STAGE(PG8_SA(0, 0), cA, voffA); PG8_STAGE(PG8_SA(0, 1), cA + hstepA, voffA);
    if (wr == 1) PG8_BAR;
    PG8_WAIT_V(2); PG8_BAR;
    PG8_STAGE(PG8_SB(1, 0), cB + kstep, voffB); PG8_STAGE(PG8_SA(1, 0), cA + kstep, voffA); PG8_STAGE(PG8_SB(1, 1), cB + hstepB + kstep, voffB);
    PG8_WAIT_V(6); PG8_BAR;
    for (;;) {
        const bool has_next = S.next(ui + 1, nxt);
        const char* nA = has_next ? (const char*)g.A + (size_t)nxt.pm * tstepA + 2 * S.koff(nxt) : cA; const char* nB = has_next ? (const char*)g.Bt + (size_t)nxt.pn * tstepB + 2 * S.koff(nxt) : cB;
        const int nt = S.nt(cur, g.K);
        for (int t = 0; t < nt; t += 2) {
            const bool last = (t == nt - 2);
            const char* a1 = cA + (size_t)(t + 1) * kstep;
            const char* a2 = last ? nA : cA + (size_t)(t + 2) * kstep; const char* b2 = last ? nB : cB + (size_t)(t + 2) * kstep;
            const char* a3 = a2 + kstep; const char* b3 = b2 + kstep;
            PG8_LDB(B0, 0, 0); PG8_LDB(B1, 0, 1); PG8_SCHED; PG8_LDA(At, 0, 0); PG8_STAGE(PG8_SA(1, 1), a1 + hstepA, voffA);
            PG8_WAIT_V(8); PG8_WAIT_L(0); PG8_BAR; PG8_MMA(0, 0, At, B0); PG8_MMA(0, 1, At, B1); PG8_BAR; PG8_SCHED;
            PG8_LDA(At, 0, 1); PG8_STAGE(PG8_SB(0, 0), b2, voffB); PG8_STAGE(PG8_SB(0, 1), b2 + hstepB, voffB); PG8_STAGE(PG8_SA(0, 0), a2, voffA);
            PG8_WAIT_V(8); PG8_WAIT_L(0); PG8_BAR; PG8_MMA(1, 0, At, B0); PG8_MMA(1, 1, At, B1); PG8_BAR; PG8_SCHED;
            PG8_LDB(B0, 1, 0); PG8_LDB(B1, 1, 1); PG8_SCHED; PG8_LDA(At, 1, 0); PG8_STAGE(PG8_SA(0, 1), a2 + hstepA, voffA);
            PG8_WAIT_V(8); PG8_WAIT_L(0); PG8_BAR; PG8_MMA(0, 0, At, B0); PG8_MMA(0, 1, At, B1); PG8_BAR; PG8_SCHED;
            PG8_LDA(At, 1, 1); PG8_STAGE(PG8_SB(1, 0), b3, voffB); PG8_STAGE(PG8_SB(1, 1), b3 + hstepB, voffB); PG8_STAGE(PG8_SA(1, 0), a3, voffA);
            PG8_WAIT_V(8); PG8_WAIT_L(0); PG8_BAR; PG8_MMA(1, 0, At, B0); PG8_MMA(1, 1, At, B1); PG8_BAR; PG8_SCHED;
        }
        if (wr == 0) PG8_BAR;
        E(acc, cur, wr, wc, fr, fq);
        if (!has_next) break;
        if (!S.keep_acc(cur))
#pragma unroll
        for (int a = 0; a < 2; ++a)
#pragma unroll
            for (int b = 0; b < 2; ++b)
#pragma unroll
                for (int m = 0; m < 4; ++m)
#pragma unroll
                    for (int n = 0; n < 2; ++n) acc[a][b][m][n] = (f32x4){0.f, 0.f, 0.f, 0.f};
        cur = nxt; cA = nA; cB = nB; ++ui;
        if (wr == 1) PG8_BAR;
    }
    PG8_WAIT_V(0);
    PG8_BAR;
#undef PG8_SA
#undef PG8_SB
#undef PG8_STAGE
#undef PG8_LDA
#undef PG8_LDB
#undef PG8_MMA
#undef PG8_WAIT_V
#undef PG8_WAIT_L
#undef PG8_BAR
#undef PG8_SCHED
}
}

#define GAS __attribute__((address_space(1)))
#define LAS __attribute__((address_space(3)))
typedef unsigned short bf16_t;
typedef short bf16x8 __attribute__((ext_vector_type(8)));
typedef short s16x4 __attribute__((ext_vector_type(4)));
typedef float f32x4 __attribute__((ext_vector_type(4)));
typedef float f32x16 __attribute__((ext_vector_type(16)));
typedef unsigned u32x4 __attribute__((ext_vector_type(4)));
typedef unsigned u32x2 __attribute__((ext_vector_type(2)));

constexpr int DM = 2048, BATCH = 4, SEQ = 4096, M = BATCH * SEQ, DFF = 5632, NIN = 12288, NGU = 11264, QKVP = 6144;
constexpr int NWAVES = 8, NTHR = 512;
constexpr size_t MiB = 1u << 20;
constexpr size_t WS_CTR = 0, WS_SS = 64 * 1024, WS_LUT = 512 * 1024, WS_KM = 1 * MiB;
constexpr size_t WS_WIN = 4 * MiB, WS_WBR = 100 * MiB, WS_WOUT = 116 * MiB, WS_WGU = 132 * MiB, WS_WDN = 220 * MiB;
constexpr size_t WS_XB = 264 * MiB, WS_QKV = 328 * MiB, WS_GATES = 520 * MiB, WS_END = 712 * MiB;
constexpr int LDS_BYTES = 143360;
constexpr int ATT_V_OFF = 0, ATT_LUT_OFF = 65536, ATT_KM_OFF = 81920, DIL_K_OFF = 73728, MISC_OFF = 142336;

struct Args {
    const float* x; const float* g_mix; const float* w_in; const float* q_gain; const float* k_gain; const float* w_branch; const float* w_out;
    const float* g_ffn; const float* w_gu; const float* w_down; const float* rel_bias;
    float* out; unsigned char* ws; int ph_lo, ph_hi;
};

__device__ __forceinline__ unsigned f2bf(float f) { unsigned u = __builtin_bit_cast(unsigned, f); return (u + 0x7fffu + ((u >> 16) & 1u)) >> 16; }
__device__ __forceinline__ unsigned pk2(float lo, float hi) { return pg8::cvt_pk_bf16(lo, hi); }
__device__ __forceinline__ float wave_sum(float v) {
#pragma unroll
    for (int o = 1; o < 64; o <<= 1) v += __shfl_xor(v, o);
    return v;
}

template <bool GU>
__device__ __forceinline__ void transpose_item(const float* W, const float* gk, int K, int N, bf16_t* WT, LAS float* scr, int item, int lane) {
    const int nblk = N / 32, kb = item / nblk, nb = item % nblk, k0 = 64 * kb, n0 = 32 * nb;
    float v[32];
#pragma unroll
    for (int i = 0; i < 32; ++i) v[i] = W[(size_t)(k0 + 2 * i + (lane >> 5)) * N + n0 + (lane & 31)];
#pragma unroll
    for (int i = 0; i < 32; ++i) { const int kk = 2 * i + (lane >> 5); if (gk) v[i] *= gk[k0 + kk]; scr[kk * 33 + (lane & 31)] = v[i]; }
    asm volatile("s_waitcnt lgkmcnt(0)" ::: "memory");
    const int c = lane & 7;
#pragma unroll
    for (int j = 0; j < 4; ++j) { const int n = (lane >> 3) + 8 * j; const LAS float* s = scr + (8 * c) * 33 + n;
        u32x4 o; o.x = pk2(s[0 * 33], s[1 * 33]); o.y = pk2(s[2 * 33], s[3 * 33]); o.z = pk2(s[4 * 33], s[5 * 33]); o.w = pk2(s[6 * 33], s[7 * 33]);
        int col = n0 + n, drow;
        if (GU) { const int half = col >= DFF ? 1 : 0, jj = col - half * DFF; drow = 256 * (jj >> 7) + 128 * half + (jj & 127); } else drow = col;
        *(u32x4*)(WT + (size_t)drow * K + k0 + 8 * c) = o; }
    asm volatile("s_waitcnt lgkmcnt(0)" ::: "memory");
}

__device__ __forceinline__ void phase_prologue(const Args& a, LAS unsigned char* lds, int tid, int lane, int wave) {
    unsigned char* ws = a.ws;
    LAS float* scr = (LAS float*)(lds + wave * 16384);
    int NGW = gridDim.x * NWAVES; asm volatile("" : "+s"(NGW));
    const int gw = blockIdx.x * NWAVES + wave;
    constexpr int I_IN = (DM / 64) * (NIN / 32), I_BR = (DM / 64) * (DM / 32), I_OUT = I_BR, I_GU = (DM / 64) * (NGU / 32), I_DN = (DFF / 64) * (DM / 32);
    constexpr int I_LAYER = I_IN + I_BR + I_OUT + I_GU + I_DN;
    for (int it = gw; it < 2 * I_LAYER; it += NGW) {
        const int l = it / I_LAYER; int r = it % I_LAYER;
        if (r < I_IN) { transpose_item<false>(a.w_in + (size_t)l * DM * NIN, a.g_mix + l * DM, DM, NIN, (bf16_t*)(ws + WS_WIN) + (size_t)l * NIN * DM, scr, r, lane); continue; } r -= I_IN;
        if (r < I_BR) { transpose_item<false>(a.w_branch + (size_t)l * DM * DM, nullptr, DM, DM, (bf16_t*)(ws + WS_WBR) + (size_t)l * DM * DM, scr, r, lane); continue; } r -= I_BR;
        if (r < I_OUT) { transpose_item<false>(a.w_out + (size_t)l * DM * DM, nullptr, DM, DM, (bf16_t*)(ws + WS_WOUT) + (size_t)l * DM * DM, scr, r, lane); continue; } r -= I_OUT;
        if (r < I_GU) { transpose_item<true>(a.w_gu + (size_t)l * DM * NGU, a.g_ffn + l * DM, DM, NGU, (bf16_t*)(ws + WS_WGU) + (size_t)l * NGU * DM, scr, r, lane); continue; } r -= I_GU;
        transpose_item<false>(a.w_down + (size_t)l * DFF * DM, nullptr, DFF, DM, (bf16_t*)(ws + WS_WDN) + (size_t)l * DM * DFF, scr, r, lane);
    }
    float* ss = (float*)(ws + WS_SS);
    for (int m = gw; m < M; m += NGW) {
        const f32x4* xr = (const f32x4*)(a.x + (size_t)m * DM) + lane; u32x2* o8 = (u32x2*)((bf16_t*)(ws + WS_XB) + (size_t)m * DM) + lane;
        float s = 0.f;
#pragma unroll
        for (int j = 0; j < 8; ++j) { const f32x4 v = xr[64 * j]; s += (v.x * v.x + v.y * v.y) + (v.z * v.z + v.w * v.w); u32x2 w; w.x = pk2(v.x, v.y); w.y = pk2(v.z, v.w); o8[64 * j] = w; }
        s = wave_sum(s);
        if (lane == 0) ss[m] = s;
    }
    int NGT = gridDim.x * NTHR; asm volatile("" : "+s"(NGT));
    const int gt = blockIdx.x * NTHR + tid;
    for (int i = gt; i < 3 * M; i += NGT) ss[M + i] = 0.f;
    if (gt < 1024) ((unsigned*)(ws + WS_CTR))[gt] = 0u;
    float* lut = (float*)(ws + WS_LUT);
    for (int i = gt; i < 12 * 4096; i += NGT) { const int hs = i >> 12, d = i & 4095; int bucket;
        if (d < 16) bucket = d; else { const float df = (float)d; int large = 16 + (int)(logf(df / 16.0f) / 4.852030263919617f * 16.0f); bucket = large < 31 ? large : 31; }
        lut[i] = a.rel_bias[bucket * 12 + hs] * 1.4426950408889634f; }
}

__device__ __forceinline__ void phase_qknorm(const Args& a, int l, LAS unsigned char* lds, int tid, int lane, int wave) {
    bf16_t* qkv = (bf16_t*)(a.ws + WS_QKV); float* kmean = (float*)(a.ws + WS_KM);
    LAS float* red = (LAS float*)lds;
    for (int it = blockIdx.x; it < 1536; it += gridDim.x) {
        const int kind = it / 768, rem = it % 768, b = rem / 192, hs = (rem % 192) / 16, blk = rem % 16;
        const float* gain = (kind ? a.k_gain : a.q_gain) + (size_t)l * 12 * 128 + hs * 128 + (lane & 15) * 8;
        float gn[8];
#pragma unroll
        for (int e = 0; e < 8; ++e) gn[e] = gain[e];
        bf16_t* base = qkv + (size_t)(b * SEQ + blk * 256 + wave * 32) * QKVP + kind * 2048 + (4 + hs) * 128 + (lane & 15) * 8;
        float ks[8];
#pragma unroll
        for (int e = 0; e < 8; ++e) ks[e] = 0.f;
        u32x4 wv[8];
#pragma unroll
        for (int ii = 0; ii < 8; ++ii) wv[ii] = *(const u32x4*)(base + (size_t)(4 * ii + (lane >> 4)) * QKVP);
#pragma unroll
        for (int ii = 0; ii < 8; ++ii) { bf16_t* p = base + (size_t)(4 * ii + (lane >> 4)) * QKVP;
            const u32x4 w = wv[ii]; float v[8];
            v[0] = pg8::bf_lo(w.x); v[1] = pg8::bf_hi(w.x); v[2] = pg8::bf_lo(w.y); v[3] = pg8::bf_hi(w.y); v[4] = pg8::bf_lo(w.z); v[5] = pg8::bf_hi(w.z); v[6] = pg8::bf_lo(w.w); v[7] = pg8::bf_hi(w.w);
            float s = 0.f;
#pragma unroll
            for (int e = 0; e < 8; ++e) s += v[e] * v[e];
            s += __shfl_xor(s, 1); s += __shfl_xor(s, 2); s += __shfl_xor(s, 4); s += __shfl_xor(s, 8);
            const float rs = rsqrtf(s * (1.0f / 128.0f) + 1e-6f);
#pragma unroll
            for (int e = 0; e < 8; ++e) { v[e] = v[e] * rs * gn[e]; ks[e] += v[e]; }
            u32x4 o; o.x = pk2(v[0], v[1]); o.y = pk2(v[2], v[3]); o.z = pk2(v[4], v[5]); o.w = pk2(v[6], v[7]);
            *(u32x4*)p = o; }
        const bool km = (kind == 1) && (hs < 6);
        if (km) {
#pragma unroll
            for (int e = 0; e < 8; ++e) { ks[e] += __shfl_xor(ks[e], 16); ks[e] += __shfl_xor(ks[e], 32); }
            if (lane < 16) {
#pragma unroll
                for (int e = 0; e < 8; ++e) red[wave * 128 + lane * 8 + e] = ks[e]; }
        }
        __syncthreads();
        if (km && tid < 128) { float s = 0.f;
#pragma unroll
            for (int w = 0; w < 8; ++w) s += red[w * 128 + tid];
            kmean[((size_t)(b * 6 + hs) * 16 + blk) * 128 + tid] = s * (1.0f / 256.0f); }
        __syncthreads();
    }
}

namespace att {
constexpr float SCALE = 0.08838834764831845f, LOG2E = 1.4426950408889634f, NEG = -1e30f, C1 = SCALE * LOG2E;
__device__ __forceinline__ unsigned offa(unsigned row, unsigned ch) { return 2048u * (row >> 3) + 512u * (ch >> 2) + 64u * (row & 7u) + 16u * ((ch & 3u) ^ ((row >> 2) & 3u)); }
__device__ __forceinline__ int clamp_s(int s) { return s < 0 ? 0 : (s > SEQ - 1 ? SEQ - 1 : s); }
__device__ __forceinline__ void load_k(bf16x8 (&kf)[8], const bf16_t* Kb, int s0, int stride, int lane) {
    const int s = clamp_s(s0 + stride * (lane & 31));
    const GAS bf16x8* p = (const GAS bf16x8*)(Kb + (size_t)s * QKVP + 8 * (lane >> 5));
#pragma unroll
    for (int j = 0; j < 8; ++j) kf[j] = p[2 * j];
}
__device__ __forceinline__ void load_v(u32x4 (&vr)[8], const bf16_t* Vb, int s0, int stride, int lane) {
#pragma unroll
    for (int ii = 0; ii < 8; ++ii) { const int s = clamp_s(s0 + stride * ((lane >> 4) + 4 * ii)); vr[ii] = *(const GAS u32x4*)(Vb + (size_t)s * QKVP + (lane & 15) * 8); }
}
__device__ __forceinline__ void stage_v(LAS unsigned char* vl, const u32x4 (&vr)[8], int lane) {
    const unsigned ch = lane & 15, wl = 512u * (ch >> 2) + 64u * (unsigned)(lane >> 4);
#pragma unroll
    for (int ii = 0; ii < 8; ++ii) *(LAS u32x4*)(vl + wl + 16u * ((ch & 3u) ^ (unsigned)(ii & 3)) + 2048 * (ii >> 1) + 256 * (ii & 1)) = vr[ii];
}
__device__ __forceinline__ f32x16 qk(const bf16x8 (&kf)[8], const bf16x8 (&qf)[8]) {
    f32x16 acc = {0.f, 0.f, 0.f, 0.f, 0.f, 0.f, 0.f, 0.f, 0.f, 0.f, 0.f, 0.f, 0.f, 0.f, 0.f, 0.f};
#pragma unroll
    for (int j = 0; j < 8; ++j) acc = __builtin_amdgcn_mfma_f32_32x32x16_bf16(kf[j], qf[j], acc, 0, 0, 0);
    return acc;
}
typedef short v4i16_t __attribute__((ext_vector_type(4)));
__device__ __forceinline__ s16x4 vtr(LAS unsigned char* p) { return __builtin_bit_cast(s16x4, __builtin_amdgcn_ds_read_tr16_b64_v4i16((LAS v4i16_t*)p)); }
__device__ __forceinline__ void pv(f32x16 (&o)[4], LAS unsigned char* vl, bf16x8 P0, bf16x8 P1, int lane) {
    const unsigned h = lane >> 5, blk = (lane >> 4) & 1, q = (lane & 15) >> 2, p = lane & 3;
    const unsigned lb = 64u * (4u * h + q) + 16u * ((p >> 1) ^ h) + 8u * (p & 1u);
    LAS unsigned char* b0 = vl + lb + 32u * blk; LAS unsigned char* b1 = vl + lb + 32u * (blk ^ 1u) + 2048u;
#pragma unroll
    for (int hf = 0; hf < 2; ++hf) {
        s16x4 lo[2][2], hi[2][2];
#pragma unroll
        for (int cc = 0; cc < 2; ++cc)
#pragma unroll
            for (int s = 0; s < 2; ++s) { lo[cc][s] = vtr(b0 + 4096 * s + 512 * (2 * hf + cc)); hi[cc][s] = vtr(b1 + 4096 * s + 512 * (2 * hf + cc)); }
        asm volatile("s_waitcnt lgkmcnt(0)" ::: "memory");
        __builtin_amdgcn_sched_barrier(0);
#pragma unroll
        for (int cc = 0; cc < 2; ++cc)
#pragma unroll
            for (int s = 0; s < 2; ++s) {
                const bf16x8 A = {lo[cc][s][0], lo[cc][s][1], lo[cc][s][2], lo[cc][s][3], hi[cc][s][0], hi[cc][s][1], hi[cc][s][2], hi[cc][s][3]};
                o[2 * hf + cc] = __builtin_amdgcn_mfma_f32_32x32x16_bf16(A, s ? P1 : P0, o[2 * hf + cc], 0, 0, 0);
            }
        __builtin_amdgcn_sched_barrier(0);
    }
}
typedef float f32x2_t __attribute__((ext_vector_type(2))); typedef __bf16 bf16x2_t __attribute__((ext_vector_type(2)));
__device__ __forceinline__ unsigned cvtpk(float lo, float hi) { f32x2_t v = {lo, hi}; bf16x2_t b = __builtin_convertvector(v, bf16x2_t); return __builtin_bit_cast(unsigned, b); }
__device__ __forceinline__ void pack_p(const float (&p)[16], bf16x8& P0, bf16x8& P1) {
    u32x4 a, b; a.x = cvtpk(p[0], p[1]); a.y = cvtpk(p[2], p[3]); a.z = cvtpk(p[4], p[5]); a.w = cvtpk(p[6], p[7]);
    b.x = cvtpk(p[8], p[9]); b.y = cvtpk(p[10], p[11]); b.z = cvtpk(p[12], p[13]); b.w = cvtpk(p[14], p[15]);
    P0 = __builtin_bit_cast(bf16x8, a); P1 = __builtin_bit_cast(bf16x8, b);
}
__device__ __forceinline__ void softmax_step(float (&x)[16], float& m, float& l, f32x16 (&o)[4], bf16x8& P0, bf16x8& P1) {
    float mx = fmaxf(x[0], x[1]);
#pragma unroll
    for (int r = 2; r < 16; ++r) mx = fmaxf(mx, x[r]);
    mx = fmaxf(mx, __shfl_xor(mx, 32));
    const float mn = fmaxf(m, mx);
    const float alpha = __builtin_amdgcn_exp2f(m - mn);
    float ls = 0.f;
#pragma unroll
    for (int r = 0; r < 16; ++r) { const float p = __builtin_amdgcn_exp2f(x[r] - mn); ls += p; x[r] = p; }
    l = l * alpha + ls; m = mn;
    if (__any(alpha != 1.0f)) {
#pragma unroll
        for (int c = 0; c < 4; ++c) o[c] = o[c] * alpha;
    }
    pack_p(x, P0, P1);
}
__device__ __forceinline__ void softmax_fixed(float (&x)[16], float& l, bf16x8& P0, bf16x8& P1) {
    float ls = 0.f;
#pragma unroll
    for (int r = 0; r < 16; ++r) { const float p = __builtin_amdgcn_exp2f(x[r]); ls += p; x[r] = p; }
    l += ls;
    pack_p(x, P0, P1);
}
__device__ __forceinline__ float softmax_ref(const Args& a, int l, int hs, const bf16x8 (&qf)[8], int lane) {
    const float* kg = a.k_gain + (size_t)l * 12 * 128 + hs * 128;
    float gm = fmaxf(fabsf(kg[lane]), fabsf(kg[lane + 64]));
    float bm = a.rel_bias[(lane & 31) * 12 + hs];
#pragma unroll
    for (int o_ = 1; o_ < 64; o_ <<= 1) { gm = fmaxf(gm, __shfl_xor(gm, o_)); bm = fmaxf(bm, __shfl_xor(bm, o_)); }
    float qs = 0.f;
#pragma unroll
    for (int j = 0; j < 8; ++j) { const u32x4 qw = __builtin_bit_cast(u32x4, qf[j]);
        const float q0 = pg8::bf_lo(qw.x), q1 = pg8::bf_hi(qw.x), q2 = pg8::bf_lo(qw.y), q3 = pg8::bf_hi(qw.y), q4 = pg8::bf_lo(qw.z), q5 = pg8::bf_hi(qw.z), q6 = pg8::bf_lo(qw.w), q7 = pg8::bf_hi(qw.w);
        qs += (q0 * q0 + q1 * q1) + (q2 * q2 + q3 * q3) + (q4 * q4 + q5 * q5) + (q6 * q6 + q7 * q7); }
    qs += __shfl_xor(qs, 32);
    return C1 * sqrtf(qs) * (11.3137085f * 1.004f * gm) + bm * LOG2E + 1e-3f;
}
__device__ __forceinline__ void store_o(const f32x16 (&o)[4], float inv, bf16_t* orow, int lane) {
    const int h = lane >> 5;
#pragma unroll
    for (int c = 0; c < 4; ++c)
#pragma unroll
        for (int i = 0; i < 4; ++i) { u32x2 w; w.x = cvtpk(o[c][4 * i] * inv, o[c][4 * i + 1] * inv); w.y = cvtpk(o[c][4 * i + 2] * inv, o[c][4 * i + 3] * inv);
            *(GAS u32x2*)(orow + 32 * c + 8 * i + 4 * h) = w; }
}
__device__ __forceinline__ void load_q(bf16x8 (&qf)[8], const bf16_t* qrow, int lane) {
    const GAS bf16x8* p = (const GAS bf16x8*)(qrow + 8 * (lane >> 5));
#pragma unroll
    for (int j = 0; j < 8; ++j) qf[j] = p[2 * j];
}

__device__ __forceinline__ void unit_moba(const Args& a, int lyr, bf16_t* Ob, int OP, int b, int hm, int qb, LAS unsigned char* lds, int tid, int lane, int wave) {
    asm volatile("" : "+v"(lane));
    const bf16_t* qkv = (const bf16_t*)(a.ws + WS_QKV);
    LAS float* lutL = (LAS float*)(lds + ATT_LUT_OFF); LAS float* kmL = (LAS float*)(lds + ATT_KM_OFF);
    { const float* lutG = (const float*)(a.ws + WS_LUT) + hm * 4096;
#pragma unroll
      for (int k_ = 0; k_ < 8; ++k_) lutL[tid + k_ * NTHR] = lutG[tid + k_ * NTHR];
      const float* kmG = (const float*)(a.ws + WS_KM) + (size_t)(b * 6 + hm) * 16 * 128;
#pragma unroll
      for (int k_ = 0; k_ < 4; ++k_) kmL[tid + k_ * NTHR] = kmG[tid + k_ * NTHR]; }
    __syncthreads();
    const int h = lane >> 5, t0 = qb * 256, tw = t0 + 32 * wave, t = tw + (lane & 31), hg = 4 + hm;
    const bf16_t* Kb = qkv + (size_t)b * SEQ * QKVP + 2048 + hg * 128; const bf16_t* Vb = Kb + 2048;
    bf16x8 qf[8]; load_q(qf, qkv + (size_t)(b * SEQ + t) * QKVP + hg * 128, lane);
    unsigned selmask = 0u, anymask = 0u;
    if (qb > 0) {
        float v1 = -3e38f, v2 = -3e38f, v3 = -3e38f; int i1 = -1, i2 = -1, i3 = -1;
        for (int n = 0; n < qb; ++n) {
            float g = 0.f;
#pragma unroll
            for (int j = 0; j < 8; ++j) { const LAS f32x4* kp = (const LAS f32x4*)(kmL + n * 128 + 16 * j + 8 * h); const f32x4 k0 = kp[0], k1 = kp[1];
                const u32x4 qw = __builtin_bit_cast(u32x4, qf[j]);
                g += pg8::bf_lo(qw.x) * k0[0] + pg8::bf_hi(qw.x) * k0[1] + pg8::bf_lo(qw.y) * k0[2] + pg8::bf_hi(qw.y) * k0[3]
                   + pg8::bf_lo(qw.z) * k1[0] + pg8::bf_hi(qw.z) * k1[1] + pg8::bf_lo(qw.w) * k1[2] + pg8::bf_hi(qw.w) * k1[3]; }
            g += __shfl_xor(g, 32);
            if (g > v1) { v3 = v2; i3 = i2; v2 = v1; i2 = i1; v1 = g; i1 = n; } else if (g > v2) { v3 = v2; i3 = i2; v2 = g; i2 = n; } else if (g > v3) { v3 = g; i3 = n; }
        }
        if (i1 >= 0) selmask |= 1u << i1; if (i2 >= 0) selmask |= 1u << i2; if (i3 >= 0) selmask |= 1u << i3;
        for (int n = 0; n < qb; ++n) if (__ballot((selmask >> n) & 1u) != 0ull) anymask |= 1u << n;
    }
    volatile LAS unsigned* misc = (volatile LAS unsigned*)(lds + MISC_OFF);
    if (tid == 0) misc[4] = 0u;
    __syncthreads();
    if (lane == 0 && anymask != 0u) __hip_atomic_fetch_or((LAS unsigned*)(lds + MISC_OFF + 16), anymask, __ATOMIC_RELAXED, __HIP_MEMORY_SCOPE_WORKGROUP);
    __syncthreads();
    const unsigned anywg = misc[4];
    const float nref = -softmax_ref(a, lyr, hm, qf, lane);
    float l = 0.f; f32x16 o[4];
#pragma unroll
    for (int c = 0; c < 4; ++c) o[c] = (f32x16){0.f, 0.f, 0.f, 0.f, 0.f, 0.f, 0.f, 0.f, 0.f, 0.f, 0.f, 0.f, 0.f, 0.f, 0.f, 0.f};
    const int srow = 8 * (wave >> 1) + ((lane >> 2) & 7), sch = 4 * (2 * (wave & 1) + (lane >> 5)) + ((lane & 3) ^ ((srow >> 2) & 3));
    const bf16_t* kg = Kb + (size_t)srow * QKVP + sch * 8; const bf16_t* vg = Vb + (size_t)srow * QKVP + sch * 8;
    const int r31 = lane & 31; const unsigned x0 = (r31 >> 2) & 1, x1 = (r31 >> 3) & 1;
    const unsigned kb_l = 2048u * (r31 >> 3) + 64u * (r31 & 7) + 16u * ((unsigned)h ^ x0);
    const unsigned ke0 = kb_l + 32u * x1, ke1 = kb_l + 32u * (x1 ^ 1u);
#define MOBA_STAGE(buf, nblk, stp) do { const size_t ro_ = (size_t)(256 * (nblk) + 64 * (stp)) * QKVP; LAS unsigned char* d_ = lds + ATT_V_OFF + (buf) * 32768 + wave * 1024; \
        __builtin_amdgcn_global_load_lds((const unsigned*)(kg + ro_), (LAS unsigned*)(d_), 16, 0, 0); \
        __builtin_amdgcn_global_load_lds((const unsigned*)(kg + ro_ + 32 * QKVP), (LAS unsigned*)(d_ + 8192), 16, 0, 0); \
        __builtin_amdgcn_global_load_lds((const unsigned*)(vg + ro_), (LAS unsigned*)(d_ + 16384), 16, 0, 0); \
        __builtin_amdgcn_global_load_lds((const unsigned*)(vg + ro_ + 32 * QKVP), (LAS unsigned*)(d_ + 24576), 16, 0, 0); } while (0)
    int n = qb, st = 3;
    MOBA_STAGE(0, n, st);
    asm volatile("s_waitcnt vmcnt(0)" ::: "memory");
    __syncthreads();
    int cur = 0;
    for (;;) {
        int nn = n, nst = st; bool has_next = true;
        if (n == qb) { if (st > 0) nst = st - 1; else { if (anywg == 0u) has_next = false; else { nn = __builtin_ctz(anywg); nst = 0; } } }
        else { if (st < 3) nst = st + 1; else { const unsigned rest = anywg & ~((2u << n) - 1u); if (rest == 0u) has_next = false; else { nn = __builtin_ctz(rest); nst = 0; } } }
        if (has_next) MOBA_STAGE(cur ^ 1, nn, nst);
        const bool own = (n == qb);
        const bool active = own ? (2 * st <= wave) : (((anymask >> (n & 31)) & 1u) != 0u);
        if (active) {
            LAS unsigned char* kl = lds + ATT_V_OFF + cur * 32768;
            const int dbase = t - (256 * n + 64 * st);
            const float lanebias = own ? nref : (((selmask >> (n & 31)) & 1u) ? nref : NEG);
            bf16x8 PA0, PA1, PB0, PB1;
#pragma unroll
            for (int tt = 0; tt < 2; ++tt) {
                bf16x8 kc[8];
#pragma unroll
                for (int s = 0; s < 8; ++s) kc[s] = *(const LAS bf16x8*)(kl + 8192 * tt + ((s & 1) ? ke1 : ke0) + 512 * (s >> 1));
                asm volatile("s_waitcnt lgkmcnt(0)" ::: "memory"); __builtin_amdgcn_sched_barrier(0);
                const f32x16 sacc = qk(kc, qf);
                const int db = dbase - 32 * tt;
                float x[16];
                if (own) {
#pragma unroll
                    for (int r = 0; r < 16; ++r) { const int dist = db - (8 * (r >> 2) + 4 * h + (r & 3)); const float lvv = lutL[dist < 0 ? 0 : dist];
                        const float xx = __builtin_fmaf(sacc[r], C1, lvv) + nref; x[r] = (dist >= 0) ? xx : NEG; }
                } else {
                    const LAS float* lp = lutL + (db - 4 * h);
#pragma unroll
                    for (int r = 0; r < 16; ++r) x[r] = __builtin_fmaf(sacc[r], C1, lp[-(8 * (r >> 2) + (r & 3))]) + lanebias;
                }
                if (tt == 0) softmax_fixed(x, l, PA0, PA1); else softmax_fixed(x, l, PB0, PB1);
            }
            pv(o, kl + 16384, PA0, PA1, lane);
            pv(o, kl + 24576, PB0, PB1, lane);
        }
        if (!has_next) break;
        asm volatile("s_waitcnt vmcnt(0)" ::: "memory");
        __syncthreads();
        n = nn; st = nst; cur ^= 1;
    }
#undef MOBA_STAGE
    l += __shfl_xor(l, 32);
    store_o(o, 1.0f / l, Ob + (size_t)(b * SEQ + t) * OP + hg * 128, lane);
}

__device__ __forceinline__ void dil_desc(int idx, int tb, int c4, int i, int& s0, int& stride, int& delta0, int& pat, int& aa) {
    if (idx < 5) { const int kt = 4 - idx; stride = 4; s0 = tb + c4 + 4 * (-128 + 32 * kt); delta0 = i + 128 - 32 * kt; pat = 0; aa = 0; }
    else if (idx < 13) { const int kt = idx - 5; stride = 1; s0 = tb - 128 + 32 * kt; delta0 = c4 + 4 * i + 128 - 32 * kt; pat = 1; aa = 0; }
    else { aa = (idx - 13) / 5; const int kt = (idx - 13) % 5; stride = 16; s0 = tb + c4 + 4 * aa + 16 * (-128 + 32 * kt); delta0 = (i >> 2) + 128 - 32 * kt; pat = 2; }
}
__device__ __forceinline__ void unit_dilated(const Args& a, int lyr, bf16_t* Ob, int OP, int b, int hd, int qb, LAS unsigned char* lds, int tid, int lane, int wave) {
    asm volatile("" : "+v"(lane));
    const bf16_t* qkv = (const bf16_t*)(a.ws + WS_QKV);
    LAS float* lut3 = (LAS float*)(lds + ATT_LUT_OFF);
    { const float* lutG = (const float*)(a.ws + WS_LUT) + (6 + hd) * 4096;

#pragma unroll
      for (int k_ = 0; k_ < 3; ++k_) { const int e = tid + k_ * NTHR; if (e >= 3 * 384) break; const int p = e / 384, d = e % 384 - 128; const int st = p == 0 ? 4 : (p == 1 ? 1 : 16); lut3[e] = (d >= 0 && d <= 128) ? lutG[st * d] : 0.f; } }
    __syncthreads();
    LAS unsigned char* vl = lds + ATT_V_OFF + wave * 8192;
    const int h = lane >> 5, i = lane & 31, t0 = qb * 256, tb = t0 + 128 * (wave >> 2), c4 = wave & 3, t = tb + c4 + 4 * i, hg = 10 + hd;
    const bf16_t* Kb = qkv + (size_t)b * SEQ * QKVP + 2048 + hg * 128; const bf16_t* Vb = Kb + 2048;
    bf16x8 qf[8]; load_q(qf, qkv + (size_t)(b * SEQ + t) * QKVP + hg * 128, lane);
    const float nref = -softmax_ref(a, lyr, 6 + hd, qf, lane);
    const unsigned dmax4 = (unsigned)((t >> 2) < 128 ? (t >> 2) : 128), dmax1 = (unsigned)(t < 128 ? t : 128), dmax16 = (unsigned)((t >> 4) < 128 ? (t >> 4) : 128);
    float l = 0.f; f32x16 o[4];
#pragma unroll
    for (int c = 0; c < 4; ++c) o[c] = (f32x16){0.f, 0.f, 0.f, 0.f, 0.f, 0.f, 0.f, 0.f, 0.f, 0.f, 0.f, 0.f, 0.f, 0.f, 0.f, 0.f};
    LAS unsigned char* kl = lds + DIL_K_OFF + wave * 8192;
    const int kc_ = (lane >> 2) & 7, kd_ = lane & 3;
#define DIL_KDMA(s0v, strv) do { _Pragma("unroll") for (int i_ = 0; i_ < 8; ++i_) { const int row_ = 8 * (i_ >> 1) + kc_; const int ch_ = 4 * (2 * (i_ & 1) + (lane >> 5)) + (kd_ ^ ((row_ >> 2) & 3)); \
        const int s_ = clamp_s((s0v) + (strv) * row_); \
        __builtin_amdgcn_global_load_lds((const unsigned*)(Kb + (size_t)s_ * QKVP + ch_ * 8), (LAS unsigned*)(kl + 1024 * i_), 16, 0, 0); } } while (0)
    const int r31 = lane & 31; const unsigned kx0 = (r31 >> 2) & 1, kx1 = (r31 >> 3) & 1;
    const unsigned kb_l = 2048u * (r31 >> 3) + 64u * (r31 & 7) + 16u * ((unsigned)h ^ kx0);
    const unsigned ke0 = kb_l + 32u * kx1, ke1 = kb_l + 32u * (kx1 ^ 1u);
    u32x4 vr[8];
    int s0, stride, delta0, pat, aa;
    dil_desc(0, tb, c4, i, s0, stride, delta0, pat, aa);
    DIL_KDMA(s0, stride); load_v(vr, Vb, s0, stride, lane);
    for (int idx = 0; idx < 33;) {
        asm volatile("s_waitcnt vmcnt(0)" ::: "memory");
        bf16x8 kc[8];
#pragma unroll
        for (int s = 0; s < 8; ++s) kc[s] = *(const LAS bf16x8*)(kl + ((s & 1) ? ke1 : ke0) + 512 * (s >> 1));
        asm volatile("s_waitcnt lgkmcnt(0)" ::: "memory"); __builtin_amdgcn_sched_barrier(0);
        int s0n = 0, stn = 1, d0n = 0, patn = 0, aan = 0, nidx = idx + 1;
#pragma unroll 1
        for (; nidx < 33; ++nidx) {
            int last;
            if (nidx < 5) last = tb + c4 + 4 * (-128 + 32 * (4 - nidx) + 31);
            else if (nidx < 13) last = tb - 128 + 32 * (nidx - 5) + 31;
            else last = tb + c4 + 4 * ((nidx - 13) / 5) + 16 * (-128 + 32 * ((nidx - 13) % 5) + 31);
            if (last >= 0) break; }
        const bool more = nidx < 33;
        if (more) { dil_desc(nidx, tb, c4, i, s0n, stn, d0n, patn, aan); DIL_KDMA(s0n, stn); }
        const f32x16 sacc = qk(kc, qf);
        stage_v(vl, vr, lane);
        if (more) load_v(vr, Vb, s0n, stn, lane);
        const unsigned dmax = pat == 0 ? dmax4 : (pat == 1 ? dmax1 : dmax16);
        const float lb = (pat == 2 && (i & 3) != aa) ? NEG : nref;
        const int dk = delta0 - 4 * h;
        const LAS float* lp = lut3 + pat * 384 + 128 + dk;
        float x[16];
#pragma unroll
        for (int r = 0; r < 16; ++r) { const float lvv = lp[-(8 * (r >> 2) + (r & 3))]; const float xx = __builtin_fmaf(sacc[r], C1, lvv) + lb;
            const unsigned delta = (unsigned)(dk - (8 * (r >> 2) + (r & 3))); x[r] = (delta <= dmax) ? xx : NEG; }
        bf16x8 P0, P1; softmax_fixed(x, l, P0, P1);
        pv(o, vl, P0, P1, lane);
        s0 = s0n; stride = stn; delta0 = d0n; pat = patn; aa = aan; idx = nidx;
    }
#undef DIL_KDMA
    l += __shfl_xor(l, 32);
    store_o(o, 1.0f / l, Ob + (size_t)(b * SEQ + t) * OP + hg * 128, lane);
}

__device__ __forceinline__ void unit_sb(const Args& a, bf16_t* Ob, int OP, int b, int ha, int qb, LAS unsigned char* lds, int tid, int lane, int wave) {
    asm volatile("" : "+v"(lane));
    const bf16_t* qkv = (const bf16_t*)(a.ws + WS_QKV);
    LAS unsigned char* vl = lds + ATT_V_OFF + wave * 8192;
    const int h = lane >> 5, t0 = qb * 256, tw = t0 + 32 * wave, t = tw + (lane & 31);
    const bf16_t* Kb = qkv + (size_t)b * SEQ * QKVP + 2048 + ha * 128; const bf16_t* Vb = Kb + 2048;
    bf16x8 qf[8]; load_q(qf, qkv + (size_t)(b * SEQ + t) * QKVP + ha * 128, lane);
    f32x16 o[4];
#pragma unroll
    for (int c = 0; c < 4; ++c) o[c] = (f32x16){0.f, 0.f, 0.f, 0.f, 0.f, 0.f, 0.f, 0.f, 0.f, 0.f, 0.f, 0.f, 0.f, 0.f, 0.f, 0.f};
    float R = 0.f;
    bf16x8 kc[8];
    int kt = tw >> 5;
    load_k(kc, Kb, 32 * kt, 1, lane);
    for (;;) {
        u32x4 vr[8]; load_v(vr, Vb, 32 * kt, 1, lane);
        const f32x16 sacc = qk(kc, qf);
        const bool more = kt > 0;
        if (more) load_k(kc, Kb, 32 * (kt - 1), 1, lane);
        stage_v(vl, vr, lane);
        const int dbase = t - 32 * kt;
        float lb[16], g[4], gp[4];
#pragma unroll
        for (int i = 0; i < 4; ++i) { g[i] = 0.f;
#pragma unroll
            for (int j = 0; j < 4; ++j) { const int r = 4 * i + j; const int kap = 8 * i + 4 * h + j; const bool past = kap < dbase;
                const float z = sacc[r] * SCALE; const float sp = __logf(1.0f + __expf(-fabsf(z)));
                lb[r] = fminf(z, 0.f) - sp; g[i] += past ? (lb[r] - z) : 0.f; }
            gp[i] = __shfl_xor(g[i], 32); }
        float sg[4]; sg[3] = 0.f; sg[2] = g[3] + gp[3]; sg[1] = sg[2] + g[2] + gp[2]; sg[0] = sg[1] + g[1] + gp[1];
        const float tot = sg[0] + g[0] + gp[0];
#pragma unroll
        for (int i = 0; i < 4; ++i) { const float basei = sg[i] + R + (h == 0 ? gp[i] : 0.f);
            float suf = 0.f;
#pragma unroll
            for (int j = 3; j >= 0; --j) { const int r = 4 * i + j; const int kap = 8 * i + 4 * h + j; const bool past = kap < dbase;
                const float l1 = past ? (lb[r] - sacc[r] * SCALE) : 0.f;
                lb[r] = past ? __expf(lb[r] + suf + basei) : 0.f; suf += l1; } }
        R += tot;
        bf16x8 P0, P1; pack_p(lb, P0, P1);
        pv(o, vl, P0, P1, lane);
        if (!more || __all(R < -110.0f)) break;
        --kt;
    }
    store_o(o, 1.0f, Ob + (size_t)(b * SEQ + t) * OP + ha * 128, lane);
}

__device__ __forceinline__ void phase_attention(const Args& a, int l, int rep, LAS unsigned char* lds, int tid, int lane, int wave) {
    unsigned* ctr0 = (unsigned*)(a.ws + WS_CTR) + (l + 2 * rep) * 64;
    bf16_t* Ob = l == 0 ? (bf16_t*)a.out : (bf16_t*)(a.ws + WS_QKV); const int OP = l == 0 ? DM : QKVP;
    volatile LAS unsigned* misc = (volatile LAS unsigned*)(lds + MISC_OFF);
    int xq = (int)((unsigned)__builtin_amdgcn_s_getreg((3 << 11) | 20) & 7u), left = 8;
    for (;;) {
        __syncthreads();
        if (tid == 0) misc[0] = atomicAdd(ctr0 + xq * 8, 1u);
        __syncthreads();
        const int j = (int)misc[0];
        if (j >= 128) { if (--left == 0) break; xq = (xq + 1) & 7; continue; }
        if (j < 48) { const int qb = 15 - j / 3, bh = 3 * xq + j % 3; unit_moba(a, l, Ob, OP, bh / 6, bh % 6, qb, lds, tid, lane, wave); }
        else if (j < 96) { const int jj = j - 48, qb = jj % 16, bh = 3 * xq + jj / 16; unit_dilated(a, l, Ob, OP, bh / 6, bh % 6, qb, lds, tid, lane, wave); }
        else { const int jj = j - 96, qb = 15 - jj / 2, bh = 2 * xq + jj % 2; unit_sb(a, Ob, OP, bh / 4, bh % 4, qb, lds, tid, lane, wave); }
    }
}
}

__device__ __forceinline__ void grid_barrier(unsigned* bar, unsigned k) {
    asm volatile("s_waitcnt vmcnt(0) lgkmcnt(0)" ::: "memory");
    __syncthreads();
    if (threadIdx.x == 0) {
        const unsigned G = gridDim.x, g = blockIdx.x & 7u, nloc = (G - g + 7u) >> 3, ngrp = G < 8u ? G : 8u;
        __builtin_amdgcn_fence(__ATOMIC_RELEASE, "agent");
        asm volatile("s_waitcnt vmcnt(0)" ::: "memory");
        const unsigned old = __hip_atomic_fetch_add(bar + 64 * g, 1u, __ATOMIC_RELAXED, __HIP_MEMORY_SCOPE_AGENT);
        if (old + 1u == nloc * k) __hip_atomic_fetch_add(bar + 512, 1u, __ATOMIC_RELAXED, __HIP_MEMORY_SCOPE_AGENT);
        unsigned spins = 0;
        while (__hip_atomic_load(bar + 512, __ATOMIC_RELAXED, __HIP_MEMORY_SCOPE_AGENT) < ngrp * k) { __builtin_amdgcn_s_sleep(2); if (++spins > (1u << 24)) break; }
        __builtin_amdgcn_fence(__ATOMIC_ACQUIRE, "agent");
        asm volatile("s_waitcnt vmcnt(0)" ::: "memory");
    }
    __syncthreads();
}

__global__ void __launch_bounds__(NTHR, 2) hybrid_fwd(Args a_) {
    __shared__ __attribute__((aligned(16))) unsigned char lds_raw[LDS_BYTES];
    LAS unsigned char* lds = (LAS unsigned char*)lds_raw;
    const int ph_lo = a_.ph_lo, ph_hi = a_.ph_hi;
    int n_grid = 0;
    for (int ph = ph_lo; ph < ph_hi; ++ph) {
        {
        constexpr int rep = 0;
        int tid = threadIdx.x; asm volatile("" : "+v"(tid));
        const int lane = tid & 63, wave = __builtin_amdgcn_readfirstlane(tid >> 6);
        const __attribute__((address_space(4))) Args* ap = (const __attribute__((address_space(4))) Args*)__builtin_amdgcn_kernarg_segment_ptr(); asm volatile("" : "+s"(ap));
        Args a; a.x = ap->x; a.g_mix = ap->g_mix; a.w_in = ap->w_in; a.q_gain = ap->q_gain; a.k_gain = ap->k_gain; a.w_branch = ap->w_branch; a.w_out = ap->w_out;
        a.g_ffn = ap->g_ffn; a.w_gu = ap->w_gu; a.w_down = ap->w_down; a.rel_bias = ap->rel_bias; a.out = ap->out; a.ws = ap->ws; a.ph_lo = 0; a.ph_hi = 0;
        unsigned char* ws = a.ws;
        const int G = gridDim.x, cidx = blockIdx.x;
        float* ss = (float*)(ws + WS_SS);
        bf16_t* xb = (bf16_t*)(ws + WS_XB); bf16_t* qkv = (bf16_t*)(ws + WS_QKV); bf16_t* gates = (bf16_t*)(ws + WS_GATES);
        bf16_t* ob = qkv; bf16_t* merged = qkv + 2048; bf16_t* act = qkv;
        if (ph == 0) phase_prologue(a, lds, tid, lane, wave);
        else {
            const int l = (ph - 1) / 7, k = (ph - 1) % 7;
            if (k == 0) {
                pg8::Gemm g{xb, (const bf16_t*)(ws + WS_WIN) + (size_t)l * NIN * DM, DM, DM, M, NIN, DM}; pg8::StaticOrder S; S.init(M, NIN, G, cidx);
                pg8::EpiIn E{qkv, gates, ss + (size_t)(2 * l) * M, a.q_gain + (size_t)l * 12 * 128, a.k_gain + (size_t)l * 12 * 128, (float*)(ws + WS_KM), lds + 132096};
                pg8::gemm_phase<pg8::EpiIn, pg8::StaticOrder>(lds, g, S, E, tid);
            } else if (k == 1) {   }
            else if (k == 2) att::phase_attention(a, l, rep, lds, tid, lane, wave);
            else if (k == 3) {
                const bf16_t* wbt = (const bf16_t*)(ws + WS_WBR) + (size_t)l * DM * DM;
                pg8::Gemm g{(l == 0 ? (const bf16_t*)a.out : ob), wbt, l == 0 ? DM : QKVP, DM, M, DM, DM}; pg8::BranchOrder S; S.so.init(M, DM, G, cidx);
                pg8::EpiBranch E{merged, gates};
                pg8::gemm_phase<pg8::EpiBranch, pg8::BranchOrder>(lds, g, S, E, tid);
            } else if (k == 4 || k == 6) {
                const bool dn = (k == 6);
                pg8::Gemm g{dn ? act : merged, dn ? (const bf16_t*)(ws + WS_WDN) + (size_t)l * DM * DFF : (const bf16_t*)(ws + WS_WOUT) + (size_t)l * DM * DM,
                            dn ? DFF : QKVP, dn ? DFF : DM, M, DM, dn ? DFF : DM};
                pg8::StaticOrder S; S.init(M, DM, G, cidx);
                const bool first = (l == 0 && !dn), lastp = dn && (l == 1);
                pg8::EpiResid E{first ? a.x : nullptr, first ? nullptr : xb, lastp ? a.out : nullptr, lastp ? nullptr : xb, lastp ? nullptr : ss + (size_t)(2 * l + (dn ? 2 : 1)) * M};
                pg8::gemm_phase<pg8::EpiResid, pg8::StaticOrder>(lds, g, S, E, tid);
            } else {
                pg8::Gemm g{xb, (const bf16_t*)(ws + WS_WGU) + (size_t)l * NGU * DM, DM, DM, M, NGU, DM}; pg8::StaticOrder S; S.init(M, NGU, G, cidx);
                pg8::EpiGU E{act, ss + (size_t)(2 * l + 1) * M};
                pg8::gemm_phase<pg8::EpiGU, pg8::StaticOrder>(lds, g, S, E, tid);
            }
        }
        }
        if (ph + 1 < ph_hi) {
            if (ph == ph_lo) cg::this_grid().sync();
            else if ((ph - 1) % 7 != 0) { ++n_grid; grid_barrier((unsigned*)(a_.ws + WS_CTR) + 256, (unsigned)n_grid); }
        }
    }
}

__global__ void fill_const(float* o, int n, float v) { for (int i = blockIdx.x * blockDim.x + threadIdx.x; i < n; i += gridDim.x * blockDim.x) o[i] = v; }
extern "C" void kernel_launch(void* const* d_in, const int* in_sizes, int n_in, void* d_out, int out_size, void* d_ws, size_t ws_size, hipStream_t stream) {
    static int grid = 0;
    if (grid == 0) {
        if (n_in != 11 || in_sizes[0] != M * DM || out_size != M * DM || ws_size < WS_END) { fprintf(stderr, "kernel_launch: unexpected shapes / workspace (n_in %d, ws %zu); nothing launched\n", n_in, ws_size); grid = -1; return; }
        int dev = 0, cus = 0, per_cu = 0;
        if (hipGetDevice(&dev) != hipSuccess || hipDeviceGetAttribute(&cus, hipDeviceAttributeMultiprocessorCount, dev) != hipSuccess || cus < 1) cus = 256;
        if (hipOccupancyMaxActiveBlocksPerMultiprocessor(&per_cu, hybrid_fwd, NTHR, 0) != hipSuccess || per_cu < 1) per_cu = 1;
        (void)hipGetLastError();
        grid = cus * per_cu;
    }
    if (grid < 0) return;
    Args a{};
    a.x = (const float*)d_in[0]; a.g_mix = (const float*)d_in[1]; a.w_in = (const float*)d_in[2]; a.q_gain = (const float*)d_in[3]; a.k_gain = (const float*)d_in[4];
    a.w_branch = (const float*)d_in[5]; a.w_out = (const float*)d_in[6]; a.g_ffn = (const float*)d_in[7]; a.w_gu = (const float*)d_in[8]; a.w_down = (const float*)d_in[9];
    a.rel_bias = (const float*)d_in[10]; a.out = (float*)d_out; a.ws = (unsigned char*)d_ws;
#if MK_COOP
    a.ph_lo = 0; a.ph_hi = MK_PH_END;
    void* args[] = {&a};
    hipError_t e = hipLaunchCooperativeKernel((void*)hybrid_fwd, dim3(grid), dim3(NTHR), args, 0, stream);
    if (e != hipSuccess) fprintf(stderr, "kernel_launch: cooperative launch failed: %s (grid %d)\n", hipGetErrorString(e), grid);
#else
    for (int ph = 0; ph < MK_PH_END; ++ph) { a.ph_lo = ph; a.ph_hi = ph + 1; hipLaunchKernelGGL(hybrid_fwd, dim3(grid), dim3(NTHR), 0, stream, a); }
#endif
}
```
